# Optimizing an MI355X kernel written in HIP

```python
import math
import jax, jax.numpy as jnp
from jax import lax
import numpy as np

D_MODEL = 1024
BATCH = 8
SEQ = 8192
DEPTH = 2

HEAD_DIM = 64
BLOCK_Q = 128
NEG = -1e30
EPS = 1e-6
FORCE_BONUS = 1000.0

SB_HEADS = 4
SWA_HEADS = 4
SWA_KV_HEADS = 2
SWA_WINDOW = 128
NSA_HEADS = 4
NSA_KV_HEADS = 2
NSA_CMP_LEN = 32
NSA_CMP_STRIDE = 16
NSA_CMP_HIDDEN = 128
NSA_SEL_LEN = 64
NSA_TOPK = 16
NSA_WINDOW = 512
NSA_QBLOCK = 64
MLA_HEADS = 4
MLA_NOPE = 64
MLA_ROPE = 32
MLA_V = 64
MLA_Q_RANK = 192
MLA_KV_RANK = 128
ROPE_THETA = 10000.0
T5_BUCKETS = 32
T5_MAX_DIST = 1024
N_BIAS_HEADS = SWA_HEADS + NSA_HEADS
MOE_GROUPS = 4
MOE_EXPERTS_PER_GROUP = 8
MOE_EXPERTS = MOE_GROUPS * MOE_EXPERTS_PER_GROUP
MOE_HIDDEN = 256
MOE_TOPK = 2

IN_SPLITS = (SB_HEADS * HEAD_DIM, SB_HEADS * HEAD_DIM, SB_HEADS * HEAD_DIM,
             SWA_HEADS * HEAD_DIM, SWA_KV_HEADS * HEAD_DIM, SWA_KV_HEADS * HEAD_DIM,
             NSA_HEADS * HEAD_DIM,
             NSA_KV_HEADS * HEAD_DIM, NSA_KV_HEADS * HEAD_DIM,
             NSA_KV_HEADS * HEAD_DIM, NSA_KV_HEADS * HEAD_DIM,
             NSA_KV_HEADS * HEAD_DIM, NSA_KV_HEADS * HEAD_DIM,
             3 * NSA_HEADS,
             MLA_Q_RANK, MLA_KV_RANK, MLA_ROPE)
IN_COLS = (3 * SB_HEADS + SWA_HEADS + 2 * SWA_KV_HEADS + NSA_HEADS + 6 * NSA_KV_HEADS) * HEAD_DIM \
    + 3 * NSA_HEADS + MLA_Q_RANK + MLA_KV_RANK + MLA_ROPE
GROUP_WIDTH = 4 * HEAD_DIM
N_GROUPS_MIX = 4
MIX_WIDTH = N_GROUPS_MIX * GROUP_WIDTH

kernel_name = "hymba_style_sb_swa_nsa_mla_hmoe"


def rms_norm(x, g):
    xf = x.astype(jnp.float32)
    y = xf * lax.rsqrt(jnp.mean(xf * xf, axis=-1, keepdims=True) + EPS)
    return (y * g.astype(jnp.float32)).astype(x.dtype)


def t5_bucket(dist):
    n = jnp.maximum(dist, 0)
    max_exact = T5_BUCKETS // 2
    nf = jnp.maximum(n, 1).astype(jnp.float32)
    large = max_exact + (jnp.log(nf / max_exact) / math.log(T5_MAX_DIST / max_exact)
                         * (T5_BUCKETS - max_exact)).astype(jnp.int32)
    large = jnp.minimum(large, T5_BUCKETS - 1)
    return jnp.where(n < max_exact, n, large)


def masked_softmax(logits, mask, sink=None):
    l = jnp.where(mask, logits, NEG)
    m = jnp.max(l, axis=-1, keepdims=True)
    if sink is not None:
        m = jnp.maximum(m, sink)
    p = jnp.where(mask, jnp.exp(l - m), 0.0)
    denom = jnp.sum(p, axis=-1, keepdims=True)
    if sink is not None:
        denom = denom + jnp.exp(sink - m)
    return p / jnp.maximum(denom, 1e-30)


def rope(x, cos, sin):
    half = x.shape[-1] // 2
    xf = x.astype(jnp.float32)
    x1, x2 = xf[..., :half], xf[..., half:]
    c = cos[None, :, None, :]
    s = sin[None, :, None, :]
    return jnp.concatenate([x1 * c - x2 * s, x1 * s + x2 * c], axis=-1).astype(x.dtype)


def stick_breaking_attention(q, k, v):
    B, S, H, d = q.shape
    scale = d ** -0.5
    k_pos = jnp.arange(S)

    def block(i):
        start = i * BLOCK_Q
        qi = lax.dynamic_slice_in_dim(q, start, BLOCK_Q, axis=1)
        q_pos = start + jnp.arange(BLOCK_Q)
        mask = k_pos[None, :] < q_pos[:, None]
        z = jnp.einsum('bqhd,bkhd->bhqk', qi, k).astype(jnp.float32) * scale
        log_keep = jnp.where(mask, jax.nn.log_sigmoid(-z), 0.0)
        after = lax.cumsum(log_keep, axis=3, reverse=True) - log_keep
        a = jnp.where(mask, jnp.exp(jax.nn.log_sigmoid(z) + after), 0.0)
        return jnp.einsum('bhqk,bkhd->bqhd', a.astype(v.dtype), v)

    out = lax.map(block, jnp.arange(S // BLOCK_Q))
    return jnp.moveaxis(out, 0, 1).reshape(B, S, H, d)


def banded_attention(q, k, v, window, bias_tbl, sinks):
    B, S, H, d = q.shape
    Hk = k.shape[2]
    grp = H // Hk
    nprev = -(-(window - 1) // BLOCK_Q)
    pad = nprev * BLOCK_Q
    span = pad + BLOCK_Q
    kp = jnp.pad(k, ((0, 0), (pad, 0), (0, 0), (0, 0)))
    vp = jnp.pad(v, ((0, 0), (pad, 0), (0, 0), (0, 0)))
    qg = q.reshape(B, S, Hk, grp, d)
    tbl = bias_tbl.reshape(Hk, grp, T5_BUCKETS)
    snk = None if sinks is None else sinks.reshape(Hk, grp, 1, 1).astype(jnp.float32)
    scale = d ** -0.5

    def block(i):
        start = i * BLOCK_Q
        qi = lax.dynamic_slice_in_dim(qg, start, BLOCK_Q, axis=1)
        ki = lax.dynamic_slice_in_dim(kp, start, span, axis=1)
        vi = lax.dynamic_slice_in_dim(vp, start, span, axis=1)
        q_pos = start + jnp.arange(BLOCK_Q)
        k_pos = start - pad + jnp.arange(span)
        dist = q_pos[:, None] - k_pos[None, :]
        mask = (dist >= 0) & (dist < window) & (k_pos[None, :] >= 0)
        logits = jnp.einsum('bqhgd,bkhd->bhgqk', qi, ki).astype(jnp.float32) * scale
        logits = logits + tbl[:, :, t5_bucket(dist)].astype(jnp.float32)
        p = masked_softmax(logits, mask, snk)
        return jnp.einsum('bhgqk,bkhd->bqhgd', p.astype(v.dtype), vi)

    out = lax.map(block, jnp.arange(S // BLOCK_Q))
    return jnp.moveaxis(out, 0, 1).reshape(B, S, H, d)


def causal_attention(q, k, v):
    B, S, H, dk = q.shape
    dv = v.shape[-1]
    scale = dk ** -0.5
    k_pos = jnp.arange(S)

    def block(i):
        start = i * BLOCK_Q
        qi = lax.dynamic_slice_in_dim(q, start, BLOCK_Q, axis=1)
        q_pos = start + jnp.arange(BLOCK_Q)
        mask = k_pos[None, :] <= q_pos[:, None]
        logits = jnp.einsum('bqhd,bkhd->bhqk', qi, k).astype(jnp.float32) * scale
        p = masked_softmax(logits, mask)
        return jnp.einsum('bhqk,bkhd->bqhd', p.astype(v.dtype), v)

    out = lax.map(block, jnp.arange(S // BLOCK_Q))
    return jnp.moveaxis(out, 0, 1).reshape(B, S, H, dv)


def nsa_compress(x, pos, w1, w2):
    B, S, Hk, d = x.shape
    n_cat = NSA_CMP_LEN // NSA_CMP_STRIDE
    nb = S // NSA_CMP_STRIDE
    nc = nb - n_cat + 1
    xb = x.reshape(B, nb, NSA_CMP_STRIDE, Hk, d)
    win = jnp.concatenate([xb[:, j:j + nc] for j in range(n_cat)], axis=2)
    win = win + pos[None, None, :, None, :]
    h = jax.nn.gelu(jnp.einsum('bnlhd,ldf->bnhf', win, w1))
    return jnp.einsum('bnhf,fe->bnhe', h, w2)


def nsa_attention(q, k_cmp, v_cmp, k_slc, v_slc, k_win, v_win, gates, bias_tbl):
    B, S, H, d = q.shape
    Hk = k_slc.shape[2]
    grp = H // Hk
    nc = k_cmp.shape[1]
    n_sel = S // NSA_SEL_LEN
    topk = min(NSA_TOPK, n_sel)
    span_sel = topk * NSA_SEL_LEN
    scale = d ** -0.5
    tbl = bias_tbl.reshape(Hk, grp, T5_BUCKETS)
    qg = q.reshape(B, S, Hk, grp, d)
    cmp_start = jnp.arange(nc) * NSA_CMP_STRIDE
    cmp_end = cmp_start + NSA_CMP_LEN - 1
    sel_idx = jnp.arange(n_sel)
    sel_start = sel_idx * NSA_SEL_LEN
    overlap = ((cmp_start[:, None] < sel_start[None, :] + NSA_SEL_LEN)
               & (cmp_end[:, None] >= sel_start[None, :])).astype(jnp.float32)
    ks_blk = k_slc.reshape(B, n_sel, NSA_SEL_LEN, Hk, d).transpose(0, 3, 1, 2, 4)
    vs_blk = v_slc.reshape(B, n_sel, NSA_SEL_LEN, Hk, d).transpose(0, 3, 1, 2, 4)
    b_ix = jnp.arange(B)[:, None, None, None]
    h_ix = jnp.arange(Hk)[None, :, None, None]
    hh = jnp.arange(Hk)[:, None, None, None, None]
    gg = jnp.arange(grp)[None, :, None, None, None]
    tok_off = jnp.arange(NSA_SEL_LEN)

    def block(i):
        start = i * NSA_QBLOCK
        qi = lax.dynamic_slice_in_dim(qg, start, NSA_QBLOCK, axis=1)
        q_pos = start + jnp.arange(NSA_QBLOCK)
        dist_c = q_pos[:, None] - cmp_end[None, :]
        mask_c = dist_c >= 0
        lc = jnp.einsum('bqhgd,bnhd->bhgqn', qi, k_cmp).astype(jnp.float32) * scale
        lc = lc + tbl[:, :, t5_bucket(dist_c)].astype(jnp.float32)
        pc = masked_softmax(lc, mask_c)
        o_c = jnp.einsum('bhgqn,bnhd->bqhgd', pc.astype(v_cmp.dtype), v_cmp)
        imp = jnp.einsum('bhgqn,nj->bhqj', pc, overlap)
        cur = q_pos // NSA_SEL_LEN
        forced = ((sel_idx[None, :] == 0) | (sel_idx[None, :] == cur[:, None])
                  | (sel_idx[None, :] == cur[:, None] - 1))
        valid = sel_start[None, :] <= q_pos[:, None]
        score = jnp.where(valid, imp + jnp.where(forced, FORCE_BONUS, 0.0), NEG)
        _, idx = lax.top_k(score, topk)
        ksel = ks_blk[b_ix, h_ix, idx]
        vsel = vs_blk[b_ix, h_ix, idx]
        key_pos = idx[..., None] * NSA_SEL_LEN + tok_off
        dist_s = q_pos[None, None, :, None, None] - key_pos
        ls = jnp.einsum('bqhgd,bhqkld->bhgqkl', qi, ksel).astype(jnp.float32) * scale
        ls = ls + tbl[hh, gg, t5_bucket(dist_s)[:, :, None]].astype(jnp.float32)
        ls = ls.reshape(B, Hk, grp, NSA_QBLOCK, span_sel)
        mask_s = (dist_s >= 0).reshape(B, Hk, 1, NSA_QBLOCK, span_sel)
        ps = masked_softmax(ls, mask_s)
        o_s = jnp.einsum('bhgqm,bhqmd->bqhgd', ps.astype(v_slc.dtype),
                         vsel.reshape(B, Hk, NSA_QBLOCK, span_sel, d))
        return o_c, o_s

    o_c, o_s = lax.map(block, jnp.arange(S // NSA_QBLOCK))
    o_c = jnp.moveaxis(o_c, 0, 1).reshape(B, S, H, d)
    o_s = jnp.moveaxis(o_s, 0, 1).reshape(B, S, H, d)
    o_w = banded_attention(q, k_win, v_win, NSA_WINDOW, bias_tbl, None)
    return (gates[:, :, 0, :, None] * o_c + gates[:, :, 1, :, None] * o_s
            + gates[:, :, 2, :, None] * o_w)


def mla_attention(c_q, c_kv, k_pe, q_lat_g, w_q_up, kv_lat_g, w_kv_up, q_g, k_g, cos, sin):
    B, S, _ = c_q.shape
    q = (rms_norm(c_q, q_lat_g) @ w_q_up).reshape(B, S, MLA_HEADS, MLA_NOPE + MLA_ROPE)
    kv = (rms_norm(c_kv, kv_lat_g) @ w_kv_up).reshape(B, S, MLA_HEADS, MLA_NOPE + MLA_V)
    k_nope, v = kv[..., :MLA_NOPE], kv[..., MLA_NOPE:]
    k = jnp.concatenate([k_nope, jnp.broadcast_to(k_pe[:, :, None, :], (B, S, MLA_HEADS, MLA_ROPE))], axis=-1)
    q = rms_norm(q, q_g)
    k = rms_norm(k, k_g)
    q = jnp.concatenate([q[..., :MLA_NOPE], rope(q[..., MLA_NOPE:], cos, sin)], axis=-1)
    k = jnp.concatenate([k[..., :MLA_NOPE], rope(k[..., MLA_NOPE:], cos, sin)], axis=-1)
    return causal_attention(q, k, v)


def mixer(h, rel_bias, cos, sin, w_in, swa_q_norm, swa_k_norm, swa_sinks, nsa_q_norm,
          nsa_k_norm, nsa_cmp_pos, nsa_cmp_w1, nsa_cmp_w2, mla_q_lat_norm, mla_w_q_up,
          mla_kv_lat_norm, mla_w_kv_up, mla_q_norm, mla_k_norm, out_norm, w_out):
    B, S, _ = h.shape
    proj = h @ w_in
    parts = []
    off = 0
    for n in IN_SPLITS:
        parts.append(proj[..., off:off + n])
        off += n
    (sb_q, sb_k, sb_v, swa_q, swa_k, swa_v, nsa_q, nsa_kc, nsa_vc, nsa_ks, nsa_vs,
     nsa_kw, nsa_vw, nsa_g, mla_cq, mla_ckv, mla_kpe) = parts

    def heads(t):
        return t.reshape(B, S, -1, HEAD_DIM)

    o_a = stick_breaking_attention(heads(sb_q), heads(sb_k), heads(sb_v))
    o_b = banded_attention(rms_norm(heads(swa_q), swa_q_norm), rms_norm(heads(swa_k), swa_k_norm),
                           heads(swa_v), SWA_WINDOW, rel_bias[:, :SWA_HEADS].T, swa_sinks)
    k_cmp = rms_norm(nsa_compress(heads(nsa_kc), nsa_cmp_pos[0], nsa_cmp_w1[0], nsa_cmp_w2[0]), nsa_k_norm[0])
    v_cmp = nsa_compress(heads(nsa_vc), nsa_cmp_pos[1], nsa_cmp_w1[1], nsa_cmp_w2[1])
    gates = jax.nn.sigmoid(nsa_g.reshape(B, S, 3, NSA_HEADS))
    o_c = nsa_attention(rms_norm(heads(nsa_q), nsa_q_norm), k_cmp, v_cmp,
                        rms_norm(heads(nsa_ks), nsa_k_norm[1]), heads(nsa_vs),
                        rms_norm(heads(nsa_kw), nsa_k_norm[2]), heads(nsa_vw),
                        gates, rel_bias[:, SWA_HEADS:].T)
    o_d = mla_attention(mla_cq, mla_ckv, mla_kpe, mla_q_lat_norm, mla_w_q_up, mla_kv_lat_norm,
                        mla_w_kv_up, mla_q_norm, mla_k_norm, cos, sin)
    o = jnp.stack([o_a.reshape(B, S, GROUP_WIDTH), o_b.reshape(B, S, GROUP_WIDTH),
                   o_c.reshape(B, S, GROUP_WIDTH), o_d.reshape(B, S, GROUP_WIDTH)], axis=2)
    o = rms_norm(o, out_norm.reshape(N_GROUPS_MIX, GROUP_WIDTH)).reshape(B, S, MIX_WIDTH)
    return o @ w_out


def hier_moe(h, w_group, b_group, w_expert, b_expert, w_gate, w_up, w_down):
    B, S, D = h.shape
    t = h.reshape(B * S, D)
    g_logits = (t @ w_group).astype(jnp.float32) + b_group.astype(jnp.float32)
    g_prob = jax.nn.softmax(g_logits, axis=-1)
    g_star = jnp.argmax(g_logits, axis=-1)
    g_w = jnp.max(g_prob, axis=-1, keepdims=True)
    e_logits = ((t @ w_expert).astype(jnp.float32) + b_expert.astype(jnp.float32)
                ).reshape(-1, MOE_GROUPS, MOE_EXPERTS_PER_GROUP)
    e_in = e_logits[jnp.arange(t.shape[0]), g_star]
    e_prob = jax.nn.softmax(e_in, axis=-1)
    top_p, top_i = lax.top_k(e_prob, MOE_TOPK)
    top_w = top_p / jnp.sum(top_p, axis=-1, keepdims=True) * g_w
    expert_id = g_star[:, None] * MOE_EXPERTS_PER_GROUP + top_i
    combine = jnp.sum(jax.nn.one_hot(expert_id, MOE_EXPERTS, dtype=jnp.float32)
                      * top_w[..., None], axis=1).astype(t.dtype)
    y = jnp.zeros_like(t)
    for e in range(MOE_EXPERTS):
        a = jax.nn.silu(t @ w_gate[e]) * (t @ w_up[e])
        y = y + combine[:, e:e + 1] * (a @ w_down[e])
    return y.reshape(B, S, D)


def setup_inputs(seed: int = 0) -> dict:
    key = jax.random.key(seed)
    ks = jax.random.split(key, 28)
    f32 = jnp.float32
    L = DEPTH

    def nrm(k, shape, scale):
        return jax.random.normal(k, shape, f32) * scale

    def gain(k, shape):
        return 1.0 + 0.02 * jax.random.normal(k, shape, f32)

    return {
        "x": nrm(ks[0], (BATCH, SEQ, D_MODEL), 1.0),
        "rel_bias": nrm(ks[1], (T5_BUCKETS, N_BIAS_HEADS), 0.5),
        "attn_norm": gain(ks[2], (L, D_MODEL)),
        "w_in": nrm(ks[3], (L, D_MODEL, IN_COLS), D_MODEL ** -0.5),
        "swa_q_norm": gain(ks[4], (L, HEAD_DIM)),
        "swa_k_norm": gain(ks[5], (L, HEAD_DIM)),
        "swa_sinks": nrm(ks[6], (L, SWA_HEADS), 0.5),
        "nsa_q_norm": gain(ks[7], (L, HEAD_DIM)),
        "nsa_k_norm": gain(ks[8], (L, 3, HEAD_DIM)),
        "nsa_cmp_pos": nrm(ks[9], (L, 2, NSA_CMP_LEN, HEAD_DIM), 0.1),
        "nsa_cmp_w1": nrm(ks[10], (L, 2, NSA_CMP_LEN, HEAD_DIM, NSA_CMP_HIDDEN), (NSA_CMP_LEN * HEAD_DIM) ** -0.5),
        "nsa_cmp_w2": nrm(ks[11], (L, 2, NSA_CMP_HIDDEN, HEAD_DIM), NSA_CMP_HIDDEN ** -0.5),
        "mla_q_lat_norm": gain(ks[12], (L, MLA_Q_RANK)),
        "mla_w_q_up": nrm(ks[13], (L, MLA_Q_RANK, MLA_HEADS * (MLA_NOPE + MLA_ROPE)), MLA_Q_RANK ** -0.5),
        "mla_kv_lat_norm": gain(ks[14], (L, MLA_KV_RANK)),
        "mla_w_kv_up": nrm(ks[15], (L, MLA_KV_RANK, MLA_HEADS * (MLA_NOPE + MLA_V)), MLA_KV_RANK ** -0.5),
        "mla_q_norm": gain(ks[16], (L, MLA_NOPE + MLA_ROPE)),
        "mla_k_norm": gain(ks[17], (L, MLA_NOPE + MLA_ROPE)),
        "out_norm": gain(ks[18], (L, MIX_WIDTH)),
        "w_out": nrm(ks[19], (L, MIX_WIDTH, D_MODEL), MIX_WIDTH ** -0.5),
        "ffn_norm": gain(ks[20], (L, D_MODEL)),
        "moe_w_group": nrm(ks[21], (L, D_MODEL, MOE_GROUPS), D_MODEL ** -0.5),
        "moe_b_group": nrm(ks[22], (L, MOE_GROUPS), 0.01),
        "moe_w_expert": nrm(ks[23], (L, D_MODEL, MOE_EXPERTS), D_MODEL ** -0.5),
        "moe_b_expert": nrm(ks[24], (L, MOE_EXPERTS), 0.01),
        "moe_w_gate": nrm(ks[25], (L, MOE_EXPERTS, D_MODEL, MOE_HIDDEN), D_MODEL ** -0.5),
        "moe_w_up": nrm(ks[26], (L, MOE_EXPERTS, D_MODEL, MOE_HIDDEN), D_MODEL ** -0.5),
        "moe_w_down": nrm(ks[27], (L, MOE_EXPERTS, MOE_HIDDEN, D_MODEL), MOE_HIDDEN ** -0.5),
    }


def reference(x, rel_bias, attn_norm, w_in, swa_q_norm, swa_k_norm, swa_sinks, nsa_q_norm,
              nsa_k_norm, nsa_cmp_pos, nsa_cmp_w1, nsa_cmp_w2, mla_q_lat_norm, mla_w_q_up,
              mla_kv_lat_norm, mla_w_kv_up, mla_q_norm, mla_k_norm, out_norm, w_out, ffn_norm,
              moe_w_group, moe_b_group, moe_w_expert, moe_b_expert, moe_w_gate, moe_w_up,
              moe_w_down):
    S = x.shape[1]
    pos = jnp.arange(S, dtype=jnp.float32)
    inv_freq = ROPE_THETA ** (-jnp.arange(0, MLA_ROPE, 2, dtype=jnp.float32) / MLA_ROPE)
    ang = pos[:, None] * inv_freq[None, :]
    cos, sin = jnp.cos(ang), jnp.sin(ang)
    for l in range(DEPTH):
        h = rms_norm(x, attn_norm[l])
        x = x + mixer(h, rel_bias, cos, sin, w_in[l], swa_q_norm[l], swa_k_norm[l], swa_sinks[l],
                      nsa_q_norm[l], nsa_k_norm[l], nsa_cmp_pos[l], nsa_cmp_w1[l], nsa_cmp_w2[l],
                      mla_q_lat_norm[l], mla_w_q_up[l], mla_kv_lat_norm[l], mla_w_kv_up[l],
                      mla_q_norm[l], mla_k_norm[l], out_norm[l], w_out[l])
        h = rms_norm(x, ffn_norm[l])
        x = x + hier_moe(h, moe_w_group[l], moe_b_group[l], moe_w_expert[l], moe_b_expert[l],
                         moe_w_gate[l], moe_w_up[l], moe_w_down[l])
    return x
```

```cpp
#include <hip/hip_runtime.h>
#include <hip/hip_bf16.h>
#include <stdint.h>
#include <stdio.h>

#ifndef MK_LAUNCHES
#define MK_LAUNCHES 1
#endif

#define DEV __device__ __forceinline__
#define GAS __attribute__((address_space(1)))
#define LAS __attribute__((address_space(3)))

typedef unsigned short bf16_t;
typedef __attribute__((ext_vector_type(8))) short bf16x8;
typedef __attribute__((ext_vector_type(4))) short s16x4;
typedef short v4i16_t __attribute__((ext_vector_type(4)));
typedef __attribute__((ext_vector_type(16))) float f32x16;
typedef __attribute__((ext_vector_type(4))) float f32x4;
typedef __attribute__((ext_vector_type(2))) float f32x2_t;
typedef __attribute__((ext_vector_type(2))) __bf16 bf16x2_t;
typedef __attribute__((ext_vector_type(4))) unsigned u4;
typedef __attribute__((ext_vector_type(2))) unsigned u2;

constexpr int B_ = 8, S_ = 8192, T_ = B_ * S_, D_ = 1024, L_ = 2;
constexpr int INC = 2668;
constexpr int PLD = 2688;
constexpr int C_SBQ = 0, C_SBK = 256, C_SBV = 512, C_SWQ = 768, C_SWK = 1024, C_SWV = 1152, C_NQ = 1280, C_NKC = 1536, C_NVC = 1664,
              C_NKS = 1792, C_NVS = 1920, C_NKW = 2048, C_NVW = 2176, C_CQ = 2304, C_CKV = 2496, C_KPE = 2624, C_NG = 2656;
constexpr float EPS = 1e-6f;
constexpr float LOG2E = 1.4426950408889634f;
constexpr int NPAIR = 112;

constexpr size_t MiB = 1048576;
constexpr size_t WS_CTL = 0;
constexpr size_t CTL_BYTES = 65536;
constexpr int CW_BAR = 0;
constexpr int CW_ATTQ = 4096;
constexpr int CW_CNTE = 4224;
constexpr int CW_CNTP = 4352;
constexpr int CW_VMAX = 4608;
constexpr int CW_NSAF = 8192;
constexpr size_t W_WIN = 1 * MiB;   static_assert(CTL_BYTES <= MiB, "control region");
constexpr size_t W_WOUT = W_WIN + (size_t)L_ * PLD * 1024 * 2;
constexpr size_t W_QUP = W_WOUT + (size_t)L_ * 1024 * 1024 * 2;
constexpr size_t W_KVUP = W_QUP + (size_t)L_ * 384 * 192 * 2;
constexpr size_t W_C1 = W_KVUP + (size_t)L_ * 512 * 128 * 2;
constexpr size_t W_C2 = W_C1 + (size_t)L_ * 2 * 128 * 2048 * 2;
constexpr size_t W_B1 = W_C2 + (size_t)L_ * 2 * 128 * 128 * 2;
constexpr size_t W_R = W_B1 + (size_t)L_ * 2 * 128 * 4;
constexpr size_t W_GU = W_R + (size_t)L_ * 48 * 1024 * 4;
constexpr size_t W_DN = W_GU + (size_t)L_ * 32 * 512 * 1024 * 2;
constexpr size_t W_LUT = W_DN + (size_t)L_ * 32 * 1024 * 256 * 2;
constexpr size_t W_ROPE = W_LUT + 8 * 1024 * 4;
constexpr size_t W_MLAB = W_ROPE + (size_t)S_ * 16 * 2 * 4;
constexpr size_t W_END = W_MLAB + 256;
static_assert(W_END <= 124 * MiB, "weights region");
constexpr size_t R_X = 124 * MiB;
constexpr size_t X_XB = R_X;
constexpr size_t R_Q = R_X + 128 * MiB;
constexpr size_t X_QSB = R_Q;
constexpr size_t X_KSB = R_Q + 32 * MiB;
constexpr size_t X_VSB = R_Q + 64 * MiB;
constexpr size_t X_QSW = R_Q + 96 * MiB;
constexpr size_t R_P = R_Q + 128 * MiB;
constexpr size_t P_PROJ = R_P;
constexpr size_t P_QRAW = R_P;
constexpr size_t P_KVRAW = R_P + 48 * MiB;
constexpr size_t P_ORAW = R_P + 112 * MiB;
constexpr size_t A_QM = R_P + 240 * MiB;
constexpr size_t A_KM = R_P + 288 * MiB;
constexpr size_t R_A = R_P + 336 * MiB;
constexpr size_t A_KSW = R_A;
constexpr size_t A_VSW = R_A + 16 * MiB;
constexpr size_t A_QN = R_A + 32 * MiB;
constexpr size_t A_KNS = R_A + 64 * MiB;
constexpr size_t A_VNS = R_A + 80 * MiB;
constexpr size_t A_KNW = R_A + 96 * MiB;
constexpr size_t A_VNW = R_A + 112 * MiB;
constexpr size_t A_CQN = R_A + 128 * MiB;
constexpr size_t A_CKVN = R_A + 152 * MiB;
constexpr size_t A_KPE = R_A + 168 * MiB;
constexpr size_t A_VM = R_A + 172 * MiB;
constexpr size_t A_XC = R_A + 204 * MiB;
constexpr size_t A_GATES = R_A + 236 * MiB;
constexpr size_t A_KC = R_A + 239 * MiB;
constexpr size_t A_VC = R_A + 240 * MiB;
constexpr size_t A_H1 = R_A + 241 * MiB;
constexpr size_t A_END = R_A + 245 * MiB;
constexpr size_t M_ABUF = R_A;
constexpr size_t M_LISTE = R_A + 64 * MiB;
constexpr size_t M_LISTP = R_A + 72 * MiB;
constexpr size_t M_WSLOT = R_A + 100 * MiB;
constexpr size_t M_RSTD2 = R_A + 101 * MiB;
constexpr size_t R_MISC = A_END;
constexpr size_t MS_RSTD1 = R_MISC;
constexpr size_t MS_SELM = R_MISC + 1 * MiB;
constexpr size_t MS_UNM = R_MISC + 3 * MiB;
constexpr size_t MS_SSQP = R_MISC + 3 * MiB + 262144;
constexpr size_t WS_END = R_MISC + 5 * MiB;
static_assert(WS_END <= 1024 * MiB, "workspace");

DEV unsigned cvtpk(float lo, float hi) { f32x2_t v = {lo, hi}; bf16x2_t b = __builtin_convertvector(v, bf16x2_t); return __builtin_bit_cast(unsigned, b); }
DEV float bflo(unsigned u) { return __uint_as_float(u << 16); }
DEV float bfhi(unsigned u) { return __uint_as_float(u & 0xffff0000u); }
DEV u4 gld16(const void* p) { return *(const GAS u4*)p; }
DEV void gst16(void* p, u4 v) { *(GAS u4*)p = v; }
DEV u2 gld8(const void* p) { return *(const GAS u2*)p; }
DEV void gst8(void* p, u2 v) { *(GAS u2*)p = v; }
DEV float gldf(const void* p) { return *(const GAS float*)p; }
DEV int crow(int r, int hi) { return (r & 3) + 8 * (r >> 2) + 4 * hi; }
DEV float fexp2(float x) { return __builtin_amdgcn_exp2f(x); }
DEV float frcp(float x) { return __builtin_amdgcn_rcpf(x); }
DEV float hsum(float v) { auto rr = __builtin_amdgcn_permlane32_swap(__float_as_uint(v), __float_as_uint(v), false, false); return __uint_as_float(rr[0]) + __uint_as_float(rr[1]); }
DEV float hmax(float v) { auto rr = __builtin_amdgcn_permlane32_swap(__float_as_uint(v), __float_as_uint(v), false, false); return __builtin_fmaxf(__uint_as_float(rr[0]), __uint_as_float(rr[1])); }
DEV float hother(float v, int hi) { auto rr = __builtin_amdgcn_permlane32_swap(__float_as_uint(v), __float_as_uint(v), false, false); return __uint_as_float(hi ? rr[0] : rr[1]); }
DEV unsigned hother_u(unsigned v, int hi) { auto rr = __builtin_amdgcn_permlane32_swap(v, v, false, false); return hi ? rr[0] : rr[1]; }
#define MFMA32(a, b, c) __builtin_amdgcn_mfma_f32_32x32x16_bf16(a, b, c, 0, 0, 0)

extern __shared__ __attribute__((aligned(16))) char smem[];
#define LDS_U4(off) (*(LAS u4*)((LAS char*)smem + (off)))
#define LDS_U2(off) (*(LAS u2*)((LAS char*)smem + (off)))
#define LDS_F(off) (*(LAS float*)((LAS char*)smem + (off)))
#define LDS_I(off) (*(LAS int*)((LAS char*)smem + (off)))
#define LDS_U(off) (*(LAS unsigned*)((LAS char*)smem + (off)))
#define LDS_BF8(off) (*(LAS bf16x8*)((LAS char*)smem + (off)))
DEV s16x4 lds_tr(unsigned off) { return __builtin_bit_cast(s16x4, __builtin_amdgcn_ds_read_tr16_b64_v4i16((LAS v4i16_t*)((LAS char*)smem + off))); }

constexpr int LDS_PH = 1024;
constexpr int LDS_BYTES = 155648;
constexpr int LDS_SCHED = LDS_PH + 147456, LDS_EPI = LDS_SCHED + 512;

#define XB_TMO      128
#define XB_XCNT(j)  (256  + 64 * (j))
#define XB_XSUB(j)  (1280 + 64 * (j))
#define XB_XGEN(j)  (2304 + 64 * (j))
#define XB_TOP      3328
#define XB_TOPGEN   3392
#define XCD_BAR_WORDS 3456
#define XB_SPIN_CAP (1u << 22)
DEV unsigned xb_ld(unsigned* p)              { return __hip_atomic_load(p, __ATOMIC_RELAXED, __HIP_MEMORY_SCOPE_AGENT); }
DEV unsigned xb_add(unsigned* p, unsigned v) { return __hip_atomic_fetch_add(p, v, __ATOMIC_RELAXED, __HIP_MEMORY_SCOPE_AGENT); }
DEV unsigned xb_xcc_id() { return (unsigned)__builtin_amdgcn_s_getreg((3 << 11) | 20) & 0xFu; }
#define XB_SPIN(cond, bar) do { unsigned _sp = 0; while (cond) { __builtin_amdgcn_s_sleep(1); \
    if ((++_sp & 255u) == 0u) { if (xb_ld(&(bar)[XB_TMO])) break; if (_sp > XB_SPIN_CAP) { atomicAdd(&(bar)[XB_TMO], 1u); break; } } } } while (0)
struct XcdBarrier { unsigned* bar; unsigned x; volatile LAS unsigned* st; };
DEV XcdBarrier xcd_barrier_post(unsigned* bar, volatile LAS unsigned* st) {
    XcdBarrier b; b.bar = bar; b.x = xb_xcc_id(); b.st = st;
    if (threadIdx.x == 0) (void)xb_add(&bar[XB_XCNT(b.x)], 1u);
    return b;
}
DEV void xcd_barrier_complete(unsigned* bar, unsigned x, unsigned& nloc, unsigned& nx) {
    const unsigned G = gridDim.x * gridDim.y * gridDim.z;
    unsigned sum, cnt, mine, sp = 0u;
    for (;;) {
        sum = 0u; cnt = 0u; mine = 0u;
#pragma unroll
        for (unsigned j = 0; j < 16; ++j) { const unsigned c = xb_ld(&bar[XB_XCNT(j)]); sum += c; cnt += (c > 0u) ? 1u : 0u; mine = (j == x) ? c : mine; }
        if (sum == G) break;
        __builtin_amdgcn_s_sleep(1);
        if ((++sp & 255u) == 0u) { if (xb_ld(&bar[XB_TMO])) break; if (sp > XB_SPIN_CAP) { atomicAdd(&bar[XB_TMO], 1u); break; } }
    }
    nloc = mine > 0u ? mine : 1u; nx = cnt > 0u ? cnt : 1u;
}
DEV void xcd_barrier(const XcdBarrier& b) {
    asm volatile("s_waitcnt vmcnt(0)" ::: "memory");
    __syncthreads();
    if (threadIdx.x == 0) {
        unsigned* bar = b.bar;
        __builtin_amdgcn_s_waitcnt(0);
        unsigned nloc = b.st[0], nx = b.st[1];
        if (nloc == 0u) { xcd_barrier_complete(bar, b.x, nloc, nx); b.st[0] = nloc; b.st[1] = nx; }
        const unsigned old = xb_add(&bar[XB_XSUB(b.x)], 1u);
        const unsigned gen = old / nloc;
        if (old + 1u == (gen + 1u) * nloc) {
            __builtin_amdgcn_fence(__ATOMIC_RELEASE, "agent");
            asm volatile("s_waitcnt vmcnt(0)" ::: "memory");
            const unsigned og = xb_add(&bar[XB_TOP], 1u);
            const unsigned tg = og / nx;
            if (og + 1u == (tg + 1u) * nx) xb_add(&bar[XB_TOPGEN], 1u);
            else XB_SPIN(xb_ld(&bar[XB_TOPGEN]) == tg, bar);
            __builtin_amdgcn_fence(__ATOMIC_ACQUIRE, "agent");
            xb_add(&bar[XB_XGEN(b.x)], 1u);
            asm volatile("s_waitcnt vmcnt(0)" ::: "memory");
        } else {
            XB_SPIN(xb_ld(&bar[XB_XGEN(b.x)]) == gen, bar);
            __builtin_amdgcn_fence(__ATOMIC_ACQUIRE, "agent");
            asm volatile("s_waitcnt vmcnt(0)" ::: "memory");
        }
    }
    __syncthreads();
}

struct Args {
    const float* in[28];
    float* out;
    unsigned char* ws;
    int ph_lo, ph_hi;
};

template <class F> DEV void xpose64(const F& f, int k0, int n0, bf16_t* dst, long dld, int slot, int half, float (&rg)[8]) {
    const int tid = threadIdx.x; const unsigned base = LDS_PH + slot * (64 * 65 * 4);
    if (half == 0) {
#pragma unroll
        for (int r = 0; r < 2; ++r) { const int idx = tid + 512 * r, i = idx >> 4, j4 = (idx & 15) * 4; float o4[4]; f.ld4(k0 + i, n0 + j4, o4); rg[4 * r] = o4[0]; rg[4 * r + 1] = o4[1]; rg[4 * r + 2] = o4[2]; rg[4 * r + 3] = o4[3]; }
    } else if (half == 2) {
#pragma unroll
        for (int r = 0; r < 2; ++r) { const int idx = tid + 512 * r, i = idx >> 4, j4 = (idx & 15) * 4;
#pragma unroll
            for (int e = 0; e < 4; ++e) LDS_F(base + (i * 65 + j4 + e) * 4) = rg[4 * r + e]; }
    } else {
        const int j = tid >> 3, ch = tid & 7; float v[8];
#pragma unroll
        for (int e = 0; e < 8; ++e) v[e] = LDS_F(base + ((ch * 8 + e) * 65 + j) * 4);
        u4 o; o.x = cvtpk(v[0], v[1]); o.y = cvtpk(v[2], v[3]); o.z = cvtpk(v[4], v[5]); o.w = cvtpk(v[6], v[7]);
        gst16(dst + (long)(n0 + j) * dld + k0 + ch * 8, o);
    }
}
struct FWin { const float* w; const float* g; DEV float operator()(int k, int n) const {
    const int oc = n < 2304 ? n : (n < 2656 ? n + 12 : (n < 2668 ? n - 352 : -1));
    return oc < 0 ? 0.f : gldf(g + k) * gldf(w + (long)k * INC + oc); }
    DEV void ld4(int k, int n, float (&o)[4]) const {
        const int oc = n < 2304 ? n : (n < 2656 ? n + 12 : (n < 2668 ? n - 352 : -1)); u4 v = {0u, 0u, 0u, 0u}; float gk = 0.f;
        if (oc >= 0) { v = gld16(w + (long)k * INC + oc); gk = gldf(g + k); }
        o[0] = gk * __uint_as_float(v.x); o[1] = gk * __uint_as_float(v.y); o[2] = gk * __uint_as_float(v.z); o[3] = gk * __uint_as_float(v.w); } };
struct FScaled { const float* w; const float* g; int ld; DEV float operator()(int k, int n) const { return gldf(g + k) * gldf(w + (long)k * ld + n); }
    DEV void ld4(int k, int n, float (&o)[4]) const { const u4 v = gld16(w + (long)k * ld + n); const float gk = gldf(g + k);
        o[0] = gk * __uint_as_float(v.x); o[1] = gk * __uint_as_float(v.y); o[2] = gk * __uint_as_float(v.z); o[3] = gk * __uint_as_float(v.w); } };
struct FPlain { const float* w; int ld; DEV float operator()(int k, int n) const { return gldf(w + (long)k * ld + n); }
    DEV void ld4(int k, int n, float (&o)[4]) const { const u4 v = gld16(w + (long)k * ld + n); o[0] = __uint_as_float(v.x); o[1] = __uint_as_float(v.y); o[2] = __uint_as_float(v.z); o[3] = __uint_as_float(v.w); } };
struct FC2 { const float* w; DEV float operator()(int k, int n) const { return n < 64 ? gldf(w + k * 64 + n) : 0.f; }
    DEV void ld4(int k, int n, float (&o)[4]) const { u4 v = {0u, 0u, 0u, 0u}; if (n < 64) v = gld16(w + k * 64 + n); o[0] = __uint_as_float(v.x); o[1] = __uint_as_float(v.y); o[2] = __uint_as_float(v.z); o[3] = __uint_as_float(v.w); } };
struct FGU { const float* wg; const float* wu; const float* g; DEV float operator()(int k, int n) const {
    const int j = 32 * (n >> 6) + (n & 31); const float* w = (const float*)((uintptr_t)wg + (uintptr_t)((n >> 5) & 1) * ((uintptr_t)wu - (uintptr_t)wg)); return gldf(g + k) * gldf(w + (long)k * 256 + j); }
    DEV void ld4(int k, int n, float (&o)[4]) const {
        const int j = 32 * (n >> 6) + (n & 31); const float* w = (const float*)((uintptr_t)wg + (uintptr_t)((n >> 5) & 1) * ((uintptr_t)wu - (uintptr_t)wg)); const u4 v = gld16(w + (long)k * 256 + j); const float gk = gldf(g + k);
        o[0] = gk * __uint_as_float(v.x); o[1] = gk * __uint_as_float(v.y); o[2] = gk * __uint_as_float(v.z); o[3] = gk * __uint_as_float(v.w); } };

__constant__ float c_invf[16] = {1.0f, 0.5623413324356079f, 0.3162277638912201f, 0.17782793939113617f, 0.10000000149011612f, 0.05623413249850273f,
    0.03162277489900589f, 0.017782794311642647f, 0.009999999776482582f, 0.005623413249850273f, 0.003162277629598975f, 0.0017782794311642647f,
    0.0010000000474974513f, 0.000562341301701963f, 0.0003162277571391314f, 0.00017782794020604342f};
DEV int t5_bucket(int n) {
    if (n < 16) return n;
    int b = 16;
    b += (n >= 21) + (n >= 27) + (n >= 35) + (n >= 46) + (n >= 59) + (n >= 77) + (n >= 99) + (n >= 128) + (n >= 166) + (n >= 216) + (n >= 280) + (n >= 363) + (n >= 470) + (n >= 609) + (n >= 790);
    return b;
}

namespace p0c {
constexpr int N_WIN = L_ * 16 * 42, N_WOUT = L_ * 256, N_QUP = L_ * 18, N_KVUP = L_ * 16, N_C1 = L_ * 2 * 64, N_C2 = L_ * 2 * 4, N_GU = L_ * 32 * 128, N_DN = L_ * 32 * 64;
constexpr int O1 = N_WIN, O2 = O1 + N_WOUT, O3 = O2 + N_QUP, O4 = O3 + N_KVUP, O5 = O4 + N_C1, O6 = O5 + N_C2, O7 = O6 + N_GU, O8 = O7 + N_DN;
}
DEV void p0_tile(const Args& a, int t, int u, int half, float (&rg)[8]) {
    using namespace p0c; unsigned char* ws = a.ws;
        if (t < O1) { const int l = t / 672, r = t % 672, kt = r / 42, nt = r % 42;
            FWin f{a.in[3] + (long)l * 1024 * INC, a.in[2] + l * 1024}; xpose64(f, kt * 64, nt * 64, (bf16_t*)(ws + W_WIN) + (long)l * PLD * 1024, 1024, u, half, rg);
        } else if (t < O2) { const int u2 = t - O1, l = u2 / 256, r = u2 % 256, kt = r / 16, nt = r % 16;
            FScaled f{a.in[19] + (long)l * 1048576, a.in[18] + l * 1024, 1024}; xpose64(f, kt * 64, nt * 64, (bf16_t*)(ws + W_WOUT) + (long)l * 1048576, 1024, u, half, rg);
        } else if (t < O3) { const int u2 = t - O2, l = u2 / 18, r = u2 % 18, kt = r / 6, nt = r % 6;
            FScaled f{a.in[13] + (long)l * 192 * 384, a.in[12] + l * 192, 384}; xpose64(f, kt * 64, nt * 64, (bf16_t*)(ws + W_QUP) + (long)l * 384 * 192, 192, u, half, rg);
        } else if (t < O4) { const int u2 = t - O3, l = u2 / 16, r = u2 % 16, kt = r / 8, nt = r % 8;
            FScaled f{a.in[15] + (long)l * 128 * 512, a.in[14] + l * 128, 512}; xpose64(f, kt * 64, nt * 64, (bf16_t*)(ws + W_KVUP) + (long)l * 512 * 128, 128, u, half, rg);
        } else if (t < O5) { const int u2 = t - O4, lw = u2 / 64, r = u2 % 64, kt = r / 2, nt = r % 2;
            FPlain f{a.in[10] + (long)lw * 2048 * 128, 128}; xpose64(f, kt * 64, nt * 64, (bf16_t*)(ws + W_C1) + (long)lw * 128 * 2048, 2048, u, half, rg);
        } else if (t < O6) { const int u2 = t - O5, lw = u2 / 4, r = u2 % 4, kt = r / 2, nt = r % 2;
            FC2 f{a.in[11] + (long)lw * 128 * 64}; xpose64(f, kt * 64, nt * 64, (bf16_t*)(ws + W_C2) + (long)lw * 128 * 128, 128, u, half, rg);
        } else if (t < O7) { const int u2 = t - O6, le = u2 / 128, r = u2 % 128, kt = r / 8, nt = r % 8;
            FGU f{a.in[25] + (long)le * 262144, a.in[26] + (long)le * 262144, a.in[20] + (le / 32) * 1024}; xpose64(f, kt * 64, nt * 64, (bf16_t*)(ws + W_GU) + (long)le * 524288, 1024, u, half, rg);
        } else { const int u2 = t - O7, le = u2 / 64, r = u2 % 64, kt = r / 16, nt = r % 16;
            FPlain f{a.in[27] + (long)le * 262144, 1024}; xpose64(f, kt * 64, nt * 64, (bf16_t*)(ws + W_DN) + (long)le * 262144, 256, u, half, rg);
        }
}
DEV void phase_p0(const Args& a) {
    using namespace p0c; unsigned char* ws = a.ws;
    {
        float rg[6][8]; const int tstep = (int)gridDim.x * 6;
        int t0 = (int)blockIdx.x * 6;
#pragma unroll
        for (int u = 0; u < 6; ++u) if (t0 + u < O8) p0_tile(a, t0 + u, u, 0, rg[u]);
        for (; t0 < O8; t0 += tstep) {
#pragma unroll
            for (int u = 0; u < 6; ++u) if (t0 + u < O8) p0_tile(a, t0 + u, u, 2, rg[u]);
            __syncthreads();
            const int t1 = t0 + tstep;
#pragma unroll
            for (int u = 0; u < 6; ++u) if (t1 + u < O8) p0_tile(a, t1 + u, u, 0, rg[u]);
#pragma unroll
            for (int u = 0; u < 6; ++u) if (t0 + u < O8) p0_tile(a, t0 + u, u, 1, rg[u]);
            __syncthreads();
        }
    }
    const int gtid = blockIdx.x * 512 + threadIdx.x, gsz = gridDim.x * 512;
    for (int i = gtid; i < L_ * 2 * 128; i += gsz) {
        const int lw = i >> 7, f = i & 127; const float* pos = a.in[9] + (long)lw * 2048; const float* w1 = a.in[10] + (long)lw * 2048 * 128;
        float s = 0.f; for (int k = 0; k < 2048; ++k) s += gldf(pos + k) * gldf(w1 + (long)k * 128 + f);
        ((float*)(ws + W_B1))[i] = s;
    }
    for (int i = gtid; i < L_ * 48 * 1024; i += gsz) {
        const int l = i / 49152, r = i % 49152, j = r >> 10, k = r & 1023;
        float v = 0.f; if (j < 4) v = gldf(a.in[21] + (long)l * 4096 + k * 4 + j); else if (j < 36) v = gldf(a.in[23] + (long)l * 32768 + k * 32 + (j - 4));
        ((float*)(ws + W_R))[i] = v * gldf(a.in[20] + l * 1024 + k);
    }
    for (int i = gtid; i < L_; i += gsz) {
        float gq = 0.f, gk = 0.f; for (int j = 0; j < 96; ++j) { gq = __builtin_fmaxf(gq, __builtin_fabsf(gldf(a.in[16] + i * 96 + j))); gk = __builtin_fmaxf(gk, __builtin_fabsf(gldf(a.in[17] + i * 96 + j))); }
        ((float*)(ws + W_MLAB))[i] = 96.f * gq * gk * (0.10206207261596577f * LOG2E) * 1.02f + 0.1f; }
    for (int i = gtid; i < L_ * 12; i += gsz) {
        const int l = i / 12, kind = (i % 12) >> 2, h = i & 3, hb = kind == 2 ? h : 4 + h;
        const float* sq = kind == 2 ? a.in[4] + l * 64 : a.in[7] + l * 64; const float* sk = kind == 2 ? a.in[5] + l * 64 : a.in[8] + (l * 3 + (kind == 0 ? 0 : 2)) * 64;
        float gq = 0.f, gk = 0.f; for (int j = 0; j < 64; ++j) { gq = __builtin_fmaxf(gq, __builtin_fabsf(gldf(sq + j))); gk = __builtin_fmaxf(gk, __builtin_fabsf(gldf(sk + j))); }
        float bmx = gldf(a.in[1] + hb), bmn = bmx; for (int k = 1; k < 32; ++k) { const float v = gldf(a.in[1] + k * 8 + hb); bmx = __builtin_fmaxf(bmx, v); bmn = __builtin_fminf(bmn, v); }
        const float qk = 8.f * gq * gk * 1.02f + 0.01f; const float hiB = (qk + bmx) * LOG2E, loB = (-qk + bmn) * LOG2E;
        ((float*)(ws + W_MLAB))[16 + l * 32 + kind * 8 + h] = (hiB - loB <= 120.f) ? hiB : 1e30f; }
    for (int i = gtid; i < 8 * 1024; i += gsz) { const int h = i >> 10, d = i & 1023; ((float*)(ws + W_LUT))[i] = gldf(a.in[1] + t5_bucket(d) * 8 + h) * LOG2E; }
    for (int i = gtid; i < S_ * 16; i += gsz) { const int s = i >> 4, f = i & 15;
        const float ang = (float)s * c_invf[f]; double rev = (double)ang * 0.15915494309189535; rev -= __builtin_rint(rev);
        const float rv = (float)rev; ((float*)(ws + W_ROPE))[2 * i] = __builtin_amdgcn_cosf(rv); ((float*)(ws + W_ROPE))[2 * i + 1] = __builtin_amdgcn_sinf(rv); }
}

DEV void phase_rowstat(const float* x, bf16_t* xb, float* rstd) {
    const int lane = threadIdx.x & 63, wv = threadIdx.x >> 6;
    for (int t = blockIdx.x * 8 + wv; t < T_; t += gridDim.x * 8) {
        const float* xr = x + (long)t * 1024; float ss = 0.f;
#pragma unroll
        for (int i = 0; i < 4; ++i) {
            const u4 u = gld16(xr + i * 256 + lane * 4); const float v0 = __uint_as_float(u.x), v1 = __uint_as_float(u.y), v2 = __uint_as_float(u.z), v3 = __uint_as_float(u.w);
            ss += v0 * v0 + v1 * v1 + v2 * v2 + v3 * v3;
            u2 o; o.x = cvtpk(v0, v1); o.y = cvtpk(v2, v3); gst8(xb + (long)t * 1024 + i * 256 + lane * 4, o);
        }
#pragma unroll
        for (int m = 1; m < 64; m <<= 1) ss += __shfl_xor(ss, m);
        if (lane == 0) rstd[t] = ss;
    }
}

#define GLDS16(gp, ldsoff) __builtin_amdgcn_global_load_lds((const unsigned*)(gp), (unsigned*)(smem + (ldsoff)), 16, 0, 0)
template <class P, int TM, class = void> struct GemmPre { struct type {}; static constexpr bool on = false; };
template <class P, int TM> struct GemmPre<P, TM, decltype((void)sizeof(typename P::template Pre<TM>))> { typedef typename P::template Pre<TM> type; static constexpr bool on = true; };
template <int TM, int WN, class P>
DEV void gemm_tile(const P& p, int m0, int n0, int mrows) {
    constexpr int WM = 8 / WN, BM = 32 * TM * WM, BN = 64 * WN, STG = (BM + BN) * 128, NA = BM / 64, NB = BN / 64;
    const int tid = threadIdx.x, lane = tid & 63, wid = tid >> 6, wm = wid / WN, wn = wid % WN, l31 = lane & 31, hi = lane >> 5;
    typename GemmPre<P, TM>::type pre;
    if constexpr (GemmPre<P, TM>::on) p.template pre1<TM>(pre, m0, n0, mrows, wm, wn, lane);
    const bf16_t* ap[NA]; long bo[NB];
#pragma unroll
    for (int i = 0; i < NA; ++i) { const int row = (tid + 512 * i) >> 3, pc = tid & 7; const int rr = row < mrows ? row : mrows - 1;
        ap[i] = p.a_row(m0 + rr) + ((pc ^ ((row >> 1) & 7)) << 3); }
#pragma unroll
    for (int i = 0; i < NB; ++i) { const int n = (tid + 512 * i) >> 3, pc = tid & 7; bo[i] = (long)(n0 + n) * p.ldb() + ((pc ^ ((n >> 1) & 7)) << 3); }
    unsigned rab[TM], rasw[TM], rbb[2], rbsw[2];
#pragma unroll
    for (int i = 0; i < TM; ++i) { const int row = wm * 32 * TM + i * 32 + l31; rab[i] = row * 128; rasw[i] = (row >> 1) & 7; }
#pragma unroll
    for (int j = 0; j < 2; ++j) { const int n = wn * 64 + j * 32 + l31; rbb[j] = BM * 128 + n * 128; rbsw[j] = (n >> 1) & 7; }
    f32x16 acc[TM][2];
#pragma unroll
    for (int i = 0; i < TM; ++i) { acc[i][0] = f32x16{}; acc[i][1] = f32x16{}; }
    const int nk = p.nk(); const long aks = p.a_kstride();
    {   const bf16_t* bb = p.b_base(0);
#pragma unroll
        for (int i = 0; i < NA; ++i) GLDS16(ap[i], LDS_PH + (tid + 512 * i) * 16);
#pragma unroll
        for (int i = 0; i < NB; ++i) GLDS16(bb + bo[i], LDS_PH + BM * 128 + (tid + 512 * i) * 16);
    }
    if constexpr (GemmPre<P, TM>::on) p.template pre2<TM>(pre, m0, n0, mrows, wm, wn, lane);
    __syncthreads();
    for (int kt = 0; kt < nk; ++kt) {
        const unsigned cur = LDS_PH + (kt & 1) * STG, nxt = LDS_PH + ((kt + 1) & 1) * STG;
        if (kt + 1 < nk) { const bf16_t* bb = p.b_base(kt + 1);
#pragma unroll
            for (int i = 0; i < NA; ++i) GLDS16(ap[i] + (long)(kt + 1) * aks, nxt + (tid + 512 * i) * 16);
#pragma unroll
            for (int i = 0; i < NB; ++i) GLDS16(bb + bo[i], nxt + BM * 128 + (tid + 512 * i) * 16); }
        bf16x8 af[2][TM], bf[2][2];
#pragma unroll
        for (int i = 0; i < TM; ++i) af[0][i] = LDS_BF8(cur + rab[i] + (((0 + hi) ^ rasw[i]) << 4));
#pragma unroll
        for (int j = 0; j < 2; ++j) bf[0][j] = LDS_BF8(cur + rbb[j] + (((0 + hi) ^ rbsw[j]) << 4));
#pragma unroll
        for (int ks = 0; ks < 4; ++ks) {
            if (ks < 3) {
#pragma unroll
                for (int i = 0; i < TM; ++i) af[(ks + 1) & 1][i] = LDS_BF8(cur + rab[i] + (((2 * (ks + 1) + hi) ^ rasw[i]) << 4));
#pragma unroll
                for (int j = 0; j < 2; ++j) bf[(ks + 1) & 1][j] = LDS_BF8(cur + rbb[j] + (((2 * (ks + 1) + hi) ^ rbsw[j]) << 4));
                __builtin_amdgcn_sched_barrier(0);
            }
#pragma unroll
            for (int i = 0; i < TM; ++i)
#pragma unroll
                for (int j = 0; j < 2; ++j) acc[i][j] = MFMA32(bf[ks & 1][j], af[ks & 1][i], acc[i][j]);
            __builtin_amdgcn_sched_barrier(0);
        }
        __syncthreads();
    }
    if constexpr (GemmPre<P, TM>::on) p.template epi<TM>(acc, m0, n0, mrows, wm, wn, lane, pre); else p.template epi<TM>(acc, m0, n0, mrows, wm, wn, lane);
}
template <int TM, int WN, class P>
DEV void gemm_tile3(const P& p, int m0, int n0, int mrows) {
    constexpr int WM = 8 / WN, BM = 32 * TM * WM, BN = 64 * WN, STG = (BM + BN) * 128, NA = BM / 64, NB = BN / 64;
    const int tid = threadIdx.x, lane = tid & 63, wid = tid >> 6, wm = wid / WN, wn = wid % WN, l31 = lane & 31, hi = lane >> 5;
    typename GemmPre<P, TM>::type pre;
    if constexpr (GemmPre<P, TM>::on) p.template pre1<TM>(pre, m0, n0, mrows, wm, wn, lane);
    const bf16_t* ap[NA]; long bo[NB];
#pragma unroll
    for (int i = 0; i < NA; ++i) { const int row = (tid + 512 * i) >> 3, pc = tid & 7; const int rr = row < mrows ? row : mrows - 1;
        ap[i] = p.a_row(m0 + rr) + ((pc ^ ((row >> 1) & 7)) << 3); }
#pragma unroll
    for (int i = 0; i < NB; ++i) { const int n = (tid + 512 * i) >> 3, pc = tid & 7; bo[i] = (long)(n0 + n) * p.ldb() + ((pc ^ ((n >> 1) & 7)) << 3); }
    unsigned rab[TM], rasw[TM], rbb[2], rbsw[2];
#pragma unroll
    for (int i = 0; i < TM; ++i) { const int row = wm * 32 * TM + i * 32 + l31; rab[i] = row * 128; rasw[i] = (row >> 1) & 7; }
#pragma unroll
    for (int j = 0; j < 2; ++j) { const int n = wn * 64 + j * 32 + l31; rbb[j] = BM * 128 + n * 128; rbsw[j] = (n >> 1) & 7; }
    f32x16 acc[TM][2];
#pragma unroll
    for (int i = 0; i < TM; ++i) { acc[i][0] = f32x16{}; acc[i][1] = f32x16{}; }
    const int nk = p.nk(); const long aks = p.a_kstride();
    static_assert(NA + NB == 6, "counted waits below assume 6 LDS-DMA instructions per thread and stage");
#pragma unroll
    for (int st = 0; st < 2; ++st) { const bf16_t* bb = p.b_base(st);
#pragma unroll
        for (int i = 0; i < NA; ++i) GLDS16(ap[i] + (long)st * aks, LDS_PH + st * STG + (tid + 512 * i) * 16);
#pragma unroll
        for (int i = 0; i < NB; ++i) GLDS16(bb + bo[i], LDS_PH + st * STG + BM * 128 + (tid + 512 * i) * 16);
    }
    asm volatile("s_waitcnt vmcnt(6)" ::: "memory");
    if constexpr (GemmPre<P, TM>::on) p.template pre2<TM>(pre, m0, n0, mrows, wm, wn, lane);
    __builtin_amdgcn_s_barrier();
    int cs = 0;
    for (int kt = 0; kt < nk; ++kt) {
        const unsigned cur = LDS_PH + cs * STG; const int ns = cs >= 1 ? cs - 1 : 2;
        const unsigned nxt = LDS_PH + ns * STG;
        if (kt + 2 < nk) { const bf16_t* bb = p.b_base(kt + 2);
#pragma unroll
            for (int i = 0; i < NA; ++i) GLDS16(ap[i] + (long)(kt + 2) * aks, nxt + (tid + 512 * i) * 16);
#pragma unroll
            for (int i = 0; i < NB; ++i) GLDS16(bb + bo[i], nxt + BM * 128 + (tid + 512 * i) * 16); }
        bf16x8 af[2][TM], bf[2][2];
#pragma unroll
        for (int i = 0; i < TM; ++i) af[0][i] = LDS_BF8(cur + rab[i] + (((0 + hi) ^ rasw[i]) << 4));
#pragma unroll
        for (int j = 0; j < 2; ++j) bf[0][j] = LDS_BF8(cur + rbb[j] + (((0 + hi) ^ rbsw[j]) << 4));
#pragma unroll
        for (int ks = 0; ks < 4; ++ks) {
            if (ks < 3) {
#pragma unroll
                for (int i = 0; i < TM; ++i) af[(ks + 1) & 1][i] = LDS_BF8(cur + rab[i] + (((2 * (ks + 1) + hi) ^ rasw[i]) << 4));
#pragma unroll
                for (int j = 0; j < 2; ++j) bf[(ks + 1) & 1][j] = LDS_BF8(cur + rbb[j] + (((2 * (ks + 1) + hi) ^ rbsw[j]) << 4));
                __builtin_amdgcn_sched_barrier(0);
            }
#pragma unroll
            for (int i = 0; i < TM; ++i)
#pragma unroll
                for (int j = 0; j < 2; ++j) acc[i][j] = MFMA32(bf[ks & 1][j], af[ks & 1][i], acc[i][j]);
            __builtin_amdgcn_sched_barrier(0);
        }
        if (kt + 2 < nk) asm volatile("s_waitcnt vmcnt(6) lgkmcnt(0)" ::: "memory"); else asm volatile("s_waitcnt vmcnt(0) lgkmcnt(0)" ::: "memory");
        __builtin_amdgcn_s_barrier();
        cs = cs == 2 ? 0 : cs + 1;
    }
    __syncthreads();
    if constexpr (GemmPre<P, TM>::on) p.template epi<TM>(acc, m0, n0, mrows, wm, wn, lane, pre); else p.template epi<TM>(acc, m0, n0, mrows, wm, wn, lane);
}
#define EPI_M(TM, i) (wm * 32 * TM + (i) * 32 + (lane & 31))
#define EPI_NB(j, q) (wn * 64 + (j) * 32 + 8 * (q) + 4 * (lane >> 5))
#define EPI_JQ _Pragma("unroll") for (int j = 0; j < 2; ++j) _Pragma("unroll") for (int q = 0; q < 4; ++q)
DEV u2 pack4(float a, float b, float c, float d) { u2 o; o.x = cvtpk(a, b); o.y = cvtpk(c, d); return o; }
DEV u4 pair_swap(u2 a, u2 b) { auto r = __builtin_amdgcn_permlane32_swap(a.x, b.x, false, false); auto t = __builtin_amdgcn_permlane32_swap(a.y, b.y, false, false);
    u4 w; w.x = r[0]; w.y = t[0]; w.z = r[1]; w.w = t[1]; return w; }
DEV void pair_unswap(u4 w, u2& a, u2& b) { auto r = __builtin_amdgcn_permlane32_swap(w.x, w.z, false, false); auto t = __builtin_amdgcn_permlane32_swap(w.y, w.w, false, false);
    a.x = r[0]; a.y = t[0]; b.x = r[1]; b.y = t[1]; }
DEV void st_bf16(bf16_t* p, float v) { *(GAS bf16_t*)p = (bf16_t)(cvtpk(v, 0.f) & 0xffffu); }

struct GemmIn {
    const bf16_t* A; const bf16_t* Bt; const float* rstd; bf16_t* C; int nparts;
    DEV const bf16_t* a_row(int r) const { return A + (long)r * 1024; }
    DEV long a_kstride() const { return 64; }
    DEV const bf16_t* b_base(int kt) const { return Bt + kt * 64; }
    DEV long ldb() const { return 1024; }
    DEV int nk() const { return 16; }
    template <int TM> DEV void epi(f32x16 (&acc)[TM][2], int m0, int n0, int mrows, int wm, int wn, int lane) const {
#pragma unroll
        for (int i = 0; i < TM; ++i) { const int row = m0 + EPI_M(TM, i); float sq = gldf(rstd + row); if (nparts == 4) sq = ((sq + gldf(rstd + T_ + row)) + gldf(rstd + 2 * T_ + row)) + gldf(rstd + 3 * T_ + row);
            const float rs = __builtin_amdgcn_rsqf(sq * (1.f / 1024.f) + EPS); bf16_t* cr = C + (long)row * PLD + n0;
            EPI_JQ gst8(cr + EPI_NB(j, q), pack4(acc[i][j][4 * q] * rs, acc[i][j][4 * q + 1] * rs, acc[i][j][4 * q + 2] * rs, acc[i][j][4 * q + 3] * rs)); }
    }
};
struct GemmPlain {
    const bf16_t* A; long lda; const bf16_t* Bt; long ldb_; int nk_; bf16_t* C; long ldc;
    DEV const bf16_t* a_row(int r) const { return A + (long)r * lda; }
    DEV long a_kstride() const { return 64; }
    DEV const bf16_t* b_base(int kt) const { return Bt + kt * 64; }
    DEV long ldb() const { return ldb_; }
    DEV int nk() const { return nk_; }
    template <int TM> DEV void epi(f32x16 (&acc)[TM][2], int m0, int n0, int mrows, int wm, int wn, int lane) const {
#pragma unroll
        for (int i = 0; i < TM; ++i) { bf16_t* cr = C + (long)(m0 + EPI_M(TM, i)) * ldc + n0;
#pragma unroll
            for (int j = 0; j < 2; ++j)
#pragma unroll
                for (int q = 0; q < 4; q += 2)
                    gst16(cr + wn * 64 + j * 32 + 8 * q + 8 * (lane >> 5), pair_swap(pack4(acc[i][j][4 * q], acc[i][j][4 * q + 1], acc[i][j][4 * q + 2], acc[i][j][4 * q + 3]),
                                                                                          pack4(acc[i][j][4 * q + 4], acc[i][j][4 * q + 5], acc[i][j][4 * q + 6], acc[i][j][4 * q + 7]))); }
    }
};
template <class MK> DEV void gemm_smallk_run(const MK& mk, int tfirst, int tstep, int tend) {
    constexpr int TM = 2, WN = 2, BM = 256, BN = 128, STG = (BM + BN) * 128, NA = BM / 64, NB = BN / 64;
    const int tid = threadIdx.x, lane = tid & 63, wid = tid >> 6, wm = wid / WN, wn = wid % WN, l31 = lane & 31, hi = lane >> 5;
    if (tfirst >= tend) return;
    unsigned rab[TM], rasw[TM], rbb[2], rbsw[2];
#pragma unroll
    for (int i = 0; i < TM; ++i) { const int row = wm * 32 * TM + i * 32 + l31; rab[i] = row * 128; rasw[i] = (row >> 1) & 7; }
#pragma unroll
    for (int j = 0; j < 2; ++j) { const int n = wn * 64 + j * 32 + l31; rbb[j] = BM * 128 + n * 128; rbsw[j] = (n >> 1) & 7; }
#define SMK_ISSUE(T) do { GemmPlain q_; int qm_, qn_; mk((T), q_, qm_, qn_); \
        for (int kt_ = 0; kt_ < q_.nk_; ++kt_) { \
            _Pragma("unroll") for (int i = 0; i < NA; ++i) { const int row = (tid + 512 * i) >> 3, pc = tid & 7; GLDS16(q_.A + (long)(qm_ + row) * q_.lda + kt_ * 64 + ((pc ^ ((row >> 1) & 7)) << 3), LDS_PH + kt_ * STG + (tid + 512 * i) * 16); } \
            _Pragma("unroll") for (int i = 0; i < NB; ++i) { const int n = (tid + 512 * i) >> 3, pc = tid & 7; GLDS16(q_.Bt + (long)(qn_ + n) * q_.ldb_ + kt_ * 64 + ((pc ^ ((n >> 1) & 7)) << 3), LDS_PH + kt_ * STG + BM * 128 + (tid + 512 * i) * 16); } } } while (0)
    SMK_ISSUE(tfirst);
    asm volatile("s_waitcnt vmcnt(0)" ::: "memory");
    for (int t = tfirst; t < tend; t += tstep) {
        GemmPlain p; int m0, n0; mk(t, p, m0, n0);
        __builtin_amdgcn_s_barrier();
        f32x16 acc[TM][2];
#pragma unroll
        for (int i = 0; i < TM; ++i) { acc[i][0] = f32x16{}; acc[i][1] = f32x16{}; }
        for (int kt = 0; kt < p.nk_; ++kt) {
            const unsigned cur = LDS_PH + kt * STG;
            bf16x8 af[2][TM], bf[2][2];
#pragma unroll
            for (int i = 0; i < TM; ++i) af[0][i] = LDS_BF8(cur + rab[i] + (((0 + hi) ^ rasw[i]) << 4));
#pragma unroll
            for (int j = 0; j < 2; ++j) bf[0][j] = LDS_BF8(cur + rbb[j] + (((0 + hi) ^ rbsw[j]) << 4));
#pragma unroll
            for (int ks = 0; ks < 4; ++ks) {
                if (ks < 3) {
#pragma unroll
                    for (int i = 0; i < TM; ++i) af[(ks + 1) & 1][i] = LDS_BF8(cur + rab[i] + (((2 * (ks + 1) + hi) ^ rasw[i]) << 4));
#pragma unroll
                    for (int j = 0; j < 2; ++j) bf[(ks + 1) & 1][j] = LDS_BF8(cur + rbb[j] + (((2 * (ks + 1) + hi) ^ rbsw[j]) << 4));
                    __builtin_amdgcn_sched_barrier(0);
                }
#pragma unroll
                for (int i = 0; i < TM; ++i)
#pragma unroll
                    for (int j = 0; j < 2; ++j) acc[i][j] = MFMA32(bf[ks & 1][j], af[ks & 1][i], acc[i][j]);
                __builtin_amdgcn_sched_barrier(0);
            }
        }
        asm volatile("s_waitcnt lgkmcnt(0)" ::: "memory");
        __builtin_amdgcn_s_barrier();
        const bool more = t + tstep < tend;
        if (more) SMK_ISSUE(t + tstep);
        __builtin_amdgcn_sched_barrier(0);
        p.template epi<TM>(acc, m0, n0, 256, wm, wn, lane);
        __builtin_amdgcn_sched_barrier(0);
        if (more) asm volatile("s_waitcnt vmcnt(8)" ::: "memory");
    }
#undef SMK_ISSUE
}
DEV float gelu_tanh(float x) { const float u = 0.7978845608028654f * (x + 0.044715f * x * x * x); const float e = fexp2(u * (2.f * LOG2E)); return 0.5f * x * (2.f - 2.f * frcp(1.f + e)); }
struct GemmCmp1 {
    const bf16_t* Xc; int w; const bf16_t* Bt; const float* bias; bf16_t* H1;
    DEV const bf16_t* a_row(int r) const { const int hk = r & 1, bn = r >> 1, b = bn >> 9; int n = bn & 511; n = n > 510 ? 510 : n;
        return Xc + ((long)(b * S_ + 16 * n) * 4 + w * 2 + hk) * 64; }
    DEV long a_kstride() const { return 256; }
    DEV const bf16_t* b_base(int kt) const { return Bt + kt * 64; }
    DEV long ldb() const { return 2048; }
    DEV int nk() const { return 32; }
    template <int TM> DEV void epi(f32x16 (&acc)[TM][2], int m0, int n0, int mrows, int wm, int wn, int lane) const {
#pragma unroll
        for (int i = 0; i < TM; ++i) { bf16_t* cr = H1 + (long)(m0 + EPI_M(TM, i)) * 128 + n0;
            EPI_JQ { const int nb = EPI_NB(j, q); const u4 bb = gld16(bias + n0 + nb);
                gst8(cr + nb, pack4(gelu_tanh(acc[i][j][4 * q] + __uint_as_float(bb.x)), gelu_tanh(acc[i][j][4 * q + 1] + __uint_as_float(bb.y)),
                                    gelu_tanh(acc[i][j][4 * q + 2] + __uint_as_float(bb.z)), gelu_tanh(acc[i][j][4 * q + 3] + __uint_as_float(bb.w)))); } }
    }
};
struct GemmCmp2 {
    const bf16_t* H1; int w; const bf16_t* Bt; const float* gain; bf16_t* Kimg; bf16_t* Vimg;
    DEV const bf16_t* a_row(int r) const { return H1 + (long)r * 128; }
    DEV long a_kstride() const { return 64; }
    DEV const bf16_t* b_base(int kt) const { return Bt + kt * 64; }
    DEV long ldb() const { return 128; }
    DEV int nk() const { return 2; }
    template <int TM> DEV void epi(f32x16 (&acc)[TM][2], int m0, int n0, int mrows, int wm, int wn, int lane) const {
        if (wn != 0) return;
#pragma unroll
        for (int i = 0; i < TM; ++i) {
            const int row = m0 + EPI_M(TM, i); const int hk = row & 1, bn = row >> 1, b = bn >> 9, n = bn & 511;
            float rs = 1.f;
            if (w == 0) { float ss = 0.f;
#pragma unroll
                for (int r = 0; r < 16; ++r) ss += acc[i][0][r] * acc[i][0][r] + acc[i][1][r] * acc[i][1][r];
                rs = __builtin_amdgcn_rsqf(hsum(ss) * (1.f / 64.f) + EPS); }
            if (n == 511) rs = 0.f;
            const long tb = ((long)(b * 2 + hk) * 8 + (n >> 6)) * 4096; const int key = n & 63;
            EPI_JQ { const int col = j * 32 + 8 * q + 4 * (lane >> 5); float v0 = acc[i][j][4 * q] * rs, v1 = acc[i][j][4 * q + 1] * rs, v2 = acc[i][j][4 * q + 2] * rs, v3 = acc[i][j][4 * q + 3] * rs;
                if (w == 0) { const u4 gg = gld16(gain + col); v0 *= __uint_as_float(gg.x); v1 *= __uint_as_float(gg.y); v2 *= __uint_as_float(gg.z); v3 *= __uint_as_float(gg.w);
                    gst8(Kimg + tb + (col >> 3) * 512 + key * 8 + (col & 7), pack4(v0, v1, v2, v3)); }
                else gst8(Vimg + tb + (col >> 5) * 2048 + key * 32 + (col & 31), pack4(v0, v1, v2, v3)); }
        }
    }
};
struct GemmOut {
    const bf16_t* A; const bf16_t* Bt; const float* xin; float* xout;
    DEV const bf16_t* a_row(int r) const { return A + (long)r * 1024; }
    DEV long a_kstride() const { return 64; }
    DEV const bf16_t* b_base(int kt) const { return Bt + kt * 64; }
    DEV long ldb() const { return 1024; }
    DEV int nk() const { return 16; }
    template <int TM> DEV void epi(f32x16 (&acc)[TM][2], int m0, int n0, int mrows, int wm, int wn, int lane) const {
#pragma unroll
        for (int i = 0; i < TM; ++i) { const long ro = (long)(m0 + EPI_M(TM, i)) * 1024 + n0;
            EPI_JQ { const long o = ro + EPI_NB(j, q); const u4 xi = gld16(xin + o); u4 xo;
                xo.x = __float_as_uint(__uint_as_float(xi.x) + acc[i][j][4 * q]); xo.y = __float_as_uint(__uint_as_float(xi.y) + acc[i][j][4 * q + 1]);
                xo.z = __float_as_uint(__uint_as_float(xi.z) + acc[i][j][4 * q + 2]); xo.w = __float_as_uint(__uint_as_float(xi.w) + acc[i][j][4 * q + 3]); gst16(xout + o, xo); }
            __builtin_amdgcn_sched_barrier(0); }
    }
};
struct GemmMoe1 {
    const bf16_t* xb; const int* list; const bf16_t* Bt; const float* rstd; const float* wslot; bf16_t* abuf;
    DEV const bf16_t* a_row(int r) const { const int e = *(const GAS int*)(list + r); return xb + (long)(e >> 1) * 1024; }
    DEV long a_kstride() const { return 64; }
    DEV const bf16_t* b_base(int kt) const { return Bt + kt * 64; }
    DEV long ldb() const { return 1024; }
    DEV int nk() const { return 16; }
    template <int TM> struct Pre { int ee[TM]; float rsv[TM], cwv[TM]; };
    template <int TM> DEV void pre1(Pre<TM>& pr, int m0, int n0, int mrows, int wm, int wn, int lane) const {
        if constexpr (TM <= 2) {
#pragma unroll
        for (int i = 0; i < TM; ++i) { const int lr = EPI_M(TM, i); pr.ee[i] = *(const GAS int*)(list + m0 + (lr < mrows ? lr : 0)); } } }
    template <int TM> DEV void pre2(Pre<TM>& pr, int m0, int n0, int mrows, int wm, int wn, int lane) const {
        if constexpr (TM <= 2) {
#pragma unroll
        for (int i = 0; i < TM; ++i) { pr.rsv[i] = gldf(rstd + (pr.ee[i] >> 1)); pr.cwv[i] = gldf(wslot + pr.ee[i]); } } }
    template <int TM> DEV void epi(f32x16 (&acc)[TM][2], int m0, int n0, int mrows, int wm, int wn, int lane, const Pre<TM>& pr0) const {
        const int hid0 = 32 * ((n0 >> 6) + wn) + 4 * (lane >> 5);
        Pre<TM> pr = pr0;
        if constexpr (TM > 2) {
#pragma unroll
            for (int i = 0; i < TM; ++i) { const int lr = EPI_M(TM, i); pr.ee[i] = *(const GAS int*)(list + m0 + (lr < mrows ? lr : 0)); }
#pragma unroll
            for (int i = 0; i < TM; ++i) { pr.rsv[i] = gldf(rstd + (pr.ee[i] >> 1)); pr.cwv[i] = gldf(wslot + pr.ee[i]); } }
#pragma unroll
        for (int i = 0; i < TM; ++i) { const int lr = EPI_M(TM, i);
            if (lr < mrows) { const int e = pr.ee[i]; const float rs = pr.rsv[i], cw = pr.cwv[i]; bf16_t* ar = abuf + (long)e * 256 + hid0;
                u2 pk[4];
#pragma unroll
                for (int q = 0; q < 4; ++q) { float o[4];
#pragma unroll
                    for (int k = 0; k < 4; ++k) { const float g = acc[i][0][4 * q + k] * rs, u = acc[i][1][4 * q + k] * rs; o[k] = g * frcp(1.f + fexp2(-g * LOG2E)) * u * cw; }
                    pk[q] = pack4(o[0], o[1], o[2], o[3]); }
                gst16(ar + 4 * (lane >> 5), pair_swap(pk[0], pk[1])); gst16(ar + 16 + 4 * (lane >> 5), pair_swap(pk[2], pk[3])); } }
    }
};
struct GemmMoe2 {
    const bf16_t* abuf; const int* list; const bf16_t* B0; const bf16_t* B1; bf16_t* xb; float* xout; float* ssq_out;
    DEV const bf16_t* a_row(int r) const { return abuf + (long)(*(const GAS int*)(list + r)) * 512; }
    DEV long a_kstride() const { return 64; }
    DEV const bf16_t* b_base(int kt) const { return kt < 4 ? B0 + kt * 64 : B1 + (kt - 4) * 64; }
    DEV long ldb() const { return 256; }
    DEV int nk() const { return 8; }
    template <int TM> struct Pre { int tok[TM]; u4 xw[TM][2][2]; };
    template <int TM> DEV void pre1(Pre<TM>& pr, int m0, int n0, int mrows, int wm, int wn, int lane) const {
#pragma unroll
        for (int i = 0; i < TM; ++i) { const int lr = EPI_M(TM, i); pr.tok[i] = *(const GAS int*)(list + m0 + (lr < mrows ? lr : 0)); } }
    template <int TM> DEV void pre2(Pre<TM>& pr, int m0, int n0, int mrows, int wm, int wn, int lane) const {
#pragma unroll
        for (int i = 0; i < TM; ++i) { const long ro = (long)pr.tok[i] * 1024 + n0;
#pragma unroll
            for (int j = 0; j < 2; ++j)
#pragma unroll
                for (int qp = 0; qp < 2; ++qp) pr.xw[i][j][qp] = gld16(xb + ro + wn * 64 + j * 32 + 16 * qp + 8 * (lane >> 5)); } }
    template <int TM> DEV void epi(f32x16 (&acc)[TM][2], int m0, int n0, int mrows, int wm, int wn, int lane, const Pre<TM>& pr) const {
#pragma unroll
        for (int i = 0; i < TM; ++i) { const int lr = EPI_M(TM, i); const bool ok = lr < mrows; float ss = 0.f;
            if (ok) { const long ro = (long)pr.tok[i] * 1024 + n0;
#pragma unroll
                for (int j = 0; j < 2; ++j)
#pragma unroll
                    for (int qp = 0; qp < 2; ++qp) {
                        u2 rr[2]; pair_unswap(pr.xw[i][j][qp], rr[0], rr[1]); u2 pk[2];
#pragma unroll
                        for (int h = 0; h < 2; ++h) { const int q = 2 * qp + h; const u2 r = rr[h];
                            const float y0 = __uint_as_float(r.x << 16) + acc[i][j][4 * q], y1 = __uint_as_float(r.x & 0xffff0000u) + acc[i][j][4 * q + 1], y2 = __uint_as_float(r.y << 16) + acc[i][j][4 * q + 2], y3 = __uint_as_float(r.y & 0xffff0000u) + acc[i][j][4 * q + 3];
                            if (xout) { u4 xo; xo.x = __float_as_uint(y0); xo.y = __float_as_uint(y1); xo.z = __float_as_uint(y2); xo.w = __float_as_uint(y3); gst16(xout + ro + EPI_NB(j, q), xo); }
                            else { pk[h] = pack4(y0, y1, y2, y3); ss += y0 * y0 + y1 * y1 + y2 * y2 + y3 * y3; } }
                        if (!xout) gst16(xb + ro + wn * 64 + j * 32 + 16 * qp + 8 * (lane >> 5), pair_swap(pk[0], pk[1])); } }
            if (!xout) { ss = hsum(ss); if (lane < 32) LDS_F(LDS_EPI + (lr * 4 + wn) * 4) = ok ? ss : 0.f; } }
        if (!xout) {
            __syncthreads();
            const int t = threadIdx.x;
            if (t < 32 * TM * 2 && t < mrows) { const u4 pv = LDS_U4(LDS_EPI + t * 16); const int tok = *(const GAS int*)(list + m0 + t);
                *(GAS float*)(ssq_out + (long)(n0 >> 8) * T_ + tok) = (__uint_as_float(pv.x) + __uint_as_float(pv.y)) + (__uint_as_float(pv.z) + __uint_as_float(pv.w)); }
            __syncthreads();
        }
    }
};

namespace pg8 {
#define PG8_LAS __attribute__((address_space(3)))
typedef unsigned short bf16_t;
typedef short bf16x8 __attribute__((ext_vector_type(8)));
typedef float f32x4 __attribute__((ext_vector_type(4)));
typedef unsigned u32x4 __attribute__((ext_vector_type(4)));
constexpr int BM = 256, BK = 64, HALF = 128, HTB = HALF * BK * 2  , STAGE_BYTES = 8 * HTB, NXCD = 8, WGM = 8;

__host__ __device__ __forceinline__ int lds_byte(int r, int c) { const int st = (r >> 4) * 2 + (c >> 5), rr = r & 15, cc = c & 31, ob = rr * 64 + cc * 2; return st * 1024 + (ob ^ (((ob >> 9) & 1) << 5)); }
__host__ __device__ __forceinline__ void stage_rc(int b, int& R, int& C) { const int st = b / 1024, sb = b % 1024, swz = sb ^ (((sb >> 9) & 1) << 5); R = (st >> 1) * 16 + swz / 64; C = (st & 1) * 32 + (swz % 64) / 2; }
__host__ __device__ __forceinline__ int perm32(int rho) { const int n = rho >> 4, i = rho & 15; return 8 * (i >> 2) + 4 * n + (i & 3); }

struct Unit { int pm, pn; };
struct Gemm { const bf16_t* A; const bf16_t* Bt; int M, N, K; };

struct StaticOrder {
    int nM, nN, nwg, G, c;
    __host__ __device__ void init(int M, int N, int G_, int c_) { nM = M / BM; nN = N / BM; nwg = nM * nN; G = G_; c = c_; }
    __host__ __device__ bool next(int i, Unit& u) const {
        const long L = (long)i * G + c; if (L >= nwg) return false;
        int wgid = (int)L; { const int q = nwg / NXCD, r = nwg % NXCD, xcd = wgid % NXCD, off = wgid / NXCD; wgid = (xcd < r ? xcd * (q + 1) : r * (q + 1) + (xcd - r) * q) + off; }
        const int nig = WGM * nN, gid = wgid / nig, fm = gid * WGM, gsz = (nM - fm) < WGM ? (nM - fm) : WGM;
        u.pm = fm + ((wgid % nig) % gsz); u.pn = (wgid % nig) / gsz; return true;
    }
    __device__ __forceinline__ void a_ready(const Unit&) const {}
    __device__ __forceinline__ void done(const Unit&) const {}
};
__device__ __forceinline__ unsigned cvt_pk_bf16(float lo, float hi) { unsigned r; asm volatile("v_cvt_pk_bf16_f32 %0, %1, %2" : "=v"(r) : "v"(lo), "v"(hi)); return r; }

struct EpiProj {
    static constexpr bool PERM = true, AFTER_DRAIN = false;
    bf16_t* O; int ldc; int ncols; const float* ssq; int nparts; int T;
    __device__ __forceinline__ void operator()(const f32x4 (&acc)[2][2][4][2], const Unit& u, int wr, int wc, int fr, int fq) const {
        const int row0 = u.pm * BM + wr * 64 + fr, col0 = u.pn * BM + wc * 32 + 8 * fq;
        float rs[2][4];
#pragma unroll
        for (int ai = 0; ai < 2; ++ai)
#pragma unroll
            for (int m = 0; m < 4; ++m) { const int row = row0 + ai * HALF + m * 16; float sq = ssq[row]; if (nparts == 4) sq = ((sq + ssq[T + row]) + ssq[2 * T + row]) + ssq[3 * T + row]; rs[ai][m] = sq; }
#pragma unroll
        for (int ai = 0; ai < 2; ++ai)
#pragma unroll
            for (int m = 0; m < 4; ++m) rs[ai][m] = __builtin_amdgcn_rsqf(rs[ai][m] * (1.f / 1024.f) + 1e-6f);
#pragma unroll
        for (int bj = 0; bj < 2; ++bj) {
            if (u.pn * BM + bj * HALF >= ncols) continue;
#pragma unroll
            for (int ai = 0; ai < 2; ++ai)
#pragma unroll
                for (int m = 0; m < 4; ++m) { bf16_t* rowp = O + (size_t)(row0 + ai * HALF + m * 16) * ldc + col0 + bj * HALF; const f32x4 v0 = acc[ai][bj][m][0] * rs[ai][m], v1 = acc[ai][bj][m][1] * rs[ai][m];
                    u32x4 w; w.x = cvt_pk_bf16(v0[0], v0[1]); w.y = cvt_pk_bf16(v0[2], v0[3]); w.z = cvt_pk_bf16(v1[0], v1[1]); w.w = cvt_pk_bf16(v1[2], v1[3]); *(u32x4*)rowp = w; }
        }
    }
};
struct EpiResid {
    static constexpr bool PERM = true, AFTER_DRAIN = false;
    bf16_t* xb; int ldc;
    __device__ __forceinline__ void operator()(const f32x4 (&acc)[2][2][4][2], const Unit& u, int wr, int wc, int fr, int fq) const {
        const int row0 = u.pm * BM + wr * 64 + fr, col0 = u.pn * BM + wc * 32 + 8 * fq;
        u4 xr[2][4][2];
#pragma unroll
        for (int ai = 0; ai < 2; ++ai)
#pragma unroll
            for (int m = 0; m < 4; ++m) { const size_t ro = (size_t)(row0 + ai * HALF + m * 16) * ldc + col0;
#pragma unroll
                for (int bj = 0; bj < 2; ++bj) xr[ai][m][bj] = gld16(xb + ro + bj * HALF); }
#pragma unroll
        for (int ai = 0; ai < 2; ++ai)
#pragma unroll
            for (int m = 0; m < 4; ++m) { const size_t ro = (size_t)(row0 + ai * HALF + m * 16) * ldc + col0;
#pragma unroll
                for (int bj = 0; bj < 2; ++bj) { const u4 r = xr[ai][m][bj]; const f32x4 a0 = acc[ai][bj][m][0], a1 = acc[ai][bj][m][1]; u4 w;
                    w.x = cvt_pk_bf16(__uint_as_float(r.x << 16) + a0[0], __uint_as_float(r.x & 0xffff0000u) + a0[1]); w.y = cvt_pk_bf16(__uint_as_float(r.y << 16) + a0[2], __uint_as_float(r.y & 0xffff0000u) + a0[3]);
                    w.z = cvt_pk_bf16(__uint_as_float(r.z << 16) + a1[0], __uint_as_float(r.z & 0xffff0000u) + a1[1]); w.w = cvt_pk_bf16(__uint_as_float(r.w << 16) + a1[2], __uint_as_float(r.w & 0xffff0000u) + a1[3]);
                    gst16(xb + ro + bj * HALF, w); } }
    }
};

template <class Epi, class Sched, bool ALIGN_EPI = false, bool SP2 = false>
__device__ __forceinline__ void gemm_phase(PG8_LAS unsigned char* lds, const Gemm g, const Sched& S, const Epi& E) {
    const int tid = threadIdx.x, wid = __builtin_amdgcn_readfirstlane(tid >> 6), lane = tid & 63, wr = wid >> 2, wc = wid & 3, fr = lane & 15, fq = lane >> 4;
    const int K = g.K, nt = K / BK;
    unsigned voffA[2], voffB[2];
#pragma unroll
    for (int i = 0; i < 2; ++i) { int R, C; stage_rc(tid * 16 + i * 8192, R, C); const int Rb = Epi::PERM ? ((R & ~31) + perm32(R & 31)) : R;
        voffA[i] = (unsigned)(R * K + C) * 2u; voffB[i] = (unsigned)(Rb * K + C) * 2u; }
    const size_t kstep = (size_t)(BK * 2);
    const size_t hstep = (size_t)HALF * K * 2;
    const size_t tstep = 2 * hstep;
    const unsigned ldsw = (unsigned)wid * 1024u;
    const int aoff = lds_byte(wr * 64 + fr, fq * 8), boff = lds_byte(wc * 32 + fr, fq * 8);
#define PG8_SA(b, h) (((b) * 2 + (h)) * HTB)
#define PG8_SB(b, h) ((4 + (b) * 2 + (h)) * HTB)
#define PG8_STAGE(bufoff, gbase, voff) do { _Pragma("unroll") for (int _i = 0; _i < 2; ++_i) \
        __builtin_amdgcn_global_load_lds((const unsigned*)((const char*)(gbase) + (voff)[_i]), (PG8_LAS unsigned*)(lds + (bufoff) + ldsw + _i * 8192), 16, 0, 0); } while (0)
#define PG8_LDA(dst, b, h) do { _Pragma("unroll") for (int m = 0; m < 4; ++m) _Pragma("unroll") for (int k = 0; k < 2; ++k) dst[m][k] = *(const PG8_LAS bf16x8*)(lds + PG8_SA(b, h) + aoff + m * 2048 + k * 1024); } while (0)
#define PG8_LDB(dst, b, h) do { _Pragma("unroll") for (int n = 0; n < 2; ++n) _Pragma("unroll") for (int k = 0; k < 2; ++k) dst[n][k] = *(const PG8_LAS bf16x8*)(lds + PG8_SB(b, h) + boff + n * 2048 + k * 1024); } while (0)
#define PG8_MMA(ai, bj, At, Bt) do { __builtin_amdgcn_s_setprio(1); _Pragma("unroll") for (int m = 0; m < 4; ++m) _Pragma("unroll") for (int n = 0; n < 2; ++n) _Pragma("unroll") for (int k = 0; k < 2; ++k) \
        acc[ai][bj][m][n] = __builtin_amdgcn_mfma_f32_16x16x32_bf16(Bt[n][k], At[m][k], acc[ai][bj][m][n], 0, 0, 0); __builtin_amdgcn_s_setprio(0); } while (0)
#define PG8_WAIT_V(n) asm volatile("s_waitcnt vmcnt(" #n ")" ::: "memory")
#define PG8_WAIT_L(n) asm volatile("s_waitcnt lgkmcnt(" #n ")" ::: "memory")
#define PG8_BAR __builtin_amdgcn_s_barrier()
#define PG8_SCHED __builtin_amdgcn_sched_barrier(0)
    Unit cur, nxt; int ui = 0;
    if (!S.next(0, cur)) return;
    f32x4 acc[2][2][4][2];
#pragma unroll
    for (int a = 0; a < 2; ++a)
#pragma unroll
        for (int b = 0; b < 2; ++b)
#pragma unroll
            for (int m = 0; m < 4; ++m)
#pragma unroll
                for (int n = 0; n < 2; ++n) acc[a][b][m][n] = (f32x4){0.f, 0.f, 0.f, 0.f};
    bf16x8 At[4][2], B0[2][2], B1[2][2];
    const char* cA = (const char*)g.A + (size_t)cur.pm * tstep; const char* cB = (const char*)g.Bt + (size_t)cur.pn * tstep;
    S.a_ready(cur);
    if constexpr (SP2) {
        PG8_STAGE(PG8_SB(0, 0), cB, voffB); PG8_STAGE(PG8_SB(0, 1), cB + hstep, voffB); PG8_STAGE(PG8_SA(0, 0), cA, voffA); PG8_STAGE(PG8_SA(0, 1), cA + hstep, voffA);
        if (wr == 1) PG8_BAR;
        PG8_WAIT_V(2); PG8_BAR;
        PG8_STAGE(PG8_SB(1, 0), cB + kstep, voffB); PG8_STAGE(PG8_SA(1, 0), cA + kstep, voffA); PG8_STAGE(PG8_SB(1, 1), cB + hstep + kstep, voffB);
        PG8_WAIT_V(6); PG8_BAR;
    } else {
        PG8_STAGE(PG8_SB(0, 0), cB, voffB); PG8_STAGE(PG8_SA(0, 0), cA, voffA); PG8_STAGE(PG8_SB(0, 1), cB + hstep, voffB); PG8_STAGE(PG8_SA(0, 1), cA + hstep, voffA);
        if (wr == 1) PG8_BAR;
        PG8_WAIT_V(4); PG8_BAR;
        PG8_STAGE(PG8_SB(1, 0), cB + kstep, voffB); PG8_STAGE(PG8_SA(1, 0), cA + kstep, voffA); PG8_STAGE(PG8_SB(1, 1), cB + hstep + kstep, voffB);
        PG8_WAIT_V(6); PG8_BAR;
    }
    for (;;) {
        const bool has_next = S.next(ui + 1, nxt);
        const char* nA = has_next ? (const char*)g.A + (size_t)nxt.pm * tstep : cA; const char* nB = has_next ? (const char*)g.Bt + (size_t)nxt.pn * tstep : cB;
        for (int t = 0; t < nt; t += 2) {
            const bool last = (t == nt - 2);
            const char* a1 = cA + (size_t)(t + 1) * kstep;
            const char* a2 = last ? nA : cA + (size_t)(t + 2) * kstep; const char* b2 = last ? nB : cB + (size_t)(t + 2) * kstep;
            const char* a3 = a2 + kstep; const char* b3 = b2 + kstep;
            if (last && has_next) S.a_ready(nxt);
            if constexpr (SP2) {
            PG8_LDB(B0, 0, 0); PG8_LDB(B1, 0, 1); PG8_SCHED; PG8_LDA(At, 0, 0); PG8_STAGE(PG8_SA(1, 1), a1 + hstep, voffA);
            PG8_WAIT_V(8); PG8_WAIT_L(0); PG8_BAR; PG8_MMA(0, 0, At, B0); PG8_MMA(0, 1, At, B1); PG8_BAR; PG8_SCHED;
            PG8_LDA(At, 0, 1); PG8_STAGE(PG8_SB(0, 0), b2, voffB); PG8_STAGE(PG8_SB(0, 1), b2 + hstep, voffB); PG8_STAGE(PG8_SA(0, 0), a2, voffA);
            PG8_WAIT_V(8); PG8_WAIT_L(0); PG8_BAR; PG8_MMA(1, 0, At, B0); PG8_MMA(1, 1, At, B1); PG8_BAR; PG8_SCHED;
            PG8_LDB(B0, 1, 0); PG8_LDB(B1, 1, 1); PG8_SCHED; PG8_LDA(At, 1, 0); PG8_STAGE(PG8_SA(0, 1), a2 + hstep, voffA);
            PG8_WAIT_V(8); PG8_WAIT_L(0); PG8_BAR; PG8_MMA(0, 0, At, B0); PG8_MMA(0, 1, At, B1); PG8_BAR; PG8_SCHED;
            PG8_LDA(At, 1, 1); PG8_STAGE(PG8_SB(1, 0), b3, voffB); PG8_STAGE(PG8_SB(1, 1), b3 + hstep, voffB); PG8_STAGE(PG8_SA(1, 0), a3, voffA);
            PG8_WAIT_V(8); PG8_WAIT_L(0); PG8_BAR; PG8_MMA(1, 0, At, B0); PG8_MMA(1, 1, At, B1); PG8_BAR; PG8_SCHED;
            } else {
            PG8_LDB(B0, 0, 0); PG8_SCHED; PG8_LDA(At, 0, 0); PG8_STAGE(PG8_SA(1, 1), a1 + hstep, voffA);
            PG8_WAIT_L(8); PG8_BAR; PG8_WAIT_L(0); PG8_MMA(0, 0, At, B0); PG8_BAR; PG8_SCHED;
            PG8_LDB(B1, 0, 1); PG8_STAGE(PG8_SB(0, 0), b2, voffB);
            PG8_BAR; PG8_WAIT_L(0); PG8_MMA(0, 1, At, B1); PG8_BAR;
            PG8_LDA(At, 0, 1); PG8_STAGE(PG8_SA(0, 0), a2, voffA);
            PG8_BAR; PG8_WAIT_L(0); PG8_MMA(1, 0, At, B0); PG8_BAR; PG8_SCHED;
            PG8_STAGE(PG8_SB(0, 1), b2 + hstep, voffB);
            PG8_WAIT_V(6); PG8_BAR; PG8_MMA(1, 1, At, B1); PG8_BAR;
            PG8_LDB(B0, 1, 0); PG8_SCHED; PG8_LDA(At, 1, 0); PG8_STAGE(PG8_SA(0, 1), a2 + hstep, voffA);
            PG8_WAIT_L(8); PG8_BAR; PG8_WAIT_L(0); PG8_MMA(0, 0, At, B0); PG8_BAR; PG8_SCHED;
            PG8_LDB(B1, 1, 1); PG8_STAGE(PG8_SB(1, 0), b3, voffB);
            PG8_BAR; PG8_WAIT_L(0); PG8_MMA(0, 1, At, B1); PG8_BAR;
            PG8_LDA(At, 1, 1); PG8_STAGE(PG8_SA(1, 0), a3, voffA);
            PG8_BAR; PG8_WAIT_L(0); PG8_MMA(1, 0, At, B0); PG8_BAR; PG8_SCHED;
            PG8_STAGE(PG8_SB(1, 1), b3 + hstep, voffB);
            PG8_WAIT_V(6); PG8_BAR; PG8_MMA(1, 1, At, B1); PG8_BAR;
            }
        }
        if constexpr (ALIGN_EPI) { if (wr == 0) PG8_BAR; }
        if constexpr (!Epi::AFTER_DRAIN) { E(acc, cur, wr, wc, fr, fq); S.done(cur); }
        if (!has_next) break;
#pragma unroll
        for (int a = 0; a < 2; ++a)
#pragma unroll
            for (int b = 0; b < 2; ++b)
#pragma unroll
                for (int m = 0; m < 4; ++m)
#pragma unroll
                    for (int n = 0; n < 2; ++n) acc[a][b][m][n] = (f32x4){0.f, 0.f, 0.f, 0.f};
        cur = nxt; cA = nA; cB = nB; ++ui;
        if constexpr (ALIGN_EPI) { if (wr == 1) PG8_BAR; }
    }
    PG8_WAIT_V(0);
    if constexpr (!ALIGN_EPI) { if (wr == 0) PG8_BAR; }
    PG8_BAR;
    if constexpr (Epi::AFTER_DRAIN) { E.fused(acc, cur, wr, wc, fr, fq, lds, wid, lane); S.done(cur); }
#undef PG8_SA
#undef PG8_SB
#undef PG8_STAGE
#undef PG8_LDA
#undef PG8_LDB
#undef PG8_MMA
#undef PG8_WAIT_V
#undef PG8_WAIT_L
#undef PG8_BAR
#undef PG8_SCHED
}
}
constexpr int AT_K0 = LDS_PH, AT_K1 = LDS_PH + 12288, AT_V0 = LDS_PH + 24576, AT_V1 = AT_V0 + 8192, AT_LUT = AT_V1 + 8192,
              AT_UN = AT_LUT + 8192, AT_ALIVE = AT_UN + 16, AT_ITEM = AT_ALIVE + 16, AT_IMP = AT_ITEM + 16, AT_END = AT_IMP + 8 * 16 * 129 * 4,
              SB_O = AT_IMP, SB_L = SB_O + 256 * 65 * 4, SB_SM = SB_L + 1024, SB_LIST = SB_SM + 2048, SB_CTR = SB_LIST + 1024, SB_VX = SB_CTR + 16, SB_END = SB_VX + 3 * 8192;
constexpr float NEG_INF = -__builtin_inff();
static_assert(AT_END <= LDS_BYTES && SB_END <= LDS_BYTES, "attention LDS map");

template <int DK> DEV void att_gload(u4& k0, u4& k1, u4& v, const bf16_t* kt, const bf16_t* vt, const int tid__) {
    const int tid = tid__;
    k0 = gld16(kt + tid * 8);
    if (DK == 96) { if (tid < 256) k1 = gld16(kt + (512 + tid) * 8); }
    v = gld16(vt + tid * 8);
}
template <int DK> DEV void att_lstore(const u4& k0, const u4& k1, const u4& v, int buf, const int tid__) {
    const int tid = tid__; const unsigned ks = buf ? AT_K1 : AT_K0, vs = buf ? AT_V1 : AT_V0;
    LDS_U4(ks + tid * 16) = k0;
    if (DK == 96) { if (tid < 256) LDS_U4(ks + (512 + tid) * 16) = k1; }
    LDS_U4(vs + tid * 16) = v;
}
template <int DK> DEV void att_dma(const bf16_t* kt, const bf16_t* vt, int buf, const int tid__) {
    const int tid = tid__; const unsigned ks = AT_K0 + buf * 12288, vs = AT_V0 + buf * 8192;
    GLDS16(kt + tid * 8, ks + tid * 16);
    if (DK == 96) { if (tid < 256) GLDS16(kt + (512 + tid) * 8, ks + (512 + tid) * 16); }
    GLDS16(vt + tid * 8, vs + tid * 16);
}
template <int DK> DEV void att_qk(f32x16& s0, f32x16& s1, int buf, const bf16x8 (&qf)[DK / 16], int lane) {
    const unsigned kb = (buf ? AT_K1 : AT_K0) + (lane >> 5) * 1024 + (lane & 31) * 16;
    s0 = f32x16{}; s1 = f32x16{};
#pragma unroll
    for (int d0 = 0; d0 < DK / 16; ++d0) { const bf16x8 a0 = LDS_BF8(kb + d0 * 2048), a1 = LDS_BF8(kb + d0 * 2048 + 512); s0 = MFMA32(a0, qf[d0], s0); s1 = MFMA32(a1, qf[d0], s1); }
}
#define PACK8(p, sp) __builtin_bit_cast(bf16x8, (u4){cvtpk((p)[8 * (sp) + 0], (p)[8 * (sp) + 1]), cvtpk((p)[8 * (sp) + 2], (p)[8 * (sp) + 3]), cvtpk((p)[8 * (sp) + 4], (p)[8 * (sp) + 5]), cvtpk((p)[8 * (sp) + 6], (p)[8 * (sp) + 7])})
DEV bf16x8 att_vfrag(unsigned a) { const s16x4 lo = lds_tr(a), h4 = lds_tr(a + 512); return (bf16x8){lo[0], lo[1], lo[2], lo[3], h4[0], h4[1], h4[2], h4[3]}; }
DEV void att_pv(f32x16& o0, f32x16& o1, int buf, const f32x16& p0, const f32x16& p1, int lane) {
    const unsigned vb = (buf ? AT_V1 : AT_V0) + (4 * (lane >> 5) + ((lane & 15) >> 2)) * 64 + ((lane >> 4) & 1) * 32 + (lane & 3) * 8;
#pragma unroll
    for (int kb = 0; kb < 2; ++kb)
#pragma unroll
        for (int sp = 0; sp < 2; ++sp) {
            const bf16x8 pf = kb ? PACK8(p1, sp) : PACK8(p0, sp); const unsigned a = vb + (32 * kb + 16 * sp) * 64;
            o0 = MFMA32(att_vfrag(a), pf, o0); o1 = MFMA32(att_vfrag(a + 4096), pf, o1);
        }
}
DEV float att_rowmax(const f32x16& p0, const f32x16& p1) {
    float m = __builtin_fmaxf(p0[0], p1[0]);
#pragma unroll
    for (int r = 1; r < 16; ++r) m = __builtin_fmaxf(m, __builtin_fmaxf(p0[r], p1[r]));
    return hmax(m);
}
template <bool BIAS> DEV void att_logits(f32x16& p0, f32x16& p1, int tq, int n0, int kmul, int kadd, int W, float c, int lutoff, bool selbit, int hi) {
#pragma unroll
    for (int r = 0; r < 16; ++r) {
        const int n = n0 + crow(r, hi);
        { const int dist = tq - (kmul * n + kadd); const bool ok = selbit && dist >= 0 && dist < W; float t = p0[r] * c;
          if (BIAS) { const int idx = dist < 0 ? 0 : (dist > 1023 ? 1023 : dist); t += LDS_F(AT_LUT + lutoff + idx * 4); }
          p0[r] = ok ? t : NEG_INF; }
        { const int dist = tq - (kmul * (n + 32) + kadd); const bool ok = selbit && dist >= 0 && dist < W; float t = p1[r] * c;
          if (BIAS) { const int idx = dist < 0 ? 0 : (dist > 1023 ? 1023 : dist); t += LDS_F(AT_LUT + lutoff + idx * 4); }
          p1[r] = ok ? t : NEG_INF; }
    }
}
DEV float att_rowmax_local(const f32x16& p0, const f32x16& p1) {
    float a = __builtin_fmaxf(p0[0], p1[0]), b = __builtin_fmaxf(p0[1], p1[1]);
#pragma unroll
    for (int r = 2; r < 16; r += 2) { a = __builtin_fmaxf(a, __builtin_fmaxf(p0[r], p1[r])); b = __builtin_fmaxf(b, __builtin_fmaxf(p0[r + 1], p1[r + 1])); }
    return __builtin_fmaxf(a, b);
}
typedef float f32x2 __attribute__((ext_vector_type(2)));
#define PAIR(p, k) ((f32x2){(p)[2 * (k)], (p)[2 * (k) + 1]})
#define UNPAIR(p, k, v) do { (p)[2 * (k)] = (v)[0]; (p)[2 * (k) + 1] = (v)[1]; } while (0)
template <bool FAST, bool FIXED = false> DEV void att_softmax(f32x16& p0, f32x16& p1, float& m, float& l, f32x16& o0, f32x16& o1, float c, float off0, bool sb) {
    if constexpr (FIXED) {
        const f32x2 c2 = {c, c}; f32x2 sa = {0.f, 0.f}, sc = {0.f, 0.f};
        if (FAST) { const float off = sb ? off0 - m : NEG_INF; const f32x2 off2 = {off, off};
#pragma unroll
            for (int k = 0; k < 8; ++k) { f32x2 u = PAIR(p0, k) * c2 + off2, v = PAIR(p1, k) * c2 + off2; u[0] = fexp2(u[0]); u[1] = fexp2(u[1]); v[0] = fexp2(v[0]); v[1] = fexp2(v[1]);
                sa += u; sc += v; UNPAIR(p0, k, u); UNPAIR(p1, k, v); }
        } else { const f32x2 mn2 = {m, m};
#pragma unroll
            for (int k = 0; k < 8; ++k) { f32x2 u = PAIR(p0, k) - mn2, v = PAIR(p1, k) - mn2; u[0] = fexp2(u[0]); u[1] = fexp2(u[1]); v[0] = fexp2(v[0]); v[1] = fexp2(v[1]);
                sa += u; sc += v; UNPAIR(p0, k, u); UNPAIR(p1, k, v); }
        }
        sa += sc; l += sa[0] + sa[1];
        return;
    }
    float mx; const f32x2 c2 = {c, c};
    if (FAST) {
        float a, b;
        { const f32x2 t0 = PAIR(p0, 0) * c2, t1 = PAIR(p1, 0) * c2; a = __builtin_fmaxf(t0[0], t0[1]); b = __builtin_fmaxf(t1[0], t1[1]); }
#pragma unroll
        for (int k = 1; k < 8; ++k) { const f32x2 t0 = PAIR(p0, k) * c2, t1 = PAIR(p1, k) * c2; a = __builtin_fmaxf(__builtin_fmaxf(a, t0[0]), t0[1]); b = __builtin_fmaxf(__builtin_fmaxf(b, t1[0]), t1[1]); }
        mx = hmax(__builtin_fmaxf(a, b)); mx = sb ? mx + off0 : NEG_INF;
    } else mx = hmax(att_rowmax_local(p0, p1));
    float mn = __builtin_fmaxf(m, mx);
    if (__any(mx > m + 8.f)) {
    const float al = fexp2(m - mn); l *= al; const f32x2 al2 = {al, al};
#pragma unroll
    for (int k = 0; k < 8; ++k) { const f32x2 x = PAIR(o0, k) * al2, y = PAIR(o1, k) * al2; UNPAIR(o0, k, x); UNPAIR(o1, k, y); }
    m = mn;
    } else mn = m;
    f32x2 sa = {0.f, 0.f}, sc = {0.f, 0.f};
    if (FAST) { const float off = sb ? off0 - mn : NEG_INF; const f32x2 off2 = {off, off};
#pragma unroll
        for (int k = 0; k < 8; ++k) { f32x2 u = PAIR(p0, k) * c2 + off2, v = PAIR(p1, k) * c2 + off2; u[0] = fexp2(u[0]); u[1] = fexp2(u[1]); v[0] = fexp2(v[0]); v[1] = fexp2(v[1]);
            sa += u; sc += v; UNPAIR(p0, k, u); UNPAIR(p1, k, v); }
    } else { const f32x2 mn2 = {mn, mn};
#pragma unroll
        for (int k = 0; k < 8; ++k) { f32x2 u = PAIR(p0, k) - mn2, v = PAIR(p1, k) - mn2; u[0] = fexp2(u[0]); u[1] = fexp2(u[1]); v[0] = fexp2(v[0]); v[1] = fexp2(v[1]);
            sa += u; sc += v; UNPAIR(p0, k, u); UNPAIR(p1, k, v); }
    }
    sa += sc; l += sa[0] + sa[1];
}
DEV int att_next(int j, int thi, bool usemask) {
    if (usemask) { while (j <= thi && !((LDS_U(AT_UN + (j >> 5) * 4) >> (j & 31)) & 1u)) ++j; }
    return j;
}
template <int DK, bool BIAS, bool FAST, bool FIXED = false>
DEV void att_seg(const bf16_t* Kimg, const bf16_t* Vimg, int j0, int j1, int thi, const bf16x8 (&qf)[DK / 16], int tq, int W, float c, int lutoff, float bfar,
                 float& m, float& l, f32x16& o0, f32x16& o1, const int tid__, int& buf, int kmul, int kadd) {
    const int lane = tid__ & 63, hi = lane >> 5;
    for (int j = j0; j <= j1; ++j) {
        if (j < thi) att_dma<DK>(Kimg + (long)(j + 1) * (DK * 64), Vimg + (long)(j + 1) * 4096, buf ^ 1, tid__);
        bool skip = false, wfast = false;
        if (!FAST) { const int wlo = __builtin_amdgcn_readlane(tq, 0), whi = __builtin_amdgcn_readlane(tq, 31);
            const int pmin = kmul * (64 * j) + kadd, pmax = kmul * (64 * j + 63) + kadd;
            skip = pmin > whi || wlo - pmax >= W;
            if (!BIAS) wfast = pmax <= wlo && whi - pmin < W; }
        if (!skip) {
        f32x16 p0, p1;
        att_qk<DK>(p0, p1, buf, qf, lane);
        if (FAST || wfast) att_softmax<true, FIXED>(p0, p1, m, l, o0, o1, c, bfar, true);
        else { int tq_ = tq, hi_ = hi; asm volatile("" : "+v"(tq_), "+v"(hi_));
               att_logits<BIAS>(p0, p1, tq_, 64 * j, kmul, kadd, W, c, lutoff, true, hi_); att_softmax<false, FIXED>(p0, p1, m, l, o0, o1, c, 0.f, true); }
        att_pv(o0, o1, buf, p0, p1, lane);
        }
        __syncthreads();
        buf ^= 1;
    }
}
template <int DK, bool BIAS, bool SEL, bool FASTB = false, bool FIXED = false>
DEV void att_run(const bf16_t* Kimg, const bf16_t* Vimg, int tlo, int thi, const bf16x8 (&qf)[DK / 16], int tq, int W, float c, int lutoff,
                 const unsigned (&sw)[4], float& m, float& l, f32x16& o0, f32x16& o1, const int tid__, int q0, int qspan, int kmul = 1, int kadd = 0) {
    static_assert(!SEL, "mask-driven tile walks are handled by the compacted selected branch");
    if (tlo > thi) return;
    int buf = 0;
    att_dma<DK>(Kimg + (long)tlo * (DK * 64), Vimg + (long)tlo * 4096, 0, tid__);
    const float bfar = BIAS ? LDS_F(AT_LUT + lutoff + 1023 * 4) : 0.f;
    __syncthreads();
    int jf = tlo - 1;
    if ((!BIAS || FASTB) && W == (1 << 30)) { const int thr = BIAS ? 790 : 0; const int num = q0 - thr - kadd - 63 * kmul;
        if (num >= 0) { jf = num / (64 * kmul); jf = jf > thi ? thi : jf; } }
    if (!BIAS || FASTB) att_seg<DK, BIAS, true, FIXED>(Kimg, Vimg, tlo, jf, thi, qf, tq, W, c, lutoff, bfar, m, l, o0, o1, tid__, buf, kmul, kadd);
    att_seg<DK, BIAS, false, FIXED>(Kimg, Vimg, jf + 1 > tlo ? jf + 1 : tlo, thi, thi, qf, tq, W, c, lutoff, bfar, m, l, o0, o1, tid__, buf, kmul, kadd);
}
DEV void att_store_out(bf16_t* orow, const f32x16& o0, const f32x16& o1, int hi) {
#pragma unroll
    for (int a = 0; a < 4; a += 2) {
        gst16(orow + 8 * a + 8 * hi, pair_swap(pack4(o0[4 * a], o0[4 * a + 1], o0[4 * a + 2], o0[4 * a + 3]), pack4(o0[4 * a + 4], o0[4 * a + 5], o0[4 * a + 6], o0[4 * a + 7])));
        gst16(orow + 32 + 8 * a + 8 * hi, pair_swap(pack4(o1[4 * a], o1[4 * a + 1], o1[4 * a + 2], o1[4 * a + 3]), pack4(o1[4 * a + 4], o1[4 * a + 5], o1[4 * a + 6], o1[4 * a + 7])));
    }
}
template <int NQ> DEV void att_loadq(bf16x8 (&qf)[NQ], const bf16_t* qrow, int hi) {
#pragma unroll
    for (int d0 = 0; d0 < NQ; ++d0) qf[d0] = __builtin_bit_cast(bf16x8, gld16(qrow + d0 * 16 + hi * 8));
}
DEV void att_load_lut(const float* lut2, const int tid__) {
    for (int i = tid__; i < 2048; i += 512) LDS_F(AT_LUT + i * 4) = gldf(lut2 + i);
}

DEV void attn_swa(const int tid__, const Args& a, int l, int b, int hk, int qb) {
    unsigned char* ws = a.ws; const int lane = tid__ & 63, wid = __builtin_amdgcn_readfirstlane(tid__ >> 6), l31 = lane & 31, hi = lane >> 5, g = l31 >> 4;
    const int h = hk * 2 + g, q0 = qb * 128, tq = q0 + 16 * wid + (l31 & 15);
    att_load_lut((const float*)(ws + W_LUT) + (hk * 2) * 1024, tid__);
    bf16x8 qf[4]; att_loadq<4>(qf, (const bf16_t*)(ws + X_QSW) + ((long)(b * 4 + h) * S_ + tq) * 64, hi);
    float m = gldf(a.in[6] + l * 4 + h) * LOG2E, ls = hi ? 0.f : 1.f; f32x16 o0 = f32x16{}, o1 = f32x16{};
    const unsigned sw[4] = {0, 0, 0, 0};
    const float fb = gldf((const float*)(ws + W_MLAB) + 16 + l * 32 + 2 * 8 + h);
    __syncthreads();
    const int tlo = q0 / 64 - 2 < 0 ? 0 : q0 / 64 - 2;
    if (__all(fb < 1e20f && m - fb < 100.f)) { ls = hi ? 0.f : fexp2(m - fb); m = fb;
    att_run<64, true, false, false, true>((const bf16_t*)(ws + A_KSW) + (long)(b * 2 + hk) * 128 * 4096, (const bf16_t*)(ws + A_VSW) + (long)(b * 2 + hk) * 128 * 4096,
                             tlo, q0 / 64 + 1, qf, tq, 128, 0.125f * LOG2E, g * 4096, sw, m, ls, o0, o1, tid__, q0, 128);
    } else
    att_run<64, true, false>((const bf16_t*)(ws + A_KSW) + (long)(b * 2 + hk) * 128 * 4096, (const bf16_t*)(ws + A_VSW) + (long)(b * 2 + hk) * 128 * 4096,
                             tlo, q0 / 64 + 1, qf, tq, 128, 0.125f * LOG2E, g * 4096, sw, m, ls, o0, o1, tid__, q0, 128);
    const float inv = frcp(hsum(ls));
#pragma unroll
    for (int r = 0; r < 16; ++r) { o0[r] *= inv; o1[r] *= inv; }
    att_store_out((bf16_t*)(ws + P_ORAW) + (long)(b * S_ + tq) * 1024 + 256 + h * 64, o0, o1, hi);
    __syncthreads();
}
DEV void attn_mla(const int tid__, const Args& a, int l, int b, int h, int qb) {
    unsigned char* ws = a.ws; const int lane = tid__ & 63, wid = __builtin_amdgcn_readfirstlane(tid__ >> 6), l31 = lane & 31, hi = lane >> 5;
    const int q0 = qb * 256, tq = q0 + 32 * wid + l31;
    bf16x8 qf[6]; att_loadq<6>(qf, (const bf16_t*)(ws + A_QM) + ((long)(b * 4 + h) * S_ + tq) * 96, hi);
    float m = -1e30f, ls = 0.f; f32x16 o0 = f32x16{}, o1 = f32x16{};
    const unsigned sw[4] = {0, 0, 0, 0};
    const float mb = gldf((const float*)(ws + W_MLAB) + l);
    if (mb <= 60.f) { m = mb;
    att_run<96, false, false, false, true>((const bf16_t*)(ws + A_KM) + (long)(b * 4 + h) * 128 * 6144, (const bf16_t*)(ws + A_VM) + (long)(b * 4 + h) * 128 * 4096,
                              0, q0 / 64 + 3, qf, tq, 1 << 30, 0.10206207261596577f * LOG2E, 0, sw, m, ls, o0, o1, tid__, q0, 256);
    } else
    att_run<96, false, false>((const bf16_t*)(ws + A_KM) + (long)(b * 4 + h) * 128 * 6144, (const bf16_t*)(ws + A_VM) + (long)(b * 4 + h) * 128 * 4096,
                              0, q0 / 64 + 3, qf, tq, 1 << 30, 0.10206207261596577f * LOG2E, 0, sw, m, ls, o0, o1, tid__, q0, 256);
    const float inv = frcp(hsum(ls));
#pragma unroll
    for (int r = 0; r < 16; ++r) { o0[r] *= inv; o1[r] *= inv; }
    att_store_out((bf16_t*)(ws + P_ORAW) + (long)(b * S_ + tq) * 1024 + 768 + h * 64, o0, o1, hi);
}
DEV void attn_sb(const int tid__, const Args& a, int l, int b, int h, int qb) {
    unsigned char* ws = a.ws; const int lane = tid__ & 63, wid = __builtin_amdgcn_readfirstlane(tid__ >> 6), l31 = lane & 31, hi = lane >> 5;
    const int q0 = qb * 256, tq = q0 + 32 * wid + l31;
    bf16x8 qf[4]; att_loadq<4>(qf, (const bf16_t*)(ws + X_QSB) + ((long)(b * 4 + h) * S_ + tq) * 64, hi);
    const bf16_t* Kimg = (const bf16_t*)(ws + X_KSB) + (long)(b * 4 + h) * 128 * 4096; const bf16_t* Vimg = (const bf16_t*)(ws + X_VSB) + (long)(b * 4 + h) * 128 * 4096;
    f32x16 o0 = f32x16{}, o1 = f32x16{}; float carry = 1.f;
    if (tid__ < 3) LDS_I(AT_ALIVE + tid__ * 4) = 0;
    u4 k0, k1, v; int buf = 0, j = q0 / 64 + 3, it = 0;
    att_gload<64>(k0, k1, v, Kimg + (long)j * 4096, Vimg + (long)j * 4096, tid__); att_lstore<64>(k0, k1, v, 0, tid__);
    __syncthreads();
    for (;;) {
        const int jn = j - 1;
        if (jn >= 0) att_gload<64>(k0, k1, v, Kimg + (long)jn * 4096, Vimg + (long)jn * 4096, tid__);
        if (tid__ == 0) LDS_I(AT_ALIVE + ((it + 1) % 3) * 4) = 0;
        const bool skip = 64 * j >= __builtin_amdgcn_readfirstlane(tq - l31) + 31;
        if (!skip) {
        f32x16 p0, p1, g0, g1;
        att_qk<64>(p0, p1, buf, qf, lane);
#pragma unroll
        for (int r = 0; r < 16; ++r) {
            const int key = 64 * j + crow(r, hi);
            { const bool ok = key < tq; const float z = __builtin_fminf(p0[r] * 0.125f, 80.f); const float e = fexp2(z * LOG2E), rr = frcp(1.f + e); p0[r] = ok ? rr : 1.f; g0[r] = ok ? e * rr : 0.f; }
            { const bool ok = key + 32 < tq; const float z = __builtin_fminf(p1[r] * 0.125f, 80.f); const float e = fexp2(z * LOG2E), rr = frcp(1.f + e); p1[r] = ok ? rr : 1.f; g1[r] = ok ? e * rr : 0.f; }
        }
        float gp[2][4], go[2][4], sg[2][4];
#pragma unroll
        for (int q = 0; q < 4; ++q) { gp[0][q] = p0[4 * q] * p0[4 * q + 1] * p0[4 * q + 2] * p0[4 * q + 3]; gp[1][q] = p1[4 * q] * p1[4 * q + 1] * p1[4 * q + 2] * p1[4 * q + 3]; }
#pragma unroll
        for (int kb = 0; kb < 2; ++kb)
#pragma unroll
            for (int q = 0; q < 4; ++q) go[kb][q] = hother(gp[kb][q], hi);
        float run = carry;
#pragma unroll
        for (int kb = 1; kb >= 0; --kb)
#pragma unroll
            for (int q = 3; q >= 0; --q) {
                const float gh1 = hi ? gp[kb][q] : go[kb][q], gh0 = hi ? go[kb][q] : gp[kb][q];
                const float s1 = run; run *= gh1; const float s0 = run; run *= gh0; sg[kb][q] = hi ? s1 : s0;
            }
        carry = run;
#pragma unroll
        for (int q = 0; q < 4; ++q) {
            { const float e3 = sg[0][q], e2 = e3 * p0[4 * q + 3], e1 = e2 * p0[4 * q + 2], e0 = e1 * p0[4 * q + 1];
              p0[4 * q] = g0[4 * q] * e0; p0[4 * q + 1] = g0[4 * q + 1] * e1; p0[4 * q + 2] = g0[4 * q + 2] * e2; p0[4 * q + 3] = g0[4 * q + 3] * e3; }
            { const float e3 = sg[1][q], e2 = e3 * p1[4 * q + 3], e1 = e2 * p1[4 * q + 2], e0 = e1 * p1[4 * q + 1];
              p1[4 * q] = g1[4 * q] * e0; p1[4 * q + 1] = g1[4 * q + 1] * e1; p1[4 * q + 2] = g1[4 * q + 2] * e2; p1[4 * q + 3] = g1[4 * q + 3] * e3; }
        }
        att_pv(o0, o1, buf, p0, p1, lane);
        }
        if (__any(carry >= 1e-30f) && lane == 0) LDS_I(AT_ALIVE + (it % 3) * 4) = 1;
        if (jn >= 0) att_lstore<64>(k0, k1, v, buf ^ 1, tid__);
        __syncthreads();
        const int alive = LDS_I(AT_ALIVE + (it % 3) * 4);
        if (jn < 0 || !alive) break;
        j = jn; buf ^= 1; ++it;
    }
    att_store_out((bf16_t*)(ws + P_ORAW) + (long)(b * S_ + tq) * 1024 + h * 64, o0, o1, hi);
    __syncthreads();
}

#define RLX_AGENT __ATOMIC_RELAXED, __HIP_MEMORY_SCOPE_AGENT
DEV void att_store_out_wt(bf16_t* orow, const f32x16& o0, const f32x16& o1, int hi) {
#pragma unroll
    for (int q = 0; q < 4; ++q) {
        const unsigned long long w0 = (unsigned long long)cvtpk(o0[4 * q], o0[4 * q + 1]) | ((unsigned long long)cvtpk(o0[4 * q + 2], o0[4 * q + 3]) << 32);
        const unsigned long long w1 = (unsigned long long)cvtpk(o1[4 * q], o1[4 * q + 1]) | ((unsigned long long)cvtpk(o1[4 * q + 2], o1[4 * q + 3]) << 32);
        __hip_atomic_store((GAS unsigned long long*)(orow + 8 * q + 4 * hi), w0, RLX_AGENT); __hip_atomic_store((GAS unsigned long long*)(orow + 32 + 8 * q + 4 * hi), w1, RLX_AGENT);
    }
}
#ifndef PROBE_NSA
#define PROBE_NSA 0
#endif
DEV void attn_nsa_a(const int tid__, const Args& a, int l, int b, int hk, int qb) {
    unsigned char* ws = a.ws; const int lane = tid__ & 63, wid = __builtin_amdgcn_readfirstlane(tid__ >> 6), l31 = lane & 31, hi = lane >> 5, g = l31 >> 4;
    const int h = hk * 2 + g, q0 = qb * 128, tq = q0 + 16 * wid + (l31 & 15);
    const float c = 0.125f * LOG2E; const int lutoff = g * 4096;
    att_load_lut((const float*)(ws + W_LUT) + (4 + hk * 2) * 1024, tid__);
    if (tid__ < 4) LDS_U(AT_UN + tid__ * 4) = 0u;
    for (int i = lane; i < 16 * 129; i += 64) LDS_F(AT_IMP + wid * (16 * 129 * 4) + i * 4) = 0.f;
    const bf16_t* qrow = (const bf16_t*)(ws + A_QN) + ((long)(b * 4 + h) * S_ + tq) * 64;
    const float* gt = (const float*)(ws + A_GATES) + (long)(b * S_ + tq) * 12 + h;
#define NSA_LOADQ() bf16x8 qf[4]; { const bf16_t* q_ = qrow; asm volatile("" : "+v"(q_)); att_loadq<4>(qf, q_, hi); }
    const int sbase = b * 2 + hk;
    const bf16_t* Kc = (const bf16_t*)(ws + A_KC) + (long)sbase * 8 * 4096; const bf16_t* Vc = (const bf16_t*)(ws + A_VC) + (long)sbase * 8 * 4096;
    __syncthreads();
    const int Tmax = ((q0 + 127 - 31) >> 4) >> 6;
    const unsigned sw[4] = {0u, 0u, 0u, 0u};
    float m = -1e30f, ls = 0.f; u4 kp0;
    const float gate_c = gldf(gt);
    for (int rep_ = 0; rep_ < ((PROBE_NSA & 16) ? 3 : 1); ++rep_)
    {
        m = -1e30f; ls = 0.f;
        f32x16 o0 = f32x16{}, o1 = f32x16{}; NSA_LOADQ();
        const float fb = gldf((const float*)(ws + W_MLAB) + 16 + l * 32 + 0 * 8 + h);
        if (__all(fb < 1e20f)) { m = fb; att_run<64, true, false, true, true>(Kc, Vc, 0, Tmax, qf, tq, 1 << 30, c, lutoff, sw, m, ls, o0, o1, tid__, q0, 128, 16, 31); }
        else
        att_run<64, true, false, true>(Kc, Vc, 0, Tmax, qf, tq, 1 << 30, c, lutoff, sw, m, ls, o0, o1, tid__, q0, 128, 16, 31);
        kp0 = gld16(Kc + tid__ * 8);
        const float lt0 = hsum(ls); const float sc = lt0 > 0.f ? gate_c * frcp(lt0) : 0.f;
#pragma unroll
        for (int r = 0; r < 16; ++r) { o0[r] *= sc; o1[r] *= sc; }
        att_store_out_wt((bf16_t*)(ws + P_ORAW) + (long)(b * S_ + tq) * 1024 + 512 + h * 64, o0, o1, hi);
    }
    const float lt = hsum(ls); const float linv = lt > 0.f ? frcp(lt) : 0.f;
    {
        const unsigned ib = AT_IMP + wid * (16 * 129 * 4) + (l31 & 15) * (129 * 4); NSA_LOADQ();
        int buf = 0; float carry = 0.f;
        LDS_U4(AT_K0 + tid__ * 16) = kp0;
        __syncthreads();
        for (int T = 0; T <= Tmax; ++T) {
            if (T < Tmax) kp0 = gld16(Kc + (long)(T + 1) * 4096 + tid__ * 8);
            f32x16 p0, p1; att_qk<64>(p0, p1, buf, qf, lane);
            if (q0 - (16 * (64 * T + 63) + 31) >= 790) {
                const float off = LDS_F(AT_LUT + lutoff + 1023 * 4) - m;
#pragma unroll
                for (int r = 0; r < 16; ++r) { p0[r] = fexp2(__builtin_fmaf(p0[r], c, off)) * linv; p1[r] = fexp2(__builtin_fmaf(p1[r], c, off)) * linv; }
            } else {
                { int tq_ = tq, hi_ = hi; asm volatile("" : "+v"(tq_), "+v"(hi_)); att_logits<true>(p0, p1, tq_, 64 * T, 16, 31, 1 << 30, c, lutoff, true, hi_); }
#pragma unroll
                for (int r = 0; r < 16; ++r) { p0[r] = fexp2(p0[r] - m) * linv; p1[r] = fexp2(p1[r] - m) * linv; }
            }
            float tprev = carry;
#pragma unroll
            for (int kb = 0; kb < 2; ++kb)
#pragma unroll
                for (int q = 0; q < 4; ++q) {
                    const float e3 = kb ? p1[4 * q + 3] : p0[4 * q + 3];
                    const float sum4 = kb ? (p1[4 * q] + p1[4 * q + 1]) + (p1[4 * q + 2] + e3) : (p0[4 * q] + p0[4 * q + 1]) + (p0[4 * q + 2] + e3);
                    const float tq_ = hother(e3, hi);
                    float e = sum4 + (hi ? tq_ : tprev);
                    e += __shfl_xor(e, 16);
                    if (g == 0) LDS_F(ib + (16 * T + 8 * kb + 2 * q + hi) * 4) = e;
                    tprev = tq_;
                }
            carry = tprev;
            if (T < Tmax) LDS_U4((buf ? AT_K0 : AT_K1) + tid__ * 16) = kp0;
            __syncthreads();
            buf ^= 1;
        }
    }
    for (int rep_ = 0; rep_ < ((PROBE_NSA & 8) ? 3 : 1); ++rep_)
    {
        const int qq = lane & 15, part = lane >> 4; const int tqq = q0 + 16 * wid + qq, cur = tqq >> 6; unsigned kk[32];
        const unsigned ib = AT_IMP + wid * (16 * 129 * 4) + qq * (129 * 4) + part * 128;
#pragma unroll
        for (int i = 0; i < 32; ++i) {
            const float v = LDS_F(ib + i * 4); const int j = 32 * part + i; const bool valid = j <= cur, forced = (j == 0) || (j == cur) || (j == cur - 1);
            kk[i] = !valid ? 0u : (forced ? (0x7fffff00u | (unsigned)(255 - j)) : ((__float_as_uint(v) & 0xffffff00u) | (unsigned)(255 - j)));
        }
        unsigned thr = 0u, ncur = 255u;
        {
            const unsigned cand = 1u << 30; unsigned cnt = 0u;
#pragma unroll
            for (int i = 0; i < 32; ++i) cnt += (kk[i] >= cand) ? 1u : 0u;
            cnt += __shfl_xor(cnt, 16); cnt += __shfl_xor(cnt, 32);
            if (cnt >= 16u) { thr = cand; ncur = cnt; }
        }
#pragma unroll 1
        for (int bit = 28; bit >= 0; bit -= 2) {
            if (__all(ncur == 16u)) break;
            const unsigned c1 = thr | (1u << bit), c2 = thr | (2u << bit), c3 = thr | (3u << bit); unsigned cnt = 0u;
#pragma unroll
            for (int i = 0; i < 32; ++i) cnt += ((kk[i] >= c1) ? 1u : 0u) + ((kk[i] >= c2) ? 0x100u : 0u) + ((kk[i] >= c3) ? 0x10000u : 0u);
            cnt += __shfl_xor(cnt, 16); cnt += __shfl_xor(cnt, 32);
            const unsigned n3 = (cnt >> 16) & 0xffu, n2 = (cnt >> 8) & 0xffu, n1 = cnt & 0xffu;
            if (n3 >= 16u) { thr = c3; ncur = n3; } else if (n2 >= 16u) { thr = c2; ncur = n2; } else if (n1 >= 16u) { thr = c1; ncur = n1; }
        }
        thr = thr < 1u ? 1u : thr;
        unsigned w = 0u;
#pragma unroll
        for (int i = 0; i < 32; ++i) w |= (kk[i] >= thr ? 1u : 0u) << i;
        __hip_atomic_store((GAS unsigned*)((unsigned*)(ws + MS_SELM) + ((long)sbase * 8192 + tqq) * 4 + part), w, RLX_AGENT);
        atomicOr((unsigned*)(smem + AT_UN + part * 4), w);
    }
    __syncthreads();
    if (tid__ < 4) __hip_atomic_store((GAS unsigned*)((unsigned*)(ws + MS_UNM) + (sbase * 64 + qb) * 4 + tid__), LDS_U(AT_UN + tid__ * 4), RLX_AGENT);
    asm volatile("s_waitcnt vmcnt(0)" ::: "memory");
    __syncthreads();
    if (tid__ == 0) __hip_atomic_store((GAS unsigned*)((unsigned*)(ws + WS_CTL) + CW_NSAF + l * 1024 + sbase * 64 + qb), 1u, RLX_AGENT);
    __syncthreads();
}
DEV float sb_bmax(const float* rel_bias, int h) {
    float m = gldf(rel_bias + 4 + h);
#pragma unroll 4
    for (int k = 1; k < 32; ++k) m = __builtin_fmaxf(m, gldf(rel_bias + k * 8 + 4 + h));
    return m;
}
DEV void attn_nsa_b(const int tid__, const Args& a, int l, int b, int hk, int qb) {
    unsigned char* ws = a.ws; const int lane = tid__ & 63, wid = __builtin_amdgcn_readfirstlane(tid__ >> 6), l31 = lane & 31, hi = lane >> 5, g = l31 >> 4;
    const int h = hk * 2 + g, q0 = qb * 128, tq = q0 + 16 * wid + (l31 & 15);
    const float c = 0.125f * LOG2E; const int lutoff = g * 4096; const int sbase = b * 2 + hk;
    att_load_lut((const float*)(ws + W_LUT) + (4 + hk * 2) * 1024, tid__);
    if (tid__ == 0) { GAS unsigned* f = (GAS unsigned*)((unsigned*)(ws + WS_CTL) + CW_NSAF + l * 1024 + sbase * 64 + qb); unsigned sp = 0;
        while (__hip_atomic_load(f, RLX_AGENT) == 0u && ++sp < (1u << 22)) __builtin_amdgcn_s_sleep(2); }
    __syncthreads();
    if (tid__ < 4) LDS_U(AT_UN + tid__ * 4) = __hip_atomic_load((GAS unsigned*)((unsigned*)(ws + MS_UNM) + (sbase * 64 + qb) * 4 + tid__), RLX_AGENT);
    unsigned sw[4];
    { GAS unsigned long long* mp = (GAS unsigned long long*)((unsigned*)(ws + MS_SELM) + ((long)sbase * 8192 + tq) * 4);
      const unsigned long long m0 = __hip_atomic_load(mp, RLX_AGENT), m1 = __hip_atomic_load(mp + 1, RLX_AGENT);
      sw[0] = (unsigned)m0; sw[1] = (unsigned)(m0 >> 32); sw[2] = (unsigned)m1; sw[3] = (unsigned)(m1 >> 32); }
    const bf16_t* qrow = (const bf16_t*)(ws + A_QN) + ((long)(b * 4 + h) * S_ + tq) * 64;
    const float* gt = (const float*)(ws + A_GATES) + (long)(b * S_ + tq) * 12 + h;
    const unsigned stash = AT_IMP + wid * (16 * 129 * 4) + lane * 4;
    __syncthreads();
    for (int rep_ = 0; rep_ < ((PROBE_NSA & 2) ? 2 : 1); ++rep_)
    {
        for (int i = tid__; i < 512; i += 512) LDS_U(SB_SM + i * 4) = __hip_atomic_load((GAS unsigned*)((unsigned*)(ws + MS_SELM) + ((long)sbase * 8192 + q0) * 4 + i), RLX_AGENT);
        for (int i = tid__; i < 256 * 65 + 256; i += 512) LDS_I(SB_O + i * 4) = 0;
        if (tid__ == 0) LDS_I(SB_CTR) = 0;
        float gq = __builtin_fabsf(gldf(a.in[7] + l * 64 + lane)), gk = __builtin_fabsf(gldf(a.in[8] + (l * 3 + 1) * 64 + lane));
#pragma unroll
        for (int mk = 1; mk < 64; mk <<= 1) { gq = __builtin_fmaxf(gq, __shfl_xor(gq, mk)); gk = __builtin_fmaxf(gk, __shfl_xor(gk, mk)); }
        __syncthreads();
        const unsigned vpriv = wid < 5 ? AT_K0 + wid * 8192 : SB_VX + (wid - 5) * 8192;
        const bf16_t* Kimg = (const bf16_t*)(ws + A_KNS) + (long)sbase * 128 * 4096; const bf16_t* Vimg = (const bf16_t*)(ws + A_VNS) + (long)sbase * 128 * 4096;
        const bf16_t* Qb = (const bf16_t*)(ws + A_QN) + ((long)(b * 4 + h) * S_ + q0) * 64 + hi * 8;
        const float mref = (8.0f * gq * gk + 0.01f) * LOG2E + sb_bmax(a.in[1], h) * LOG2E;
        const int jmax = (q0 + 127) >> 6;
        constexpr float SCL_L = 2095000.f;
        const float vmax = __builtin_fmaxf(__uint_as_float(xb_ld((unsigned*)(ws + WS_CTL) + CW_VMAX + l * 16 + sbase)), 1e-20f); const float scl_o = 2095000.f / vmax; const float lscl = __builtin_amdgcn_logf(scl_o);
        for (;;) {
            int ti = 0; if (lane == 0) ti = atomicAdd((int*)(smem + SB_CTR), 1);
            ti = __builtin_amdgcn_readfirstlane(ti);
            if (ti > jmax) break;
            const int j = jmax < 4 ? ti : (ti < 3 ? jmax - ti : (ti == 3 ? 0 : jmax - ti + 1));
            const unsigned wa = LDS_U(SB_SM + (lane * 4 + (j >> 5)) * 4), wb = LDS_U(SB_SM + ((lane + 64) * 4 + (j >> 5)) * 4);
            const unsigned long long ma = __ballot((wa >> (j & 31)) & 1u), mb = __ballot((wb >> (j & 31)) & 1u);
            const int na = __popcll(ma), n = na + __popcll(mb);
            if (n == 0) continue;
            const unsigned long long below = (1ull << lane) - 1ull;
            if ((ma >> lane) & 1ull) *(LAS unsigned char*)((LAS char*)smem + SB_LIST + wid * 128 + __popcll(ma & below)) = (unsigned char)lane;
            if ((mb >> lane) & 1ull) *(LAS unsigned char*)((LAS char*)smem + SB_LIST + wid * 128 + na + __popcll(mb & below)) = (unsigned char)(lane + 64);
            const bf16_t* kt = Kimg + (long)j * 4096 + hi * 512 + l31 * 8; bf16x8 kf[8];
#pragma unroll
            for (int d0 = 0; d0 < 4; ++d0) { kf[2 * d0] = __builtin_bit_cast(bf16x8, gld16(kt + d0 * 1024)); kf[2 * d0 + 1] = __builtin_bit_cast(bf16x8, gld16(kt + d0 * 1024 + 256)); }
            { const bf16_t* vt = Vimg + (long)j * 4096;
#pragma unroll
              for (int i = 0; i < 8; ++i) LDS_U4(vpriv + (lane + 64 * i) * 16) = gld16(vt + (lane + 64 * i) * 8); }
            const bool far = q0 - (64 * j + 63) >= 790; const float bfar = LDS_F(AT_LUT + lutoff + 1023 * 4);
            const int ntask = (n + 15) >> 4;
            bf16x8 qq[4]; int qi = *(LAS unsigned char*)((LAS char*)smem + SB_LIST + wid * 128 + ((l31 & 15) < n ? (l31 & 15) : 0));
#pragma unroll
            for (int d0 = 0; d0 < 4; ++d0) qq[d0] = __builtin_bit_cast(bf16x8, gld16(Qb + (long)qi * 64 + d0 * 16));
            for (int task = 0; task < ntask; ++task) {
                const int idx = 16 * task + (l31 & 15); const bool valid = idx < n;
                const int tqq = q0 + qi, colg = qi * 2 + g;
                const int idn = idx + 16; const int qin = *(LAS unsigned char*)((LAS char*)smem + SB_LIST + wid * 128 + (idn < n ? idn : 0)); bf16x8 qn[4];
#pragma unroll
                for (int d0 = 0; d0 < 4; ++d0) qn[d0] = __builtin_bit_cast(bf16x8, gld16(Qb + (long)qin * 64 + d0 * 16));
                f32x16 p0 = f32x16{}, p1 = f32x16{};
#pragma unroll
                for (int d0 = 0; d0 < 4; ++d0) { p0 = MFMA32(kf[2 * d0], qq[d0], p0); p1 = MFMA32(kf[2 * d0 + 1], qq[d0], p1); }
                float ssum; const float offv = (valid ? lscl : NEG_INF) - mref;
                if (far) {
                    const f32x2 c2 = {c, c}, off2 = {bfar + offv, bfar + offv}; f32x2 sa = {0.f, 0.f}, sc2 = {0.f, 0.f};
#pragma unroll
                    for (int k = 0; k < 8; ++k) { f32x2 u = PAIR(p0, k) * c2 + off2, v = PAIR(p1, k) * c2 + off2; u[0] = fexp2(u[0]); u[1] = fexp2(u[1]); v[0] = fexp2(v[0]); v[1] = fexp2(v[1]);
                        sa += u; sc2 += v; UNPAIR(p0, k, u); UNPAIR(p1, k, v); }
                    sa += sc2; ssum = sa[0] + sa[1];
                } else {
                    ssum = 0.f;
#pragma unroll
                    for (int r = 0; r < 16; ++r) {
                        const int d0_ = tqq - (64 * j + crow(r, hi)), d1_ = d0_ - 32;
                        const float b0 = LDS_F(AT_LUT + lutoff + (d0_ < 0 ? 0 : (d0_ > 1023 ? 1023 : d0_)) * 4), b1 = LDS_F(AT_LUT + lutoff + (d1_ < 0 ? 0 : (d1_ > 1023 ? 1023 : d1_)) * 4);
                        p0[r] = d0_ >= 0 ? fexp2(__builtin_fmaf(p0[r], c, b0 + offv)) : 0.f;
                        p1[r] = d1_ >= 0 ? fexp2(__builtin_fmaf(p1[r], c, b1 + offv)) : 0.f;
                        ssum += p0[r] + p1[r];
                    }
                }
                f32x16 o0 = f32x16{}, o1 = f32x16{};
                {   const unsigned vb = vpriv + (4 * hi + ((lane & 15) >> 2)) * 64 + ((lane >> 4) & 1) * 32 + (lane & 3) * 8;
#pragma unroll
                    for (int kb = 0; kb < 2; ++kb)
#pragma unroll
                        for (int sp = 0; sp < 2; ++sp) { const bf16x8 pf = kb ? PACK8(p1, sp) : PACK8(p0, sp); const unsigned av = vb + (32 * kb + 16 * sp) * 64;
                            o0 = MFMA32(att_vfrag(av), pf, o0); o1 = MFMA32(att_vfrag(av + 4096), pf, o1); } }
                if (valid) {
                    atomicAdd((int*)(smem + SB_L + colg * 4), (int)__builtin_rintf(ssum * vmax));
                    const unsigned ob = SB_O + (colg * 65 + 4 * hi) * 4;
#pragma unroll
                    for (int r = 0; r < 16; ++r) { atomicAdd((int*)(smem + ob + ((r & 3) + 8 * (r >> 2)) * 4), (int)o0[r]); atomicAdd((int*)(smem + ob + (32 + (r & 3) + 8 * (r >> 2)) * 4), (int)o1[r]); }
                }
                qi = qin;
#pragma unroll
                for (int d0 = 0; d0 < 4; ++d0) qq[d0] = qn[d0];
            }
        }
        __syncthreads();
        {
            const int colg = (16 * wid + (l31 & 15)) * 2 + g; const float t2 = (float)LDS_I(SB_L + colg * 4) * (1.f / SCL_L); const float sc = t2 > 0.f ? gldf(gt + 4) * frcp(t2) * frcp(scl_o) : 0.f;
            f32x16 o0, o1; const unsigned ob = SB_O + (colg * 65 + 4 * hi) * 4;
#pragma unroll
            for (int r = 0; r < 16; ++r) { o0[r] = sc * (float)LDS_I(ob + ((r & 3) + 8 * (r >> 2)) * 4); o1[r] = sc * (float)LDS_I(ob + (32 + (r & 3) + 8 * (r >> 2)) * 4); }
            __syncthreads();
#pragma unroll
            for (int r = 0; r < 16; ++r) { LDS_F(stash + r * 256) = o0[r]; LDS_F(stash + 4096 + r * 256) = o1[r]; }
        }
        __syncthreads();
    }
    f32x16 f0, f1;
    for (int rep_ = 0; rep_ < ((PROBE_NSA & 4) ? 2 : 1); ++rep_)
    {
        float mw = -1e30f, l3 = 0.f; f32x16 o0 = f32x16{}, o1 = f32x16{}; NSA_LOADQ();
        const int tlo = q0 / 64 - 8 < 0 ? 0 : q0 / 64 - 8;
        const float fb = gldf((const float*)(ws + W_MLAB) + 16 + l * 32 + 1 * 8 + h);
        if (__all(fb < 1e20f)) { mw = fb;
        att_run<64, true, false, false, true>((const bf16_t*)(ws + A_KNW) + (long)sbase * 128 * 4096, (const bf16_t*)(ws + A_VNW) + (long)sbase * 128 * 4096,
                                 tlo, q0 / 64 + 1, qf, tq, 512, c, lutoff, sw, mw, l3, o0, o1, tid__, q0, 128);
        } else
        att_run<64, true, false>((const bf16_t*)(ws + A_KNW) + (long)sbase * 128 * 4096, (const bf16_t*)(ws + A_VNW) + (long)sbase * 128 * 4096,
                                 tlo, q0 / 64 + 1, qf, tq, 512, c, lutoff, sw, mw, l3, o0, o1, tid__, q0, 128);
        const float t3 = hsum(l3); const float sc = t3 > 0.f ? gldf(gt + 8) * frcp(t3) : 0.f;
#pragma unroll
        for (int r = 0; r < 16; ++r) { f0[r] = LDS_F(stash + r * 256) + sc * o0[r]; f1[r] = LDS_F(stash + 4096 + r * 256) + sc * o1[r]; }
    }
    bf16_t* orow = (bf16_t*)(ws + P_ORAW) + (long)(b * S_ + tq) * 1024 + 512 + h * 64;
#pragma unroll
    for (int q = 0; q < 4; ++q) {
        const unsigned long long c0 = __hip_atomic_load((GAS unsigned long long*)(orow + 8 * q + 4 * hi), RLX_AGENT), c1 = __hip_atomic_load((GAS unsigned long long*)(orow + 32 + 8 * q + 4 * hi), RLX_AGENT);
        f0[4 * q] += bflo((unsigned)c0); f0[4 * q + 1] += bfhi((unsigned)c0); f0[4 * q + 2] += bflo((unsigned)(c0 >> 32)); f0[4 * q + 3] += bfhi((unsigned)(c0 >> 32));
        f1[4 * q] += bflo((unsigned)c1); f1[4 * q + 1] += bfhi((unsigned)c1); f1[4 * q + 2] += bflo((unsigned)(c1 >> 32)); f1[4 * q + 3] += bfhi((unsigned)(c1 >> 32));
    }
    att_store_out(orow, f0, f1, hi);
    __syncthreads();
}
DEV void unpack8(const u4& u, float (&v)[8]) { v[0] = bflo(u.x); v[1] = bfhi(u.x); v[2] = bflo(u.y); v[3] = bfhi(u.y); v[4] = bflo(u.z); v[5] = bfhi(u.z); v[6] = bflo(u.w); v[7] = bfhi(u.w); }
DEV u4 pack8f(const float (&v)[8]) { u4 o; o.x = cvtpk(v[0], v[1]); o.y = cvtpk(v[2], v[3]); o.z = cvtpk(v[4], v[5]); o.w = cvtpk(v[6], v[7]); return o; }
DEV long kimg_off(int nstream, int s, int chunk, int nchunk) { return ((long)nstream * 128 + (s >> 6)) * (nchunk * 512) + chunk * 512 + (s & 63) * 8; }
DEV long vimg_off(int nstream, int s, int chunk) { return ((long)nstream * 128 + (s >> 6)) * 4096 + (chunk >> 2) * 2048 + (s & 63) * 32 + (chunk & 3) * 8; }
DEV void phase_prep(const Args& a, int l) {
    unsigned char* ws = a.ws; const int lane = threadIdx.x & 63, wv = threadIdx.x >> 6, tj = lane >> 3, ch = lane & 7;
    const bf16_t* proj = (const bf16_t*)(ws + P_PROJ);
    if (threadIdx.x < 64) LDS_U(LDS_PH + threadIdx.x * 4) = 0u;
    __syncthreads();
    int it = -1;
    for (int grp = blockIdx.x * 8 + wv; grp < T_ / 8; grp += gridDim.x * 8) {
        ++it;
        const int t = grp * 8 + tj, b = t >> 13, s = t & 8191; const bf16_t* pr = proj + (long)t * PLD + ch * 8;
        u4 rawall[42];
#pragma unroll
        for (int k = 0; k < 42; ++k) rawall[k] = gld16(pr + k * 64);
#pragma unroll
        for (int h0 = 0; h0 < 36; h0 += 6) {
            u4 raw[6];
#pragma unroll
            for (int k = 0; k < 6; ++k) raw[k] = rawall[h0 + k];
#pragma unroll
            for (int k = 0; k < 6; ++k) {
                const int hd = h0 + k; float v[8]; unpack8(raw[k], v);
                const float* gn = nullptr;
                if (hd >= 12 && hd < 16) gn = a.in[4] + l * 64; else if (hd >= 16 && hd < 18) gn = a.in[5] + l * 64; else if (hd >= 20 && hd < 24) gn = a.in[7] + l * 64;
                else if (hd >= 28 && hd < 30) gn = a.in[8] + (l * 3 + 1) * 64; else if (hd >= 32 && hd < 34) gn = a.in[8] + (l * 3 + 2) * 64;
                u4 o = raw[k];
                if (gn) { float ss = 0.f;
#pragma unroll
                    for (int e = 0; e < 8; ++e) ss += v[e] * v[e];
                    ss += __shfl_xor(ss, 1); ss += __shfl_xor(ss, 2); ss += __shfl_xor(ss, 4);
                    const float rs = __builtin_amdgcn_rsqf(ss * (1.f / 64.f) + EPS); const u4 g0 = gld16(gn + ch * 8), g1 = gld16(gn + ch * 8 + 4);
                    v[0] *= rs * __uint_as_float(g0.x); v[1] *= rs * __uint_as_float(g0.y); v[2] *= rs * __uint_as_float(g0.z); v[3] *= rs * __uint_as_float(g0.w);
                    v[4] *= rs * __uint_as_float(g1.x); v[5] *= rs * __uint_as_float(g1.y); v[6] *= rs * __uint_as_float(g1.z); v[7] *= rs * __uint_as_float(g1.w);
                    o = pack8f(v); }
                if (hd < 4) gst16((bf16_t*)(ws + X_QSB) + ((long)(b * 4 + hd) * S_ + s) * 64 + ch * 8, o);
                else if (hd < 8) gst16((bf16_t*)(ws + X_KSB) + kimg_off(b * 4 + hd - 4, s, ch, 8), o);
                else if (hd < 12) gst16((bf16_t*)(ws + X_VSB) + vimg_off(b * 4 + hd - 8, s, ch), o);
                else if (hd < 16) gst16((bf16_t*)(ws + X_QSW) + ((long)(b * 4 + hd - 12) * S_ + s) * 64 + ch * 8, o);
                else if (hd < 18) gst16((bf16_t*)(ws + A_KSW) + kimg_off(b * 2 + hd - 16, s, ch, 8), o);
                else if (hd < 20) gst16((bf16_t*)(ws + A_VSW) + vimg_off(b * 2 + hd - 18, s, ch), o);
                else if (hd < 24) gst16((bf16_t*)(ws + A_QN) + ((long)(b * 4 + hd - 20) * S_ + s) * 64 + ch * 8, o);
                else if (hd < 28) gst16((bf16_t*)(ws + A_XC) + (long)t * 256 + (hd - 24) * 64 + ch * 8, o);
                else if (hd < 30) gst16((bf16_t*)(ws + A_KNS) + kimg_off(b * 2 + hd - 28, s, ch, 8), o);
                else if (hd < 32) { gst16((bf16_t*)(ws + A_VNS) + vimg_off(b * 2 + hd - 30, s, ch), o);
                    float mx = 0.f;
#pragma unroll
                    for (int e = 0; e < 8; ++e) mx = __builtin_fmaxf(mx, __builtin_fabsf(v[e]));
#pragma unroll
                    for (int mk = 1; mk < 64; mk <<= 1) mx = __builtin_fmaxf(mx, __shfl_xor(mx, mk));
                    if (lane == 0) { const unsigned sl = LDS_PH + (it * 2 + hd - 30) * 8; atomicMax((unsigned*)(smem + sl), __float_as_uint(mx));
                        if (atomicAdd((unsigned*)(smem + sl + 4), 1u) == 7u) atomicMax((unsigned*)(ws + WS_CTL) + CW_VMAX + l * 16 + (grp >> 10) * 2 + hd - 30, atomicMax((unsigned*)(smem + sl), 0u)); } }
                else if (hd < 34) gst16((bf16_t*)(ws + A_KNW) + kimg_off(b * 2 + hd - 32, s, ch, 8), o);
                else gst16((bf16_t*)(ws + A_VNW) + vimg_off(b * 2 + hd - 34, s, ch), o);
            }
        }
        {
            u4 raw[6]; float v[6][8];
#pragma unroll
            for (int k = 0; k < 6; ++k) raw[k] = rawall[36 + k];
            float sq = 0.f, sk = 0.f;
#pragma unroll
            for (int k = 0; k < 6; ++k) { unpack8(raw[k], v[k]);
                if (k < 5) { float ss = 0.f;
#pragma unroll
                    for (int e = 0; e < 8; ++e) ss += v[k][e] * v[k][e];
                    if (k < 3) sq += ss; else sk += ss; } }
            sq += __shfl_xor(sq, 1); sq += __shfl_xor(sq, 2); sq += __shfl_xor(sq, 4); sk += __shfl_xor(sk, 1); sk += __shfl_xor(sk, 2); sk += __shfl_xor(sk, 4);
            const float rq = __builtin_amdgcn_rsqf(sq * (1.f / 192.f) + EPS), rk = __builtin_amdgcn_rsqf(sk * (1.f / 128.f) + EPS);
#pragma unroll
            for (int k = 0; k < 5; ++k) { const float rs = k < 3 ? rq : rk;
#pragma unroll
                for (int e = 0; e < 8; ++e) v[k][e] *= rs;
                if (k < 3) gst16((bf16_t*)(ws + A_CQN) + (long)t * 192 + k * 64 + ch * 8, pack8f(v[k]));
                else gst16((bf16_t*)(ws + A_CKVN) + (long)t * 128 + (k - 3) * 64 + ch * 8, pack8f(v[k])); }
            if (ch < 4) gst16((bf16_t*)(ws + A_KPE) + (long)t * 32 + ch * 8, raw[5]);
            else if (ch < 6) { float* gt = (float*)(ws + A_GATES) + (long)t * 12 + (ch - 4) * 8; const int ne = ch == 4 ? 8 : 4;
#pragma unroll
                for (int e = 0; e < 8; ++e) if (e < ne) *(GAS float*)(gt + e) = frcp(1.f + fexp2(-v[5][e] * LOG2E)); }
        }
    }
}

DEV void phase_mla_fin(const Args& a, int l) {
    unsigned char* ws = a.ws; const int lane = threadIdx.x & 63, wv = threadIdx.x >> 6, tj = lane >> 3, ch = lane & 7;
    const float* qg = a.in[16] + l * 96; const float* kg = a.in[17] + l * 96;
    for (int grp = blockIdx.x * 8 + wv; grp < T_ / 8; grp += gridDim.x * 8) {
        const int t = grp * 8 + tj, b = t >> 13, s = t & 8191;
        u4 rq[6], rkv[8], rpe;
#pragma unroll
        for (int k = 0; k < 6; ++k) rq[k] = gld16((const bf16_t*)(ws + P_QRAW) + (long)t * 384 + k * 64 + ch * 8);
#pragma unroll
        for (int k = 0; k < 8; ++k) rkv[k] = gld16((const bf16_t*)(ws + P_KVRAW) + (long)t * 512 + k * 64 + ch * 8);
        rpe = gld16((const bf16_t*)(ws + A_KPE) + (long)t * 32 + (ch & 3) * 8);
        const float* rp = (const float*)(ws + W_ROPE) + (long)s * 32;
        float cs[8], sn[8];
        { const int i0 = (ch & 1) * 8;
#pragma unroll
          for (int e = 0; e < 8; e += 2) { const u4 cc = gld16(rp + 2 * (i0 + e)); cs[e] = __uint_as_float(cc.x); sn[e] = __uint_as_float(cc.y); cs[e + 1] = __uint_as_float(cc.z); sn[e + 1] = __uint_as_float(cc.w); } }
        const bool x2half = (ch & 2) != 0;
        float vq[6][8], hs[4] = {0.f, 0.f, 0.f, 0.f};
#pragma unroll
        for (int k = 0; k < 6; ++k) { unpack8(rq[k], vq[k]); float ss = 0.f;
#pragma unroll
            for (int e = 0; e < 8; ++e) ss += vq[k][e] * vq[k][e];
            if (k == 0) hs[0] += ss; else if (k == 1) { hs[0] += ch < 4 ? ss : 0.f; hs[1] += ch < 4 ? 0.f : ss; } else if (k == 2) hs[1] += ss;
            else if (k == 3) hs[2] += ss; else if (k == 4) { hs[2] += ch < 4 ? ss : 0.f; hs[3] += ch < 4 ? 0.f : ss; } else hs[3] += ss; }
#pragma unroll
        for (int h = 0; h < 4; ++h) { hs[h] += __shfl_xor(hs[h], 1); hs[h] += __shfl_xor(hs[h], 2); hs[h] += __shfl_xor(hs[h], 4); hs[h] = __builtin_amdgcn_rsqf(hs[h] * (1.f / 96.f) + EPS); }
#pragma unroll
        for (int k = 0; k < 6; ++k) {
            const int piece = 8 * k + ch; const int h = (k == 0) ? 0 : (k == 1 ? (ch < 4 ? 0 : 1) : (k == 2 ? 1 : (k == 3 ? 2 : (k == 4 ? (ch < 4 ? 2 : 3) : 3)))); const int ph = piece - 12 * h;
            const float rs = h == 0 ? hs[0] : (h == 1 ? hs[1] : (h == 2 ? hs[2] : hs[3]));
            float o[8]; { const u4 ga = gld16(qg + ph * 8), gb = gld16(qg + ph * 8 + 4);
                o[0] = vq[k][0] * rs * __uint_as_float(ga.x); o[1] = vq[k][1] * rs * __uint_as_float(ga.y); o[2] = vq[k][2] * rs * __uint_as_float(ga.z); o[3] = vq[k][3] * rs * __uint_as_float(ga.w);
                o[4] = vq[k][4] * rs * __uint_as_float(gb.x); o[5] = vq[k][5] * rs * __uint_as_float(gb.y); o[6] = vq[k][6] * rs * __uint_as_float(gb.z); o[7] = vq[k][7] * rs * __uint_as_float(gb.w); }
            const bool rope_reg = (k == 1 || k == 2 || k == 4 || k == 5);
            if (rope_reg) { const bool is_rope = ph >= 8;
#pragma unroll
                for (int e = 0; e < 8; ++e) { const float other = __shfl_xor(o[e], 2); const float r1 = x2half ? other : o[e], r2 = x2half ? o[e] : other;
                    const float res = x2half ? (r1 * sn[e] + r2 * cs[e]) : (r1 * cs[e] - r2 * sn[e]); o[e] = is_rope ? res : o[e]; } }
            gst16((bf16_t*)(ws + A_QM) + ((long)(b * 4 + h) * S_ + s) * 96 + ph * 8, pack8f(o));
        }
        float vpe[8]; unpack8(rpe, vpe); float spe = 0.f;
#pragma unroll
        for (int e = 0; e < 8; ++e) spe += vpe[e] * vpe[e];
        spe = ch < 4 ? spe : 0.f; spe += __shfl_xor(spe, 1); spe += __shfl_xor(spe, 2); spe += __shfl_xor(spe, 4);
        float gkn[8], gkr[8];
        { const u4 a0 = gld16(kg + ch * 8), a1 = gld16(kg + ch * 8 + 4), b0 = gld16(kg + 64 + (ch & 3) * 8), b1 = gld16(kg + 64 + (ch & 3) * 8 + 4);
          gkn[0] = __uint_as_float(a0.x); gkn[1] = __uint_as_float(a0.y); gkn[2] = __uint_as_float(a0.z); gkn[3] = __uint_as_float(a0.w); gkn[4] = __uint_as_float(a1.x); gkn[5] = __uint_as_float(a1.y); gkn[6] = __uint_as_float(a1.z); gkn[7] = __uint_as_float(a1.w);
          gkr[0] = __uint_as_float(b0.x); gkr[1] = __uint_as_float(b0.y); gkr[2] = __uint_as_float(b0.z); gkr[3] = __uint_as_float(b0.w); gkr[4] = __uint_as_float(b1.x); gkr[5] = __uint_as_float(b1.y); gkr[6] = __uint_as_float(b1.z); gkr[7] = __uint_as_float(b1.w); }
#pragma unroll
        for (int h = 0; h < 4; ++h) {
            float vk[8]; unpack8(rkv[2 * h], vk); float ss = 0.f;
#pragma unroll
            for (int e = 0; e < 8; ++e) ss += vk[e] * vk[e];
            ss += __shfl_xor(ss, 1); ss += __shfl_xor(ss, 2); ss += __shfl_xor(ss, 4);
            const float rk = __builtin_amdgcn_rsqf((ss + spe) * (1.f / 96.f) + EPS);
            float o[8];
#pragma unroll
            for (int e = 0; e < 8; ++e) o[e] = vk[e] * rk * gkn[e];
            gst16((bf16_t*)(ws + A_KM) + kimg_off(b * 4 + h, s, ch, 12), pack8f(o));
            float pe[8];
#pragma unroll
            for (int e = 0; e < 8; ++e) pe[e] = vpe[e] * rk * gkr[e];
#pragma unroll
            for (int e = 0; e < 8; ++e) { const float other = __shfl_xor(pe[e], 2); const float r1 = x2half ? other : pe[e], r2 = x2half ? pe[e] : other;
                pe[e] = x2half ? (r1 * sn[e] + r2 * cs[e]) : (r1 * cs[e] - r2 * sn[e]); }
            if (ch < 4) gst16((bf16_t*)(ws + A_KM) + kimg_off(b * 4 + h, s, 8 + ch, 12), pack8f(pe));
            gst16((bf16_t*)(ws + A_VM) + vimg_off(b * 4 + h, s, ch), rkv[2 * h + 1]);
        }
    }
}

DEV void phase_combine(const Args& a) {
    const int lane = threadIdx.x & 63, wv = threadIdx.x >> 6; bf16_t* oraw = (bf16_t*)(a.ws + P_ORAW);
    for (int t = blockIdx.x * 8 + wv; t < T_; t += gridDim.x * 8) {
        bf16_t* p = oraw + (long)t * 1024 + lane * 16;
        float v0[8], v1[8]; unpack8(gld16(p), v0); unpack8(gld16(p + 8), v1);
        float ss = 0.f;
#pragma unroll
        for (int e = 0; e < 8; ++e) ss += v0[e] * v0[e] + v1[e] * v1[e];
        ss += __shfl_xor(ss, 1); ss += __shfl_xor(ss, 2); ss += __shfl_xor(ss, 4); ss += __shfl_xor(ss, 8);
        const float rs = __builtin_amdgcn_rsqf(ss * (1.f / 256.f) + EPS);
#pragma unroll
        for (int e = 0; e < 8; ++e) { v0[e] *= rs; v1[e] *= rs; }
        gst16(p, pack8f(v0)); gst16(p + 8, pack8f(v1));
    }
}

DEV int pair_index(int lo, int hi) { return 7 * lo - (lo * (lo - 1)) / 2 + (hi - lo - 1); }
DEV void phase_router(const Args& a, int l, bool dry = false) {
    unsigned char* ws = a.ws; const int lane = threadIdx.x & 63, wv = threadIdx.x >> 6, r16 = lane & 15, q4 = lane >> 4;
    const float* WrT = (const float*)(ws + W_R) + (long)l * 48 * 1024; const bf16_t* xb = (const bf16_t*)(ws + X_XB);
    constexpr unsigned RT_WBUF = 53248;
    unsigned* ctl = (unsigned*)(ws + WS_CTL); const unsigned lg = LDS_PH + 2 * RT_WBUF + wv * 3072;
    const float* bg = a.in[22] + l * 4; const float* be = a.in[24] + l * 32;
    constexpr int WLD = 272;
    constexpr unsigned RT_CNT = LDS_PH + 2 * 53248 + 8 * 3072, RT_BASE = RT_CNT + 1024;
    for (int rnd = blockIdx.x; rnd < T_ / 256; rnd += gridDim.x) {
        f32x4 acc[2][3]; float ss[2] = {0.f, 0.f};
#pragma unroll
        for (int u = 0; u < 2; ++u) { acc[u][0] = f32x4{}; acc[u][1] = f32x4{}; acc[u][2] = f32x4{}; }
        if (threadIdx.x < 160) LDS_I(RT_CNT + threadIdx.x * 4) = 0;
        u4 wst[6];
#pragma unroll
        for (int k = 0; k < 6; ++k) { const int i = threadIdx.x + 512 * k, row = i >> 6, c4 = i & 63; wst[k] = gld16(WrT + (long)row * 1024 + c4 * 4); }
        __syncthreads();
#pragma unroll
        for (int k = 0; k < 6; ++k) { const int i = threadIdx.x + 512 * k, row = i >> 6, c4 = i & 63; LDS_U4(LDS_PH + (row * WLD + c4 * 4) * 4) = wst[k]; }
        __syncthreads();
#pragma unroll 1
        for (int kc = 0; kc < 4; ++kc) {
            const unsigned wbuf = LDS_PH + (kc & 1) * RT_WBUF;
            if (kc < 3) {
#pragma unroll
                for (int k = 0; k < 6; ++k) { const int i = threadIdx.x + 512 * k, row = i >> 6, c4 = i & 63; wst[k] = gld16(WrT + (long)row * 1024 + (kc + 1) * 256 + c4 * 4); } }
#pragma unroll
            for (int u = 0; u < 2; ++u) {
                const int t0 = rnd * 256 + (wv + 8 * u) * 16; const bf16_t* xr = xb + (long)(t0 + r16) * 1024 + kc * 256 + 4 * q4;
                const unsigned wl = wbuf + (r16 * WLD + 4 * q4) * 4;
#pragma unroll 4
                for (int i = 0; i < 16; ++i) {
                    const u2 xv = gld8(xr + 16 * i); const u4 w0 = LDS_U4(wl + i * 64), w1 = LDS_U4(wl + 16 * WLD * 4 + i * 64), w2 = LDS_U4(wl + 32 * WLD * 4 + i * 64);
                    const float x0 = __uint_as_float(xv.x << 16), x1 = __uint_as_float(xv.x & 0xffff0000u), x2 = __uint_as_float(xv.y << 16), x3 = __uint_as_float(xv.y & 0xffff0000u);
                    ss[u] += x0 * x0 + x1 * x1 + x2 * x2 + x3 * x3;
                    acc[u][0] = __builtin_amdgcn_mfma_f32_16x16x4f32(x0, __uint_as_float(w0.x), acc[u][0], 0, 0, 0); acc[u][1] = __builtin_amdgcn_mfma_f32_16x16x4f32(x0, __uint_as_float(w1.x), acc[u][1], 0, 0, 0); acc[u][2] = __builtin_amdgcn_mfma_f32_16x16x4f32(x0, __uint_as_float(w2.x), acc[u][2], 0, 0, 0);
                    acc[u][0] = __builtin_amdgcn_mfma_f32_16x16x4f32(x1, __uint_as_float(w0.y), acc[u][0], 0, 0, 0); acc[u][1] = __builtin_amdgcn_mfma_f32_16x16x4f32(x1, __uint_as_float(w1.y), acc[u][1], 0, 0, 0); acc[u][2] = __builtin_amdgcn_mfma_f32_16x16x4f32(x1, __uint_as_float(w2.y), acc[u][2], 0, 0, 0);
                    acc[u][0] = __builtin_amdgcn_mfma_f32_16x16x4f32(x2, __uint_as_float(w0.z), acc[u][0], 0, 0, 0); acc[u][1] = __builtin_amdgcn_mfma_f32_16x16x4f32(x2, __uint_as_float(w1.z), acc[u][1], 0, 0, 0); acc[u][2] = __builtin_amdgcn_mfma_f32_16x16x4f32(x2, __uint_as_float(w2.z), acc[u][2], 0, 0, 0);
                    acc[u][0] = __builtin_amdgcn_mfma_f32_16x16x4f32(x3, __uint_as_float(w0.w), acc[u][0], 0, 0, 0); acc[u][1] = __builtin_amdgcn_mfma_f32_16x16x4f32(x3, __uint_as_float(w1.w), acc[u][1], 0, 0, 0); acc[u][2] = __builtin_amdgcn_mfma_f32_16x16x4f32(x3, __uint_as_float(w2.w), acc[u][2], 0, 0, 0);
                }
            }
            if (kc < 3) {
#pragma unroll
                for (int k = 0; k < 6; ++k) { const int i = threadIdx.x + 512 * k, row = i >> 6, c4 = i & 63; LDS_U4(LDS_PH + ((kc + 1) & 1) * RT_WBUF + (row * WLD + c4 * 4) * 4) = wst[k]; }
                __syncthreads(); }
        }
        int sv_e0[2] = {0, 0}, sv_e1[2] = {0, 0}, sv_p[2] = {0, 0}, sv_r0[2] = {0, 0}, sv_r1[2] = {0, 0}, sv_r3[2] = {0, 0};
#pragma unroll
        for (int u = 0; u < 2; ++u) {
            const int t0 = rnd * 256 + (wv + 8 * u) * 16;
            float ssu = ss[u]; ssu += __shfl_xor(ssu, 16); ssu += __shfl_xor(ssu, 32);
            const float rstd = __builtin_amdgcn_rsqf(ssu * (1.f / 1024.f) + EPS);
#pragma unroll
            for (int rg = 0; rg < 4; ++rg) { const unsigned o = lg + ((q4 * 4 + rg) * 48 + r16) * 4; LDS_F(o) = acc[u][0][rg]; LDS_F(o + 64) = acc[u][1][rg]; LDS_F(o + 128) = acc[u][2][rg]; }
            if (lane < 16) {
            const int tk = t0 + lane; const unsigned row = lg + lane * 192;
            float gl[4]; int gs = 0; float gm;
#pragma unroll
            for (int j = 0; j < 4; ++j) gl[j] = LDS_F(row + j * 4) * rstd + gldf(bg + j);
            gm = gl[0];
#pragma unroll
            for (int j = 1; j < 4; ++j) if (gl[j] > gm) { gm = gl[j]; gs = j; }
            float gden = 0.f;
#pragma unroll
            for (int j = 0; j < 4; ++j) gden += fexp2((gl[j] - gm) * LOG2E);
            const float gw = frcp(gden);
            float el[8];
#pragma unroll
            for (int j = 0; j < 8; ++j) el[j] = LDS_F(row + (4 + gs * 8 + j) * 4) * rstd + gldf(be + gs * 8 + j);
            int i1 = 0; float m1 = el[0];
#pragma unroll
            for (int j = 1; j < 8; ++j) if (el[j] > m1) { m1 = el[j]; i1 = j; }
            int i2 = -1; float m2 = -3.0e38f;
#pragma unroll
            for (int j = 0; j < 8; ++j) if (j != i1 && el[j] > m2) { m2 = el[j]; i2 = j; }
            const float p2 = fexp2((m2 - m1) * LOG2E); const float w1 = gw * frcp(1.f + p2), w2 = gw - w1;
            const int lo = i1 < i2 ? i1 : i2, hi2 = i1 < i2 ? i2 : i1; const float wlo = i1 < i2 ? w1 : w2, whi = i1 < i2 ? w2 : w1;
            const int elo = gs * 8 + lo, ehi = gs * 8 + hi2, pr = gs * 28 + pair_index(lo, hi2);
            *(GAS float*)((float*)(ws + M_WSLOT) + 2 * tk) = wlo; *(GAS float*)((float*)(ws + M_WSLOT) + 2 * tk + 1) = whi;
            *(GAS float*)((float*)(ws + M_RSTD2) + tk) = rstd;
            sv_e0[u] = elo; sv_e1[u] = ehi; sv_p[u] = pr;
            sv_r0[u] = atomicAdd((int*)(smem + RT_CNT + elo * 4), 1); sv_r1[u] = atomicAdd((int*)(smem + RT_CNT + ehi * 4), 1); sv_r3[u] = atomicAdd((int*)(smem + RT_CNT + (32 + pr) * 4), 1);
        }
        }
        __syncthreads();
        if (!dry && threadIdx.x < 160) { const int t = threadIdx.x; const int c = LDS_I(RT_CNT + t * 4); int base = 0;
            if (c > 0 && t < 32 + NPAIR) base = (int)atomicAdd(t < 32 ? ctl + CW_CNTE + l * 32 + t : ctl + CW_CNTP + l * 128 + (t - 32), (unsigned)c);
            LDS_I(RT_BASE + t * 4) = base; }
        __syncthreads();
        if (!dry && lane < 16) {
#pragma unroll
            for (int u = 0; u < 2; ++u) { const int tk = rnd * 256 + (wv + 8 * u) * 16 + lane;
                *(GAS int*)((int*)(ws + M_LISTE) + (long)sv_e0[u] * 65536 + LDS_I(RT_BASE + sv_e0[u] * 4) + sv_r0[u]) = tk * 2;
                *(GAS int*)((int*)(ws + M_LISTE) + (long)sv_e1[u] * 65536 + LDS_I(RT_BASE + sv_e1[u] * 4) + sv_r1[u]) = tk * 2 + 1;
                *(GAS int*)((int*)(ws + M_LISTP) + (long)sv_p[u] * 65536 + LDS_I(RT_BASE + (32 + sv_p[u]) * 4) + sv_r3[u]) = tk; }
        }
    }
}

DEV void phase_moe1(const Args& a, int l) {
    unsigned char* ws = a.ws; unsigned* cnt = (unsigned*)(ws + WS_CTL) + CW_CNTE + l * 32;
    if (threadIdx.x < 32) LDS_I(LDS_EPI + 4096 + threadIdx.x * 4) = (int)xb_ld(cnt + threadIdx.x);
    __syncthreads();
    if (threadIdx.x == 0) { int af = 0, ah = 0; for (int e = 0; e < 32; ++e) { const int c = LDS_I(LDS_EPI + 4096 + e * 4); LDS_I(LDS_SCHED + e * 4) = af; LDS_I(LDS_SCHED + 256 + e * 4) = ah; af += (c >> 8) * 2; ah += (((c & 255) + 127) >> 7) * 2; }
        LDS_I(LDS_SCHED + 32 * 4) = af; LDS_I(LDS_SCHED + 256 + 32 * 4) = ah; }
    __syncthreads();
    const int nfull = LDS_I(LDS_SCHED + 32 * 4), total = nfull + LDS_I(LDS_SCHED + 256 + 32 * 4);
    for (int t = blockIdx.x; t < total; t += gridDim.x) {
        const bool full = t < nfull; const int v = full ? t : t - nfull; const unsigned tab = LDS_SCHED + (full ? 0 : 256);
        int e = 0; while (e < 31 && v >= LDS_I(tab + (e + 1) * 4)) ++e;
        const int loc = v - LDS_I(tab + e * 4), mt = loc >> 1, nt = loc & 1; const int ce = LDS_I(LDS_EPI + 4096 + e * 4);
        GemmMoe1 p{(const bf16_t*)(ws + X_XB), (const int*)(ws + M_LISTE) + (long)e * 65536, (const bf16_t*)(ws + W_GU) + ((long)(l * 32 + e) * 512) * 1024,
                   (const float*)(ws + M_RSTD2), (const float*)(ws + M_WSLOT), (bf16_t*)(ws + M_ABUF)};
        if (full) gemm_tile<4, 4>(p, mt * 256, nt * 256, 256);
        else { const int row0 = (ce >> 8) * 256 + mt * 128; const int mrows = ce - row0 < 128 ? ce - row0 : 128; gemm_tile3<2, 4>(p, row0, nt * 256, mrows); }
    }
}
DEV void phase_moe2(const Args& a, int l, float* xout, float* ssqo) {
    unsigned char* ws = a.ws; unsigned* cnt = (unsigned*)(ws + WS_CTL) + CW_CNTP + l * 128;
    if (threadIdx.x < NPAIR) LDS_I(LDS_EPI + 4096 + threadIdx.x * 4) = (int)xb_ld(cnt + threadIdx.x);
    __syncthreads();
    if (threadIdx.x == 0) { int acc = 0; for (int e = 0; e < NPAIR; ++e) { LDS_I(LDS_SCHED + e * 4) = acc; acc += ((LDS_I(LDS_EPI + 4096 + e * 4) + 127) >> 7) * 4; } LDS_I(LDS_SCHED + NPAIR * 4) = acc; }
    __syncthreads();
    const int total = LDS_I(LDS_SCHED + NPAIR * 4);
    for (int t = blockIdx.x; t < total; t += gridDim.x) {
        int e = 0; while (e < NPAIR - 1 && t >= LDS_I(LDS_SCHED + (e + 1) * 4)) ++e;
        const int loc = t - LDS_I(LDS_SCHED + e * 4), mt = loc >> 2, nt = loc & 3; const int ce = LDS_I(LDS_EPI + 4096 + e * 4); const int mrows = ce - mt * 128 < 128 ? ce - mt * 128 : 128;
        const int gs = e / 28; int q = e % 28, lo = 0; while (q >= 7 - lo) { q -= 7 - lo; ++lo; } const int hi2 = lo + 1 + q;
        const bf16_t* Wd = (const bf16_t*)(ws + W_DN) + (long)(l * 32) * 262144;
        GemmMoe2 p{(const bf16_t*)(ws + M_ABUF), (const int*)(ws + M_LISTP) + (long)e * 65536, Wd + (long)(gs * 8 + lo) * 262144, Wd + (long)(gs * 8 + hi2) * 262144, (bf16_t*)(ws + X_XB), xout, ssqo};
        gemm_tile3<2, 4>(p, mt * 128, nt * 256, mrows);
    }
}

#ifndef ATT_ONLY
#define ATT_ONLY 15
#endif
#define ATT_QUEUE_X(XQ, NPER, BODY) { int tid__ = threadIdx.x; asm volatile("" : "+v"(tid__)); const int x0_ = (int)(xb_xcc_id() & 7u); \
    for (int xi_ = 0; xi_ < 8; ++xi_) { const int xq = (x0_ + xi_) & 7; for (;;) { if (tid__ == 0) LDS_I(AT_ITEM) = (int)atomicAdd(qx + (XQ) + xq, 1u); __syncthreads(); \
        const int item = __builtin_amdgcn_readfirstlane(LDS_I(AT_ITEM)); __syncthreads(); if (item >= (NPER)) break; BODY } } }
#define ATT_QUEUE(QIDX, NITEMS, BODY) ATT_QUEUE_F(QIDX, NITEMS, false, BODY)
#define ATT_QUEUE_F(QIDX, NITEMS, FIRST, BODY) { int tid__ = threadIdx.x; asm volatile("" : "+v"(tid__)); const int q0_ = (FIRST) ? (int)gridDim.x : 0; int nx_ = 0; \
    if (FIRST) nx_ = (int)blockIdx.x; else if (tid__ == 0) nx_ = (int)atomicAdd(qc + (QIDX), 1u); \
    for (;;) { if (tid__ == 0) LDS_I(AT_ITEM) = nx_; __syncthreads(); \
        const int item = __builtin_amdgcn_readfirstlane(LDS_I(AT_ITEM)); __syncthreads(); if (item >= (NITEMS)) break; \
        if (tid__ == 0) nx_ = q0_ + (int)atomicAdd(qc + (QIDX), 1u);        \
        BODY } }
DEV void phase_attn(const Args& a, int l) {
    unsigned* qc = (unsigned*)(a.ws + WS_CTL) + CW_ATTQ + l * 16; unsigned* qx = (unsigned*)(a.ws + WS_CTL) + CW_ATTQ + 64 + l * 32;
#ifndef PROBE_ATT
#define PROBE_ATT 0
#endif
    if (PROBE_ATT & 1) ATT_QUEUE(8, 1024, { attn_mla(tid__, a, l, (item & 31) >> 2, item & 3, 31 - (item >> 5)); })
    if (PROBE_ATT & 2) ATT_QUEUE(9, 1024, { attn_nsa_b(tid__, a, l, (item & 15) >> 1, item & 1, 63 - (item >> 4)); })
    if (PROBE_ATT & 4) ATT_QUEUE(10, 1024, { attn_sb(tid__, a, l, item >> 7, (item >> 5) & 3, item & 31); })
    if (PROBE_ATT & 8) ATT_QUEUE(11, 1024, { attn_swa(tid__, a, l, item >> 7, (item >> 6) & 1, item & 63); })
    if (ATT_ONLY & 2) ATT_QUEUE_F(4, 1024, (gridDim.x <= 1024), { attn_nsa_a(tid__, a, l, (item & 15) >> 1, item & 1, 63 - (item >> 4)); if (PROBE_NSA & 1) attn_nsa_a(tid__, a, l, (item & 15) >> 1, item & 1, 63 - (item >> 4)); })
    if (ATT_ONLY & 1) ATT_QUEUE_X(0, 128, { const int st_ = xq * 4 + (item & 3); attn_mla(tid__, a, l, st_ >> 2, st_ & 3, 31 - (item >> 2)); })
    if (ATT_ONLY & 2) ATT_QUEUE(1, 1024, { attn_nsa_b(tid__, a, l, (item & 15) >> 1, item & 1, 63 - (item >> 4)); })
    if (ATT_ONLY & 4) ATT_QUEUE(2, 1024, { attn_sb(tid__, a, l, item >> 7, (item >> 5) & 3, item & 31); })
    if (ATT_ONLY & 8) ATT_QUEUE(3, 1024, { attn_swa(tid__, a, l, item >> 7, (item >> 6) & 1, item & 63); })
}

constexpr int NPHASE = 1 + 11 * L_;
#define XCD_REMAP(t) ((((t) & ~255)) + (((t) & 7) << 5) + (((t) & 255) >> 3))
#ifndef PROBE_PH
#define PROBE_PH 0
#endif
#ifndef PH_ONLY
#define PH_ONLY -1
#endif
#define IN(k) (a0.ph_lo <= (k) && (k) < a0.ph_hi && (PH_ONLY < 0 || PH_ONLY == ((k) == 0 ? 0 : 1 + ((k) - 1) % 11)))
#define GB(k) do { if (IN(k) && IN((k) + 1)) { xcd_barrier(bar); if (PROBE_PH & 2048) { xcd_barrier(bar); xcd_barrier(bar); } } } while (0)
#define GB2(k) do { if (IN(k) && IN((k) + 2)) xcd_barrier(bar); } while (0)
#define LAUNDER() do { unsigned char* w_ = a0.ws; float* o_ = a0.out; const float* x_ = xin0; asm volatile("" : "+s"(w_), "+s"(o_), "+s"(x_)); a.ws = w_; a.out = o_; ws = w_; xin = x_; } while (0)
template <int l> DEV void run_layer(const Args& a0, const XcdBarrier& bar) {
    Args a = a0; unsigned char* ws = a0.ws;
    const int pb = 1 + 11 * l;
    const float* xin0 = l == 0 ? a0.in[0] : (const float*)a0.out; const float* xin = xin0;
    if (IN(pb + 1)) { LAUNDER();
        pg8::Gemm g{(const bf16_t*)(ws + X_XB), (const bf16_t*)(ws + W_WIN) + (long)l * PLD * 1024, T_, 2816, 1024};
        pg8::StaticOrder S; S.init(T_, 2816, (int)gridDim.x, (int)blockIdx.x);
        pg8::EpiProj E{(bf16_t*)(ws + P_PROJ), PLD, PLD, l == 0 ? (const float*)(ws + MS_RSTD1) : (const float*)(ws + MS_SSQP), l == 0 ? 1 : 4, T_};
        for (int rep = 0; rep < ((PROBE_PH & 1) ? 2 : 1); ++rep)
        pg8::gemm_phase<pg8::EpiProj, pg8::StaticOrder, true, true>((LAS unsigned char*)((LAS char*)smem + LDS_PH), g, S, E);
    }
    GB(pb + 1);
    if (IN(pb + 2)) { LAUNDER(); phase_prep(a, l); if (PROBE_PH & 2) phase_prep(a, l); }
    GB(pb + 2);
    if (IN(pb + 3)) { LAUNDER();
        for (int rep = 0; rep < ((PROBE_PH & 16) ? 2 : 1); ++rep)
        {
            if (blockIdx.x < 64) { const int u = blockIdx.x, w = u >> 5; GemmCmp1 p{(const bf16_t*)(ws + A_XC), w, (const bf16_t*)(ws + W_C1) + (long)(l * 2 + w) * 128 * 2048, (const float*)(ws + W_B1) + (l * 2 + w) * 128, (bf16_t*)(ws + A_H1) + (long)w * 8192 * 128};
                gemm_tile3<2, 2>(p, (u & 31) * 256, 0, 256); }
            const bf16_t* wq = (const bf16_t*)(ws + W_QUP) + (long)l * 384 * 192; const bf16_t* wkv = (const bf16_t*)(ws + W_KVUP) + (long)l * 512 * 128;
            auto mk = [&](int u, GemmPlain& p, int& m0, int& n0) {
                if (u < 768) { p = GemmPlain{(const bf16_t*)(ws + A_CQN), 192, wq, 192, 3, (bf16_t*)(ws + P_QRAW), 384}; m0 = (u / 3) * 256; n0 = (u % 3) * 128; }
                else { const int v = u - 768; p = GemmPlain{(const bf16_t*)(ws + A_CKVN), 128, wkv, 128, 2, (bf16_t*)(ws + P_KVRAW), 512}; m0 = (v / 4) * 256; n0 = (v % 4) * 128; } };
            if (gridDim.x == 256) {
                if (blockIdx.x < 64) gemm_smallk_run(mk, (int)blockIdx.x, 64, 256); else gemm_smallk_run(mk, 256 + ((int)blockIdx.x - 64), 192, 1792);
            } else gemm_smallk_run(mk, (int)blockIdx.x, (int)gridDim.x, 1792);
        }
    }
    GB(pb + 3);
    if (IN(pb + 4)) { LAUNDER();
        phase_mla_fin(a, l);
        if (PROBE_PH & 32) phase_mla_fin(a, l);
        __syncthreads();
        for (int t = blockIdx.x; t < 64; t += gridDim.x) { const int w = t >> 5;
            GemmCmp2 p{(const bf16_t*)(ws + A_H1) + (long)w * 8192 * 128, w, (const bf16_t*)(ws + W_C2) + (long)(l * 2 + w) * 128 * 128, a.in[8] + (l * 3) * 64, (bf16_t*)(ws + A_KC), (bf16_t*)(ws + A_VC)};
            gemm_tile3<2, 2>(p, (t & 31) * 256, 0, 256); }
    }
    GB(pb + 4);
    if (IN(pb + 5)) { LAUNDER(); phase_attn(a, l); }
    GB(pb + 5);
    if (IN(pb + 6)) { LAUNDER(); phase_combine(a); if (PROBE_PH & 64) phase_combine(a); }
    GB(pb + 6);
    if (IN(pb + 7)) { LAUNDER();
        pg8::Gemm g{(const bf16_t*)(ws + P_ORAW), (const bf16_t*)(ws + W_WOUT) + (long)l * 1048576, T_, 1024, 1024};
        pg8::StaticOrder S; S.init(T_, 1024, (int)gridDim.x, (int)blockIdx.x);
        pg8::EpiResid E{(bf16_t*)(ws + X_XB), 1024};
        for (int rep = 0; rep < (((PROBE_PH & 128) && l == 0) ? 2 : 1); ++rep)
        pg8::gemm_phase<pg8::EpiResid, pg8::StaticOrder, true, true>((LAS unsigned char*)((LAS char*)smem + LDS_PH), g, S, E);
    }
    GB(pb + 7);
    if (IN(pb + 8)) { LAUNDER(); phase_router(a, l); if (PROBE_PH & 512) phase_router(a, l, true); }
    GB(pb + 8);
    if (IN(pb + 9)) { LAUNDER(); phase_moe1(a, l); if (PROBE_PH & 4) { __syncthreads(); phase_moe1(a, l); } }
    GB(pb + 9);
    if (IN(pb + 10)) { LAUNDER(); phase_moe2(a, l, l + 1 < L_ ? nullptr : a.out, (float*)(ws + MS_SSQP)); if (PROBE_PH & 1024) { __syncthreads(); phase_moe2(a, l, (float*)(ws + P_PROJ), nullptr); } }
    if (l + 1 < L_) GB2(pb + 10);
}
__global__ void __launch_bounds__(512, 2) hymba_fwd(Args a0) {
    if (threadIdx.x == 0) { LDS_U(0) = 0u; LDS_U(4) = 0u; LDS_U(8) = 0u; LDS_U(12) = 0u; }
    __syncthreads();
    XcdBarrier bar; bar.bar = (unsigned*)(a0.ws + WS_CTL) + CW_BAR; bar.x = 0; bar.st = (volatile LAS unsigned*)((LAS char*)smem);
    if (a0.ph_hi - a0.ph_lo > 1) bar = xcd_barrier_post((unsigned*)(a0.ws + WS_CTL) + CW_BAR, (volatile LAS unsigned*)((LAS char*)smem));
    if (IN(0)) { phase_p0(a0); if (PROBE_PH & 256) { __syncthreads(); phase_p0(a0); } phase_rowstat(a0.in[0], (bf16_t*)(a0.ws + X_XB), (float*)(a0.ws + MS_RSTD1)); }
    GB2(0);
    run_layer<0>(a0, bar);
    run_layer<1>(a0, bar);
}

extern "C" void kernel_launch(void* const* d_in, const int* in_sizes, int n_in, void* d_out, int out_size, void* d_ws, size_t ws_size, hipStream_t stream) {
    static int grid = 0;
    if (grid == 0) {
        if (n_in != 28 || out_size != T_ * D_ || ws_size < WS_END) { fprintf(stderr, "kernel_launch: unexpected shapes (n_in %d out %d ws %zu)\n", n_in, out_size, ws_size); grid = -1; return; }
        int dev = 0, cus = 0, per_cu = 0;
        if (hipGetDevice(&dev) != hipSuccess || hipDeviceGetAttribute(&cus, hipDeviceAttributeMultiprocessorCount, dev) != hipSuccess) { grid = -1; return; }
        if (hipFuncSetAttribute((const void*)hymba_fwd, hipFuncAttributeMaxDynamicSharedMemorySize, LDS_BYTES) != hipSuccess) { fprintf(stderr, "kernel_launch: hipFuncSetAttribute failed\n"); grid = -1; return; }
        if (hipOccupancyMaxActiveBlocksPerMultiprocessor(&per_cu, (const void*)hymba_fwd, 512, LDS_BYTES) != hipSuccess || per_cu < 1) { fprintf(stderr, "kernel_launch: occupancy query reports %d\n", per_cu); per_cu = 1; }
        (void)hipGetLastError();
        grid = cus;
    }
    if (grid < 0) return;
    (void)hipMemsetAsync((char*)d_ws + WS_CTL, 0, CTL_BYTES, stream);
    Args a{};
    for (int i = 0; i < 28; ++i) a.in[i] = (const float*)d_in[i];
    a.out = (float*)d_out; a.ws = (unsigned char*)d_ws;
#if MK_LAUNCHES == 1
    a.ph_lo = 0; a.ph_hi = NPHASE;
    hipLaunchKernelGGL(hymba_fwd, dim3(grid), dim3(512), LDS_BYTES, stream, a);
#else
    for (int k = 0; k < NPHASE; ++k) { a.ph_lo = k; a.ph_hi = k + 1; hipLaunchKernelGGL(hymba_fwd, dim3(grid), dim3(512), LDS_BYTES, stream, a); }
#endif
}
```

```cpp
#include <hip/hip_runtime.h>
#include <hip/hip_bf16.h>
#include <stdint.h>
#include <stdio.h>

#ifndef MK_LAUNCHES
#define MK_LAUNCHES 1
#endif

#define DEV __device__ __forceinline__
#define GAS __attribute__((address_space(1)))
#define LAS __attribute__((address_space(3)))

typedef unsigned short bf16_t;
typedef __attribute__((ext_vector_type(8))) short bf16x8;
typedef __attribute__((ext_vector_type(4))) short s16x4;
typedef short v4i16_t __attribute__((ext_vector_type(4)));
typedef __attribute__((ext_vector_type(16))) float f32x16;
typedef __attribute__((ext_vector_type(4))) float f32x4;
typedef __attribute__((ext_vector_type(2))) float f32x2_t;
typedef __attribute__((ext_vector_type(2))) __bf16 bf16x2_t;
typedef __attribute__((ext_vector_type(4))) unsigned u4;
typedef __attribute__((ext_vector_type(2))) unsigned u2;

constexpr int B_ = 8, S_ = 8192, T_ = B_ * S_, D_ = 1024, L_ = 2;
constexpr int INC = 2668;
constexpr int PLD = 2688;
constexpr int C_SBQ = 0, C_SBK = 256, C_SBV = 512, C_SWQ = 768, C_SWK = 1024, C_SWV = 1152, C_NQ = 1280, C_NKC = 1536, C_NVC = 1664,
              C_NKS = 1792, C_NVS = 1920, C_NKW = 2048, C_NVW = 2176, C_CQ = 2304, C_CKV = 2496, C_KPE = 2624, C_NG = 2656;
constexpr float EPS = 1e-6f;
constexpr float LOG2E = 1.4426950408889634f;
constexpr int NPAIR = 112;

constexpr size_t MiB = 1048576;
constexpr size_t WS_CTL = 0;
constexpr size_t CTL_BYTES = 65536;
constexpr int CW_BAR = 0;
constexpr int CW_ATTQ = 4096;
constexpr int CW_CNTE = 4224;
constexpr int CW_CNTP = 4352;
constexpr int CW_VMAX = 4608;
constexpr int CW_NSAF = 8192;
constexpr size_t W_WIN = 1 * MiB;   static_assert(CTL_BYTES <= MiB, "control region");
constexpr size_t W_WOUT = W_WIN + (size_t)L_ * PLD * 1024 * 2;
constexpr size_t W_QUP = W_WOUT + (size_t)L_ * 1024 * 1024 * 2;
constexpr size_t W_KVUP = W_QUP + (size_t)L_ * 384 * 192 * 2;
constexpr size_t W_C1 = W_KVUP + (size_t)L_ * 512 * 128 * 2;
constexpr size_t W_C2 = W_C1 + (size_t)L_ * 2 * 128 * 2048 * 2;
constexpr size_t W_B1 = W_C2 + (size_t)L_ * 2 * 128 * 128 * 2;
constexpr size_t W_R = W_B1 + (size_t)L_ * 2 * 128 * 4;
constexpr size_t W_GU = W_R + (size_t)L_ * 48 * 1024 * 4;
constexpr size_t W_DN = W_GU + (size_t)L_ * 32 * 512 * 1024 * 2;
constexpr size_t W_LUT = W_DN + (size_t)L_ * 32 * 1024 * 256 * 2;
constexpr size_t W_ROPE = W_LUT + 8 * 1024 * 4;
constexpr size_t W_MLAB = W_ROPE + (size_t)S_ * 16 * 2 * 4;
constexpr size_t W_END = W_MLAB + 256;
static_assert(W_END <= 124 * MiB, "weights region");
constexpr size_t R_X = 124 * MiB;
constexpr size_t X_XB = R_X;
constexpr size_t R_Q = R_X + 128 * MiB;
constexpr size_t X_QSB = R_Q;
constexpr size_t X_KSB = R_Q + 32 * MiB;
constexpr size_t X_VSB = R_Q + 64 * MiB;
constexpr size_t X_QSW = R_Q + 96 * MiB;
constexpr size_t R_P = R_Q + 128 * MiB;
constexpr size_t P_PROJ = R_P;
constexpr size_t P_QRAW = R_P;
constexpr size_t P_KVRAW = R_P + 48 * MiB;
constexpr size_t P_ORAW = R_P + 112 * MiB;
constexpr size_t A_QM = R_P + 240 * MiB;
constexpr size_t A_KM = R_P + 288 * MiB;
constexpr size_t R_A = R_P + 336 * MiB;
constexpr size_t A_KSW = R_A;
constexpr size_t A_VSW = R_A + 16 * MiB;
constexpr size_t A_QN = R_A + 32 * MiB;
constexpr size_t A_KNS = R_A + 64 * MiB;
constexpr size_t A_VNS = R_A + 80 * MiB;
constexpr size_t A_KNW = R_A + 96 * MiB;
constexpr size_t A_VNW = R_A + 112 * MiB;
constexpr size_t A_CQN = R_A + 128 * MiB;
constexpr size_t A_CKVN = R_A + 152 * MiB;
constexpr size_t A_KPE = R_A + 168 * MiB;
constexpr size_t A_VM = R_A + 172 * MiB;
constexpr size_t A_XC = R_A + 204 * MiB;
constexpr size_t A_GATES = R_A + 236 * MiB;
constexpr size_t A_KC = R_A + 239 * MiB;
constexpr size_t A_VC = R_A + 240 * MiB;
constexpr size_t A_H1 = R_A + 241 * MiB;
constexpr size_t A_END = R_A + 245 * MiB;
constexpr size_t M_ABUF = R_A;
constexpr size_t M_LISTE = R_A + 64 * MiB;
constexpr size_t M_LISTP = R_A + 72 * MiB;
constexpr size_t M_WSLOT = R_A + 100 * MiB;
constexpr size_t M_RSTD2 = R_A + 101 * MiB;
constexpr size_t R_MISC = A_END;
constexpr size_t MS_RSTD1 = R_MISC;
constexpr size_t MS_SELM = R_MISC + 1 * MiB;
constexpr size_t MS_UNM = R_MISC + 3 * MiB;
constexpr size_t MS_SSQP = R_MISC + 3 * MiB + 262144;
constexpr size_t WS_END = R_MISC + 5 * MiB;
static_assert(WS_END <= 1024 * MiB, "workspace");

DEV unsigned cvtpk(float lo, float hi) { f32x2_t v = {lo, hi}; bf16x2_t b = __builtin_convertvector(v, bf16x2_t); return __builtin_bit_cast(unsigned, b); }
DEV float bflo(unsigned u) { return __uint_as_float(u << 16); }
DEV float bfhi(unsigned u) { return __uint_as_float(u & 0xffff0000u); }
DEV u4 gld16(const void* p) { return *(const GAS u4*)p; }
DEV void gst16(void* p, u4 v) { *(GAS u4*)p = v; }
DEV u2 gld8(const void* p) { return *(const GAS u2*)p; }
DEV void gst8(void* p, u2 v) { *(GAS u2*)p = v; }
DEV float gldf(const void* p) { return *(const GAS float*)p; }
DEV int crow(int r, int hi) { return (r & 3) + 8 * (r >> 2) + 4 * hi; }
DEV float fexp2(float x) { return __builtin_amdgcn_exp2f(x); }
DEV float frcp(float x) { return __builtin_amdgcn_rcpf(x); }
DEV float hsum(float v) { auto rr = __builtin_amdgcn_permlane32_swap(__float_as_uint(v), __float_as_uint(v), false, false); return __uint_as_float(rr[0]) + __uint_as_float(rr[1]); }
DEV float hmax(float v) { auto rr = __builtin_amdgcn_permlane32_swap(__float_as_uint(v), __float_as_uint(v), false, false); return __builtin_fmaxf(__uint_as_float(rr[0]), __uint_as_float(rr[1])); }
DEV float hother(float v, int hi) { auto rr = __builtin_amdgcn_permlane32_swap(__float_as_uint(v), __float_as_uint(v), false, false); return __uint_as_float(hi ? rr[0] : rr[1]); }
DEV unsigned hother_u(unsigned v, int hi) { auto rr = __builtin_amdgcn_permlane32_swap(v, v, false, false); return hi ? rr[0] : rr[1]; }
#define MFMA32(a, b, c) __builtin_amdgcn_mfma_f32_32x32x16_bf16(a, b, c, 0, 0, 0)

extern __shared__ __attribute__((aligned(16))) char smem[];
#define LDS_U4(off) (*(LAS u4*)((LAS char*)smem + (off)))
#define LDS_U2(off) (*(LAS u2*)((LAS char*)smem + (off)))
#define LDS_F(off) (*(LAS float*)((LAS char*)smem + (off)))
#define LDS_I(off) (*(LAS int*)((LAS char*)smem + (off)))
#define LDS_U(off) (*(LAS unsigned*)((LAS char*)smem + (off)))
#define LDS_BF8(off) (*(LAS bf16x8*)((LAS char*)smem + (off)))
DEV s16x4 lds_tr(unsigned off) { return __builtin_bit_cast(s16x4, __builtin_amdgcn_ds_read_tr16_b64_v4i16((LAS v4i16_t*)((LAS char*)smem + off))); }

constexpr int LDS_PH = 1024;
constexpr int LDS_BYTES = 155648;
constexpr int LDS_SCHED = LDS_PH + 147456, LDS_EPI = LDS_SCHED + 512;

#define XB_TMO      128
#define XB_XCNT(j)  (256  + 64 * (j))
#define XB_XSUB(j)  (1280 + 64 * (j))
#define XB_XGEN(j)  (2304 + 64 * (j))
#define XB_TOP      3328
#define XB_TOPGEN   3392
#define XCD_BAR_WORDS 3456
#define XB_SPIN_CAP (1u << 22)
DEV unsigned xb_ld(unsigned* p)              { return __hip_atomic_load(p, __ATOMIC_RELAXED, __HIP_MEMORY_SCOPE_AGENT); }
DEV unsigned xb_add(unsigned* p, unsigned v) { return __hip_atomic_fetch_add(p, v, __ATOMIC_RELAXED, __HIP_MEMORY_SCOPE_AGENT); }
DEV unsigned xb_xcc_id() { return (unsigned)__builtin_amdgcn_s_getreg((3 << 11) | 20) & 0xFu; }
#define XB_SPIN(cond, bar) do { unsigned _sp = 0; while (cond) { __builtin_amdgcn_s_sleep(1); \
    if ((++_sp & 255u) == 0u) { if (xb_ld(&(bar)[XB_TMO])) break; if (_sp > XB_SPIN_CAP) { atomicAdd(&(bar)[XB_TMO], 1u); break; } } } } while (0)
struct XcdBarrier { unsigned* bar; unsigned x; volatile LAS unsigned* st; };
DEV XcdBarrier xcd_barrier_post(unsigned* bar, volatile LAS unsigned* st) {
    XcdBarrier b; b.bar = bar; b.x = xb_xcc_id(); b.st = st;
    if (threadIdx.x == 0) (void)xb_add(&bar[XB_XCNT(b.x)], 1u);
    return b;
}
DEV void xcd_barrier_complete(unsigned* bar, unsigned x, unsigned& nloc, unsigned& nx) {
    const unsigned G = gridDim.x * gridDim.y * gridDim.z;
    unsigned sum, cnt, mine, sp = 0u;
    for (;;) {
        sum = 0u; cnt = 0u; mine = 0u;
#pragma unroll
        for (unsigned j = 0; j < 16; ++j) { const unsigned c = xb_ld(&bar[XB_XCNT(j)]); sum += c; cnt += (c > 0u) ? 1u : 0u; mine = (j == x) ? c : mine; }
        if (sum == G) break;
        __builtin_amdgcn_s_sleep(1);
        if ((++sp & 255u) == 0u) { if (xb_ld(&bar[XB_TMO])) break; if (sp > XB_SPIN_CAP) { atomicAdd(&bar[XB_TMO], 1u); break; } }
    }
    nloc = mine > 0u ? mine : 1u; nx = cnt > 0u ? cnt : 1u;
}
DEV void xcd_barrier(const XcdBarrier& b) {
    asm volatile("s_waitcnt vmcnt(0)" ::: "memory");
    __syncthreads();
    if (threadIdx.x == 0) {
        unsigned* bar = b.bar;
        __builtin_amdgcn_s_waitcnt(0);
        unsigned nloc = b.st[0], nx = b.st[1];
        if (nloc == 0u) { xcd_barrier_complete(bar, b.x, nloc, nx); b.st[0] = nloc; b.st[1] = nx; }
        const unsigned old = xb_add(&bar[XB_XSUB(b.x)], 1u);
        const unsigned gen = old / nloc;
        if (old + 1u == (gen + 1u) * nloc) {
            __builtin_amdgcn_fence(__ATOMIC_RELEASE, "agent");
            asm volatile("s_waitcnt vmcnt(0)" ::: "memory");
            const unsigned og = xb_add(&bar[XB_TOP], 1u);
            const unsigned tg = og / nx;
            if (og + 1u == (tg + 1u) * nx) xb_add(&bar[XB_TOPGEN], 1u);
            else XB_SPIN(xb_ld(&bar[XB_TOPGEN]) == tg, bar);
            __builtin_amdgcn_fence(__ATOMIC_ACQUIRE, "agent");
            xb_add(&bar[XB_XGEN(b.x)], 1u);
            asm volatile("s_waitcnt vmcnt(0)" ::: "memory");
        } else {
            XB_SPIN(xb_ld(&bar[XB_XGEN(b.x)]) == gen, bar);
            __builtin_amdgcn_fence(__ATOMIC_ACQUIRE, "agent");
            asm volatile("s_waitcnt vmcnt(0)" ::: "memory");
        }
    }
    __syncthreads();
}

struct Args {
    const float* in[28];
    float* out;
    unsigned char* ws;
    int ph_lo, ph_hi;
};

template <class F> DEV void xpose64(const F& f, int k0, int n0, bf16_t* dst, long dld, int slot, int half, float (&rg)[8]) {
    const int tid = threadIdx.x; const unsigned base = LDS_PH + slot * (64 * 65 * 4);
    if (half == 0) {
#pragma unroll
        for (int r = 0; r < 2; ++r) { const int idx = tid + 512 * r, i = idx >> 4, j4 = (idx & 15) * 4; float o4[4]; f.ld4(k0 + i, n0 + j4, o4); rg[4 * r] = o4[0]; rg[4 * r + 1] = o4[1]; rg[4 * r + 2] = o4[2]; rg[4 * r + 3] = o4[3]; }
    } else if (half == 2) {
#pragma unroll
        for (int r = 0; r < 2; ++r) { const int idx = tid + 512 * r, i = idx >> 4, j4 = (idx & 15) * 4;
#pragma unroll
            for (int e = 0; e < 4; ++e) LDS_F(base + (i * 65 + j4 + e) * 4) = rg[4 * r + e]; }
    } else {
        const int j = tid >> 3, ch = tid & 7; float v[8];
#pragma unroll
        for (int e = 0; e < 8; ++e) v[e] = LDS_F(base + ((ch * 8 + e) * 65 + j) * 4);
        u4 o; o.x = cvtpk(v[0], v[1]); o.y = cvtpk(v[2], v[3]); o.z = cvtpk(v[4], v[5]); o.w = cvtpk(v[6], v[7]);
        gst16(dst + (long)(n0 + j) * dld + k0 + ch * 8, o);
    }
}
struct FWin { const float* w; const float* g; DEV float operator()(int k, int n) const {
    const int oc = n < 2304 ? n : (n < 2656 ? n + 12 : (n < 2668 ? n - 352 : -1));
    return oc < 0 ? 0.f : gldf(g + k) * gldf(w + (long)k * INC + oc); }
    DEV void ld4(int k, int n, float (&o)[4]) const {
        const int oc = n < 2304 ? n : (n < 2656 ? n + 12 : (n < 2668 ? n - 352 : -1)); u4 v = {0u, 0u, 0u, 0u}; float gk = 0.f;
        if (oc >= 0) { v = gld16(w + (long)k * INC + oc); gk = gldf(g + k); }
        o[0] = gk * __uint_as_float(v.x); o[1] = gk * __uint_as_float(v.y); o[2] = gk * __uint_as_float(v.z); o[3] = gk * __uint_as_float(v.w); } };
struct FScaled { const float* w; const float* g; int ld; DEV float operator()(int k, int n) const { return gldf(g + k) * gldf(w + (long)k * ld + n); }
    DEV void ld4(int k, int n, float (&o)[4]) const { const u4 v = gld16(w + (long)k * ld + n); const float gk = gldf(g + k);
        o[0] = gk * __uint_as_float(v.x); o[1] = gk * __uint_as_float(v.y); o[2] = gk * __uint_as_float(v.z); o[3] = gk * __uint_as_float(v.w); } };
struct FPlain { const float* w; int ld; DEV float operator()(int k, int n) const { return gldf(w + (long)k * ld + n); }
    DEV void ld4(int k, int n, float (&o)[4]) const { const u4 v = gld16(w + (long)k * ld + n); o[0] = __uint_as_float(v.x); o[1] = __uint_as_float(v.y); o[2] = __uint_as_float(v.z); o[3] = __uint_as_float(v.w); } };
struct FC2 { const float* w; DEV float operator()(int k, int n) const { return n < 64 ? gldf(w + k * 64 + n) : 0.f; }
    DEV void ld4(int k, int n, float (&o)[4]) const { u4 v = {0u, 0u, 0u, 0u}; if (n < 64) v = gld16(w + k * 64 + n); o[0] = __uint_as_float(v.x); o[1] = __uint_as_float(v.y); o[2] = __uint_as_float(v.z); o[3] = __uint_as_float(v.w); } };
struct FGU { const float* wg; const float* wu; const float* g; DEV float operator()(int k, int n) const {
    const int j = 32 * (n >> 6) + (n & 31); const float* w = (const float*)((uintptr_t)wg + (uintptr_t)((n >> 5) & 1) * ((uintptr_t)wu - (uintptr_t)wg)); return gldf(g + k) * gldf(w + (long)k * 256 + j); }
    DEV void ld4(int k, int n, float (&o)[4]) const {
        const int j = 32 * (n >> 6) + (n & 31); const float* w = (const float*)((uintptr_t)wg + (uintptr_t)((n >> 5) & 1) * ((uintptr_t)wu - (uintptr_t)wg)); const u4 v = gld16(w + (long)k * 256 + j); const float gk = gldf(g + k);
        o[0] = gk * __uint_as_float(v.x); o[1] = gk * __uint_as_float(v.y); o[2] = gk * __uint_as_float(v.z); o[3] = gk * __uint_as_float(v.w); } };

__constant__ float c_invf[16] = {1.0f, 0.5623413324356079f, 0.3162277638912201f, 0.17782793939113617f, 0.10000000149011612f, 0.05623413249850273f,
    0.03162277489900589f, 0.017782794311642647f, 0.009999999776482582f, 0.005623413249850273f, 0.003162277629598975f, 0.0017782794311642647f,
    0.0010000000474974513f, 0.000562341301701963f, 0.0003162277571391314f, 0.00017782794020604342f};
DEV int t5_bucket(int n) {
    if (n < 16) return n;
    int b = 16;
    b += (n >= 21) + (n >= 27) + (n >= 35) + (n >= 46) + (n >= 59) + (n >= 77) + (n >= 99) + (n >= 128) + (n >= 166) + (n >= 216) + (n >= 280) + (n >= 363) + (n >= 470) + (n >= 609) + (n >= 790);
    return b;
}

namespace p0c {
constexpr int N_WIN = L_ * 16 * 42, N_WOUT = L_ * 256, N_QUP = L_ * 18, N_KVUP = L_ * 16, N_C1 = L_ * 2 * 64, N_C2 = L_ * 2 * 4, N_GU = L_ * 32 * 128, N_DN = L_ * 32 * 64;
constexpr int O1 = N_WIN, O2 = O1 + N_WOUT, O3 = O2 + N_QUP, O4 = O3 + N_KVUP, O5 = O4 + N_C1, O6 = O5 + N_C2, O7 = O6 + N_GU, O8 = O7 + N_DN;
}
DEV void p0_tile(const Args& a, int t, int u, int half, float (&rg)[8]) {
    using namespace p0c; unsigned char* ws = a.ws;
        if (t < O1) { const int l = t / 672, r = t % 672, kt = r / 42, nt = r % 42;
            FWin f{a.in[3] + (long)l * 1024 * INC, a.in[2] + l * 1024}; xpose64(f, kt * 64, nt * 64, (bf16_t*)(ws + W_WIN) + (long)l * PLD * 1024, 1024, u, half, rg);
        } else if (t < O2) { const int u2 = t - O1, l = u2 / 256, r = u2 % 256, kt = r / 16, nt = r % 16;
            FScaled f{a.in[19] + (long)l * 1048576, a.in[18] + l * 1024, 1024}; xpose64(f, kt * 64, nt * 64, (bf16_t*)(ws + W_WOUT) + (long)l * 1048576, 1024, u, half, rg);
        } else if (t < O3) { const int u2 = t - O2, l = u2 / 18, r = u2 % 18, kt = r / 6, nt = r % 6;
            FScaled f{a.in[13] + (long)l * 192 * 384, a.in[12] + l * 192, 384}; xpose64(f, kt * 64, nt * 64, (bf16_t*)(ws + W_QUP) + (long)l * 384 * 192, 192, u, half, rg);
        } else if (t < O4) { const int u2 = t - O3, l = u2 / 16, r = u2 % 16, kt = r / 8, nt = r % 8;
            FScaled f{a.in[15] + (long)l * 128 * 512, a.in[14] + l * 128, 512}; xpose64(f, kt * 64, nt * 64, (bf16_t*)(ws + W_KVUP) + (long)l * 512 * 128, 128, u, half, rg);
        } else if (t < O5) { const int u2 = t - O4, lw = u2 / 64, r = u2 % 64, kt = r / 2, nt = r % 2;
            FPlain f{a.in[10] + (long)lw * 2048 * 128, 128}; xpose64(f, kt * 64, nt * 64, (bf16_t*)(ws + W_C1) + (long)lw * 128 * 2048, 2048, u, half, rg);
        } else if (t < O6) { const int u2 = t - O5, lw = u2 / 4, r = u2 % 4, kt = r / 2, nt = r % 2;
            FC2 f{a.in[11] + (long)lw * 128 * 64}; xpose64(f, kt * 64, nt * 64, (bf16_t*)(ws + W_C2) + (long)lw * 128 * 128, 128, u, half, rg);
        } else if (t < O7) { const int u2 = t - O6, le = u2 / 128, r = u2 % 128, kt = r / 8, nt = r % 8;
            FGU f{a.in[25] + (long)le * 262144, a.in[26] + (long)le * 262144, a.in[20] + (le / 32) * 1024}; xpose64(f, kt * 64, nt * 64, (bf16_t*)(ws + W_GU) + (long)le * 524288, 1024, u, half, rg);
        } else { const int u2 = t - O7, le = u2 / 64, r = u2 % 64, kt = r / 16, nt = r % 16;
            FPlain f{a.in[27] + (long)le * 262144, 1024}; xpose64(f, kt * 64, nt * 64, (bf16_t*)(ws + W_DN) + (long)le * 262144, 256, u, half, rg);
        }
}
DEV void phase_p0(const Args& a) {
    using namespace p0c; unsigned char* ws = a.ws;
    {
        float rg[6][8]; const int tstep = (int)gridDim.x * 6;
        int t0 = (int)blockIdx.x * 6;
#pragma unroll
        for (int u = 0; u < 6; ++u) if (t0 + u < O8) p0_tile(a, t0 + u, u, 0, rg[u]);
        for (; t0 < O8; t0 += tstep) {
#pragma unroll
            for (int u = 0; u < 6; ++u) if (t0 + u < O8) p0_tile(a, t0 + u, u, 2, rg[u]);
            __syncthreads();
            const int t1 = t0 + tstep;
#pragma unroll
            for (int u = 0; u < 6; ++u) if (t1 + u < O8) p0_tile(a, t1 + u, u, 0, rg[u]);
#pragma unroll
            for (int u = 0; u < 6; ++u) if (t0 + u < O8) p0_tile(a, t0 + u, u, 1, rg[u]);
            __syncthreads();
        }
    }
    const int gtid = blockIdx.x * 512 + threadIdx.x, gsz = gridDim.x * 512;
    for (int i = gtid; i < L_ * 2 * 128; i += gsz) {
        const int lw = i >> 7, f = i & 127; const float* pos = a.in[9] + (long)lw * 2048; const float* w1 = a.in[10] + (long)lw * 2048 * 128;
        float s = 0.f; for (int k = 0; k < 2048; ++k) s += gldf(pos + k) * gldf(w1 + (long)k * 128 + f);
        ((float*)(ws + W_B1))[i] = s;
    }
    for (int i = gtid; i < L_ * 48 * 1024; i += gsz) {
        const int l = i / 49152, r = i % 49152, j = r >> 10, k = r & 1023;
        float v = 0.f; if (j < 4) v = gldf(a.in[21] + (long)l * 4096 + k * 4 + j); else if (j < 36) v = gldf(a.in[23] + (long)l * 32768 + k * 32 + (j - 4));
        ((float*)(ws + W_R))[i] = v * gldf(a.in[20] + l * 1024 + k);
    }
    for (int i = gtid; i < L_; i += gsz) {
        float gq = 0.f, gk = 0.f; for (int j = 0; j < 96; ++j) { gq = __builtin_fmaxf(gq, __builtin_fabsf(gldf(a.in[16] + i * 96 + j))); gk = __builtin_fmaxf(gk, __builtin_fabsf(gldf(a.in[17] + i * 96 + j))); }
        ((float*)(ws + W_MLAB))[i] = 96.f * gq * gk * (0.10206207261596577f * LOG2E) * 1.02f + 0.1f; }
    for (int i = gtid; i < 8 * 1024; i += gsz) { const int h = i >> 10, d = i & 1023; ((float*)(ws + W_LUT))[i] = gldf(a.in[1] + t5_bucket(d) * 8 + h) * LOG2E; }
    for (int i = gtid; i < S_ * 16; i += gsz) { const int s = i >> 4, f = i & 15;
        const float ang = (float)s * c_invf[f]; double rev = (double)ang * 0.15915494309189535; rev -= __builtin_rint(rev);
        const float rv = (float)rev; ((float*)(ws + W_ROPE))[2 * i] = __builtin_amdgcn_cosf(rv); ((float*)(ws + W_ROPE))[2 * i + 1] = __builtin_amdgcn_sinf(rv); }
}

DEV void phase_rowstat(const float* x, bf16_t* xb, float* rstd) {
    const int lane = threadIdx.x & 63, wv = threadIdx.x >> 6;
    for (int t = blockIdx.x * 8 + wv; t < T_; t += gridDim.x * 8) {
        const float* xr = x + (long)t * 1024; float ss = 0.f;
#pragma unroll
        for (int i = 0; i < 2; ++i) {
            const u4 u = gld16(xr + i * 512 + lane * 8), w = gld16(xr + i * 512 + lane * 8 + 4);
            const float v0 = __uint_as_float(u.x), v1 = __uint_as_float(u.y), v2 = __uint_as_float(u.z), v3 = __uint_as_float(u.w), v4 = __uint_as_float(w.x), v5 = __uint_as_float(w.y), v6 = __uint_as_float(w.z), v7 = __uint_as_float(w.w);
            ss += (v0 * v0 + v1 * v1 + v2 * v2 + v3 * v3) + (v4 * v4 + v5 * v5 + v6 * v6 + v7 * v7);
            u4 o; o.x = cvtpk(v0, v1); o.y = cvtpk(v2, v3); o.z = cvtpk(v4, v5); o.w = cvtpk(v6, v7); gst16(xb + (long)t * 1024 + i * 512 + lane * 8, o);
        }
#pragma unroll
        for (int m = 1; m < 64; m <<= 1) ss += __shfl_xor(ss, m);
        if (lane == 0) rstd[t] = ss;
    }
}

#define GLDS16(gp, ldsoff) __builtin_amdgcn_global_load_lds((const unsigned*)(gp), (unsigned*)(smem + (ldsoff)), 16, 0, 0)
template <class P, int TM, class = void> struct GemmPre { struct type {}; static constexpr bool on = false; };
template <class P, int TM> struct GemmPre<P, TM, decltype((void)sizeof(typename P::template Pre<TM>))> { typedef typename P::template Pre<TM> type; static constexpr bool on = true; };
template <int TM, int WN, class P>
DEV void gemm_tile(const P& p, int m0, int n0, int mrows) {
    constexpr int WM = 8 / WN, BM = 32 * TM * WM, BN = 64 * WN, STG = (BM + BN) * 128, NA = BM / 64, NB = BN / 64;
    const int tid = threadIdx.x, lane = tid & 63, wid = tid >> 6, wm = wid / WN, wn = wid % WN, l31 = lane & 31, hi = lane >> 5;
    typename GemmPre<P, TM>::type pre;
    if constexpr (GemmPre<P, TM>::on) p.template pre1<TM>(pre, m0, n0, mrows, wm, wn, lane);
    const bf16_t* ap[NA]; long bo[NB];
#pragma unroll
    for (int i = 0; i < NA; ++i) { const int row = (tid + 512 * i) >> 3, pc = tid & 7; const int rr = row < mrows ? row : mrows - 1;
        ap[i] = p.a_row(m0 + rr) + ((pc ^ ((row >> 1) & 7)) << 3); }
#pragma unroll
    for (int i = 0; i < NB; ++i) { const int n = (tid + 512 * i) >> 3, pc = tid & 7; bo[i] = (long)(n0 + n) * p.ldb() + ((pc ^ ((n >> 1) & 7)) << 3); }
    unsigned rab[TM], rasw[TM], rbb[2], rbsw[2];
#pragma unroll
    for (int i = 0; i < TM; ++i) { const int row = wm * 32 * TM + i * 32 + l31; rab[i] = row * 128; rasw[i] = (row >> 1) & 7; }
#pragma unroll
    for (int j = 0; j < 2; ++j) { const int n = wn * 64 + j * 32 + l31; rbb[j] = BM * 128 + n * 128; rbsw[j] = (n >> 1) & 7; }
    f32x16 acc[TM][2];
#pragma unroll
    for (int i = 0; i < TM; ++i) { acc[i][0] = f32x16{}; acc[i][1] = f32x16{}; }
    const int nk = p.nk(); const long aks = p.a_kstride();
    {   const bf16_t* bb = p.b_base(0);
#pragma unroll
        for (int i = 0; i < NA; ++i) GLDS16(ap[i], LDS_PH + (tid + 512 * i) * 16);
#pragma unroll
        for (int i = 0; i < NB; ++i) GLDS16(bb + bo[i], LDS_PH + BM * 128 + (tid + 512 * i) * 16);
    }
    if constexpr (GemmPre<P, TM>::on) p.template pre2<TM>(pre, m0, n0, mrows, wm, wn, lane);
    __syncthreads();
    for (int kt = 0; kt < nk; ++kt) {
        const unsigned cur = LDS_PH + (kt & 1) * STG, nxt = LDS_PH + ((kt + 1) & 1) * STG;
        if (kt + 1 < nk) { const bf16_t* bb = p.b_base(kt + 1);
#pragma unroll
            for (int i = 0; i < NA; ++i) GLDS16(ap[i] + (long)(kt + 1) * aks, nxt + (tid + 512 * i) * 16);
#pragma unroll
            for (int i = 0; i < NB; ++i) GLDS16(bb + bo[i], nxt + BM * 128 + (tid + 512 * i) * 16); }
        bf16x8 af[2][TM], bf[2][2];
#pragma unroll
        for (int i = 0; i < TM; ++i) af[0][i] = LDS_BF8(cur + rab[i] + (((0 + hi) ^ rasw[i]) << 4));
#pragma unroll
        for (int j = 0; j < 2; ++j) bf[0][j] = LDS_BF8(cur + rbb[j] + (((0 + hi) ^ rbsw[j]) << 4));
#pragma unroll
        for (int ks = 0; ks < 4; ++ks) {
            if (ks < 3) {
#pragma unroll
                for (int i = 0; i < TM; ++i) af[(ks + 1) & 1][i] = LDS_BF8(cur + rab[i] + (((2 * (ks + 1) + hi) ^ rasw[i]) << 4));
#pragma unroll
                for (int j = 0; j < 2; ++j) bf[(ks + 1) & 1][j] = LDS_BF8(cur + rbb[j] + (((2 * (ks + 1) + hi) ^ rbsw[j]) << 4));
                __builtin_amdgcn_sched_barrier(0);
            }
#pragma unroll
            for (int i = 0; i < TM; ++i)
#pragma unroll
                for (int j = 0; j < 2; ++j) acc[i][j] = MFMA32(bf[ks & 1][j], af[ks & 1][i], acc[i][j]);
            __builtin_amdgcn_sched_barrier(0);
        }
        __syncthreads();
    }
    if constexpr (GemmPre<P, TM>::on) p.template epi<TM>(acc, m0, n0, mrows, wm, wn, lane, pre); else p.template epi<TM>(acc, m0, n0, mrows, wm, wn, lane);
}
template <int TM, int WN, class P>
DEV void gemm_tile3(const P& p, int m0, int n0, int mrows) {
    constexpr int WM = 8 / WN, BM = 32 * TM * WM, BN = 64 * WN, STG = (BM + BN) * 128, NA = BM / 64, NB = BN / 64;
    const int tid = threadIdx.x, lane = tid & 63, wid = tid >> 6, wm = wid / WN, wn = wid % WN, l31 = lane & 31, hi = lane >> 5;
    typename GemmPre<P, TM>::type pre;
    if constexpr (GemmPre<P, TM>::on) p.template pre1<TM>(pre, m0, n0, mrows, wm, wn, lane);
    const bf16_t* ap[NA]; long bo[NB];
#pragma unroll
    for (int i = 0; i < NA; ++i) { const int row = (tid + 512 * i) >> 3, pc = tid & 7; const int rr = row < mrows ? row : mrows - 1;
        ap[i] = p.a_row(m0 + rr) + ((pc ^ ((row >> 1) & 7)) << 3); }
#pragma unroll
    for (int i = 0; i < NB; ++i) { const int n = (tid + 512 * i) >> 3, pc = tid & 7; bo[i] = (long)(n0 + n) * p.ldb() + ((pc ^ ((n >> 1) & 7)) << 3); }
    unsigned rab[TM], rasw[TM], rbb[2], rbsw[2];
#pragma unroll
    for (int i = 0; i < TM; ++i) { const int row = wm * 32 * TM + i * 32 + l31; rab[i] = row * 128; rasw[i] = (row >> 1) & 7; }
#pragma unroll
    for (int j = 0; j < 2; ++j) { const int n = wn * 64 + j * 32 + l31; rbb[j] = BM * 128 + n * 128; rbsw[j] = (n >> 1) & 7; }
    f32x16 acc[TM][2];
#pragma unroll
    for (int i = 0; i < TM; ++i) { acc[i][0] = f32x16{}; acc[i][1] = f32x16{}; }
    const int nk = p.nk(); const long aks = p.a_kstride();
    static_assert(NA + NB == 6, "counted waits below assume 6 LDS-DMA instructions per thread and stage");
#pragma unroll
    for (int st = 0; st < 2; ++st) { const bf16_t* bb = p.b_base(st);
#pragma unroll
        for (int i = 0; i < NA; ++i) GLDS16(ap[i] + (long)st * aks, LDS_PH + st * STG + (tid + 512 * i) * 16);
#pragma unroll
        for (int i = 0; i < NB; ++i) GLDS16(bb + bo[i], LDS_PH + st * STG + BM * 128 + (tid + 512 * i) * 16);
    }
    asm volatile("s_waitcnt vmcnt(6)" ::: "memory");
    if constexpr (GemmPre<P, TM>::on) p.template pre2<TM>(pre, m0, n0, mrows, wm, wn, lane);
    __builtin_amdgcn_s_barrier();
    int cs = 0;
    for (int kt = 0; kt < nk; ++kt) {
        const unsigned cur = LDS_PH + cs * STG; const int ns = cs >= 1 ? cs - 1 : 2;
        const unsigned nxt = LDS_PH + ns * STG;
        if (kt + 2 < nk) { const bf16_t* bb = p.b_base(kt + 2);
#pragma unroll
            for (int i = 0; i < NA; ++i) GLDS16(ap[i] + (long)(kt + 2) * aks, nxt + (tid + 512 * i) * 16);
#pragma unroll
            for (int i = 0; i < NB; ++i) GLDS16(bb + bo[i], nxt + BM * 128 + (tid + 512 * i) * 16); }
        bf16x8 af[2][TM], bf[2][2];
#pragma unroll
        for (int i = 0; i < TM; ++i) af[0][i] = LDS_BF8(cur + rab[i] + (((0 + hi) ^ rasw[i]) << 4));
#pragma unroll
        for (int j = 0; j < 2; ++j) bf[0][j] = LDS_BF8(cur + rbb[j] + (((0 + hi) ^ rbsw[j]) << 4));
#pragma unroll
        for (int ks = 0; ks < 4; ++ks) {
            if (ks < 3) {
#pragma unroll
                for (int i = 0; i < TM; ++i) af[(ks + 1) & 1][i] = LDS_BF8(cur + rab[i] + (((2 * (ks + 1) + hi) ^ rasw[i]) << 4));
#pragma unroll
                for (int j = 0; j < 2; ++j) bf[(ks + 1) & 1][j] = LDS_BF8(cur + rbb[j] + (((2 * (ks + 1) + hi) ^ rbsw[j]) << 4));
                __builtin_amdgcn_sched_barrier(0);
            }
#pragma unroll
            for (int i = 0; i < TM; ++i)
#pragma unroll
                for (int j = 0; j < 2; ++j) acc[i][j] = MFMA32(bf[ks & 1][j], af[ks & 1][i], acc[i][j]);
            __builtin_amdgcn_sched_barrier(0);
        }
        if (kt + 2 < nk) asm volatile("s_waitcnt vmcnt(6) lgkmcnt(0)" ::: "memory"); else asm volatile("s_waitcnt vmcnt(0) lgkmcnt(0)" ::: "memory");
        __builtin_amdgcn_s_barrier();
        cs = cs == 2 ? 0 : cs + 1;
    }
    __syncthreads();
    if constexpr (GemmPre<P, TM>::on) p.template epi<TM>(acc, m0, n0, mrows, wm, wn, lane, pre); else p.template epi<TM>(acc, m0, n0, mrows, wm, wn, lane);
}
#define EPI_M(TM, i) (wm * 32 * TM + (i) * 32 + (lane & 31))
#define EPI_NB(j, q) (wn * 64 + (j) * 32 + 8 * (q) + 4 * (lane >> 5))
#define EPI_JQ _Pragma("unroll") for (int j = 0; j < 2; ++j) _Pragma("unroll") for (int q = 0; q < 4; ++q)
DEV u2 pack4(float a, float b, float c, float d) { u2 o; o.x = cvtpk(a, b); o.y = cvtpk(c, d); return o; }
DEV u4 pair_swap(u2 a, u2 b) { auto r = __builtin_amdgcn_permlane32_swap(a.x, b.x, false, false); auto t = __builtin_amdgcn_permlane32_swap(a.y, b.y, false, false);
    u4 w; w.x = r[0]; w.y = t[0]; w.z = r[1]; w.w = t[1]; return w; }
DEV void pair_unswap(u4 w, u2& a, u2& b) { auto r = __builtin_amdgcn_permlane32_swap(w.x, w.z, false, false); auto t = __builtin_amdgcn_permlane32_swap(w.y, w.w, false, false);
    a.x = r[0]; a.y = t[0]; b.x = r[1]; b.y = t[1]; }
DEV void st_bf16(bf16_t* p, float v) { *(GAS bf16_t*)p = (bf16_t)(cvtpk(v, 0.f) & 0xffffu); }

struct GemmIn {
    const bf16_t* A; const bf16_t* Bt; const float* rstd; bf16_t* C; int nparts;
    DEV const bf16_t* a_row(int r) const { return A + (long)r * 1024; }
    DEV long a_kstride() const { return 64; }
    DEV const bf16_t* b_base(int kt) const { return Bt + kt * 64; }
    DEV long ldb() const { return 1024; }
    DEV int nk() const { return 16; }
    template <int TM> DEV void epi(f32x16 (&acc)[TM][2], int m0, int n0, int mrows, int wm, int wn, int lane) const {
#pragma unroll
        for (int i = 0; i < TM; ++i) { const int row = m0 + EPI_M(TM, i); float sq = gldf(rstd + row); if (nparts == 4) sq = ((sq + gldf(rstd + T_ + row)) + gldf(rstd + 2 * T_ + row)) + gldf(rstd + 3 * T_ + row);
            const float rs = __builtin_amdgcn_rsqf(sq * (1.f / 1024.f) + EPS); bf16_t* cr = C + (long)row * PLD + n0;
            EPI_JQ gst8(cr + EPI_NB(j, q), pack4(acc[i][j][4 * q] * rs, acc[i][j][4 * q + 1] * rs, acc[i][j][4 * q + 2] * rs, acc[i][j][4 * q + 3] * rs)); }
    }
};
struct GemmPlain {
    const bf16_t* A; long lda; const bf16_t* Bt; long ldb_; int nk_; bf16_t* C; long ldc;
    DEV const bf16_t* a_row(int r) const { return A + (long)r * lda; }
    DEV long a_kstride() const { return 64; }
    DEV const bf16_t* b_base(int kt) const { return Bt + kt * 64; }
    DEV long ldb() const { return ldb_; }
    DEV int nk() const { return nk_; }
    template <int TM> DEV void epi(f32x16 (&acc)[TM][2], int m0, int n0, int mrows, int wm, int wn, int lane) const {
#pragma unroll
        for (int i = 0; i < TM; ++i) { bf16_t* cr = C + (long)(m0 + EPI_M(TM, i)) * ldc + n0;
#pragma unroll
            for (int j = 0; j < 2; ++j)
#pragma unroll
                for (int q = 0; q < 4; q += 2)
                    gst16(cr + wn * 64 + j * 32 + 8 * q + 8 * (lane >> 5), pair_swap(pack4(acc[i][j][4 * q], acc[i][j][4 * q + 1], acc[i][j][4 * q + 2], acc[i][j][4 * q + 3]),
                                                                                          pack4(acc[i][j][4 * q + 4], acc[i][j][4 * q + 5], acc[i][j][4 * q + 6], acc[i][j][4 * q + 7]))); }
    }
};
template <class MK> DEV void gemm_smallk_run(const MK& mk, int tfirst, int tstep, int tend) {
    constexpr int TM = 2, WN = 2, BM = 256, BN = 128, STG = (BM + BN) * 128, NA = BM / 64, NB = BN / 64;
    const int tid = threadIdx.x, lane = tid & 63, wid = tid >> 6, wm = wid / WN, wn = wid % WN, l31 = lane & 31, hi = lane >> 5;
    if (tfirst >= tend) return;
    unsigned rab[TM], rasw[TM], rbb[2], rbsw[2];
#pragma unroll
    for (int i = 0; i < TM; ++i) { const int row = wm * 32 * TM + i * 32 + l31; rab[i] = row * 128; rasw[i] = (row >> 1) & 7; }
#pragma unroll
    for (int j = 0; j < 2; ++j) { const int n = wn * 64 + j * 32 + l31; rbb[j] = BM * 128 + n * 128; rbsw[j] = (n >> 1) & 7; }
#define SMK_ISSUE(T) do { GemmPlain q_; int qm_, qn_; mk((T), q_, qm_, qn_); \
        for (int kt_ = 0; kt_ < q_.nk_; ++kt_) { \
            _Pragma("unroll") for (int i = 0; i < NA; ++i) { const int row = (tid + 512 * i) >> 3, pc = tid & 7; GLDS16(q_.A + (long)(qm_ + row) * q_.lda + kt_ * 64 + ((pc ^ ((row >> 1) & 7)) << 3), LDS_PH + kt_ * STG + (tid + 512 * i) * 16); } \
            _Pragma("unroll") for (int i = 0; i < NB; ++i) { const int n = (tid + 512 * i) >> 3, pc = tid & 7; GLDS16(q_.Bt + (long)(qn_ + n) * q_.ldb_ + kt_ * 64 + ((pc ^ ((n >> 1) & 7)) << 3), LDS_PH + kt_ * STG + BM * 128 + (tid + 512 * i) * 16); } } } while (0)
    SMK_ISSUE(tfirst);
    asm volatile("s_waitcnt vmcnt(0)" ::: "memory");
    for (int t = tfirst; t < tend; t += tstep) {
        GemmPlain p; int m0, n0; mk(t, p, m0, n0);
        __builtin_amdgcn_s_barrier();
        f32x16 acc[TM][2];
#pragma unroll
        for (int i = 0; i < TM; ++i) { acc[i][0] = f32x16{}; acc[i][1] = f32x16{}; }
        for (int kt = 0; kt < p.nk_; ++kt) {
            const unsigned cur = LDS_PH + kt * STG;
            bf16x8 af[2][TM], bf[2][2];
#pragma unroll
            for (int i = 0; i < TM; ++i) af[0][i] = LDS_BF8(cur + rab[i] + (((0 + hi) ^ rasw[i]) << 4));
#pragma unroll
            for (int j = 0; j < 2; ++j) bf[0][j] = LDS_BF8(cur + rbb[j] + (((0 + hi) ^ rbsw[j]) << 4));
#pragma unroll
            for (int ks = 0; ks < 4; ++ks) {
                if (ks < 3) {
#pragma unroll
                    for (int i = 0; i < TM; ++i) af[(ks + 1) & 1][i] = LDS_BF8(cur + rab[i] + (((2 * (ks + 1) + hi) ^ rasw[i]) << 4));
#pragma unroll
                    for (int j = 0; j < 2; ++j) bf[(ks + 1) & 1][j] = LDS_BF8(cur + rbb[j] + (((2 * (ks + 1) + hi) ^ rbsw[j]) << 4));
                    __builtin_amdgcn_sched_barrier(0);
                }
#pragma unroll
                for (int i = 0; i < TM; ++i)
#pragma unroll
                    for (int j = 0; j < 2; ++j) acc[i][j] = MFMA32(bf[ks & 1][j], af[ks & 1][i], acc[i][j]);
                __builtin_amdgcn_sched_barrier(0);
            }
        }
        asm volatile("s_waitcnt lgkmcnt(0)" ::: "memory");
        __builtin_amdgcn_s_barrier();
        const bool more = t + tstep < tend;
        if (more) SMK_ISSUE(t + tstep);
        __builtin_amdgcn_sched_barrier(0);
        p.template epi<TM>(acc, m0, n0, 256, wm, wn, lane);
        __builtin_amdgcn_sched_barrier(0);
        if (more) asm volatile("s_waitcnt vmcnt(8)" ::: "memory");
    }
#undef SMK_ISSUE
}
DEV float gelu_tanh(float x) { const float u = 0.7978845608028654f * (x + 0.044715f * x * x * x); const float e = fexp2(u * (2.f * LOG2E)); return 0.5f * x * (2.f - 2.f * frcp(1.f + e)); }
struct GemmCmp1 {
    const bf16_t* Xc; int w; const bf16_t* Bt; const float* bias; bf16_t* H1;
    DEV const bf16_t* a_row(int r) const { const int hk = r & 1, bn = r >> 1, b = bn >> 9; int n = bn & 511; n = n > 510 ? 510 : n;
        return Xc + ((long)(b * S_ + 16 * n) * 4 + w * 2 + hk) * 64; }
    DEV long a_kstride() const { return 256; }
    DEV const bf16_t* b_base(int kt) const { return Bt + kt * 64; }
    DEV long ldb() const { return 2048; }
    DEV int nk() const { return 32; }
    template <int TM> DEV void epi(f32x16 (&acc)[TM][2], int m0, int n0, int mrows, int wm, int wn, int lane) const {
#pragma unroll
        for (int i = 0; i < TM; ++i) { bf16_t* cr = H1 + (long)(m0 + EPI_M(TM, i)) * 128 + n0;
            EPI_JQ { const int nb = EPI_NB(j, q); const u4 bb = gld16(bias + n0 + nb);
                gst8(cr + nb, pack4(gelu_tanh(acc[i][j][4 * q] + __uint_as_float(bb.x)), gelu_tanh(acc[i][j][4 * q + 1] + __uint_as_float(bb.y)),
                                    gelu_tanh(acc[i][j][4 * q + 2] + __uint_as_float(bb.z)), gelu_tanh(acc[i][j][4 * q + 3] + __uint_as_float(bb.w)))); } }
    }
};
struct GemmCmp2 {
    const bf16_t* H1; int w; const bf16_t* Bt; const float* gain; bf16_t* Kimg; bf16_t* Vimg;
    DEV const bf16_t* a_row(int r) const { return H1 + (long)r * 128; }
    DEV long a_kstride() const { return 64; }
    DEV const bf16_t* b_base(int kt) const { return Bt + kt * 64; }
    DEV long ldb() const { return 128; }
    DEV int nk() const { return 2; }
    template <int TM> DEV void epi(f32x16 (&acc)[TM][2], int m0, int n0, int mrows, int wm, int wn, int lane) const {
        if (wn != 0) return;
#pragma unroll
        for (int i = 0; i < TM; ++i) {
            const int row = m0 + EPI_M(TM, i); const int hk = row & 1, bn = row >> 1, b = bn >> 9, n = bn & 511;
            float rs = 1.f;
            if (w == 0) { float ss = 0.f;
#pragma unroll
                for (int r = 0; r < 16; ++r) ss += acc[i][0][r] * acc[i][0][r] + acc[i][1][r] * acc[i][1][r];
                rs = __builtin_amdgcn_rsqf(hsum(ss) * (1.f / 64.f) + EPS); }
            if (n == 511) rs = 0.f;
            const long tb = ((long)(b * 2 + hk) * 8 + (n >> 6)) * 4096; const int key = n & 63;
            EPI_JQ { const int col = j * 32 + 8 * q + 4 * (lane >> 5); float v0 = acc[i][j][4 * q] * rs, v1 = acc[i][j][4 * q + 1] * rs, v2 = acc[i][j][4 * q + 2] * rs, v3 = acc[i][j][4 * q + 3] * rs;
                if (w == 0) { const u4 gg = gld16(gain + col); v0 *= __uint_as_float(gg.x); v1 *= __uint_as_float(gg.y); v2 *= __uint_as_float(gg.z); v3 *= __uint_as_float(gg.w);
                    gst8(Kimg + tb + (col >> 3) * 512 + key * 8 + (col & 7), pack4(v0, v1, v2, v3)); }
                else gst8(Vimg + tb + (col >> 5) * 2048 + key * 32 + (col & 31), pack4(v0, v1, v2, v3)); }
        }
    }
};
struct GemmOut {
    const bf16_t* A; const bf16_t* Bt; const float* xin; float* xout;
    DEV const bf16_t* a_row(int r) const { return A + (long)r * 1024; }
    DEV long a_kstride() const { return 64; }
    DEV const bf16_t* b_base(int kt) const { return Bt + kt * 64; }
    DEV long ldb() const { return 1024; }
    DEV int nk() const { return 16; }
    template <int TM> DEV void epi(f32x16 (&acc)[TM][2], int m0, int n0, int mrows, int wm, int wn, int lane) const {
#pragma unroll
        for (int i = 0; i < TM; ++i) { const long ro = (long)(m0 + EPI_M(TM, i)) * 1024 + n0;
            EPI_JQ { const long o = ro + EPI_NB(j, q); const u4 xi = gld16(xin + o); u4 xo;
                xo.x = __float_as_uint(__uint_as_float(xi.x) + acc[i][j][4 * q]); xo.y = __float_as_uint(__uint_as_float(xi.y) + acc[i][j][4 * q + 1]);
                xo.z = __float_as_uint(__uint_as_float(xi.z) + acc[i][j][4 * q + 2]); xo.w = __float_as_uint(__uint_as_float(xi.w) + acc[i][j][4 * q + 3]); gst16(xout + o, xo); }
            __builtin_amdgcn_sched_barrier(0); }
    }
};
struct GemmMoe1 {
    const bf16_t* xb; const int* list; const bf16_t* Bt; const float* rstd; const float* wslot; bf16_t* abuf;
    DEV const bf16_t* a_row(int r) const { const int e = *(const GAS int*)(list + r); return xb + (long)(e >> 1) * 1024; }
    DEV long a_kstride() const { return 64; }
    DEV const bf16_t* b_base(int kt) const { return Bt + kt * 64; }
    DEV long ldb() const { return 1024; }
    DEV int nk() const { return 16; }
    template <int TM> struct Pre { int ee[TM]; float rsv[TM], cwv[TM]; };
    template <int TM> DEV void pre1(Pre<TM>& pr, int m0, int n0, int mrows, int wm, int wn, int lane) const {
        if constexpr (TM <= 2) {
#pragma unroll
        for (int i = 0; i < TM; ++i) { const int lr = EPI_M(TM, i); pr.ee[i] = *(const GAS int*)(list + m0 + (lr < mrows ? lr : 0)); } } }
    template <int TM> DEV void pre2(Pre<TM>& pr, int m0, int n0, int mrows, int wm, int wn, int lane) const {
        if constexpr (TM <= 2) {
#pragma unroll
        for (int i = 0; i < TM; ++i) { pr.rsv[i] = gldf(rstd + (pr.ee[i] >> 1)); pr.cwv[i] = gldf(wslot + pr.ee[i]); } } }
    template <int TM> DEV void epi(f32x16 (&acc)[TM][2], int m0, int n0, int mrows, int wm, int wn, int lane, const Pre<TM>& pr0) const {
        const int hid0 = 32 * ((n0 >> 6) + wn) + 4 * (lane >> 5);
        Pre<TM> pr = pr0;
        if constexpr (TM > 2) {
#pragma unroll
            for (int i = 0; i < TM; ++i) { const int lr = EPI_M(TM, i); pr.ee[i] = *(const GAS int*)(list + m0 + (lr < mrows ? lr : 0)); }
#pragma unroll
            for (int i = 0; i < TM; ++i) { pr.rsv[i] = gldf(rstd + (pr.ee[i] >> 1)); pr.cwv[i] = gldf(wslot + pr.ee[i]); } }
#pragma unroll
        for (int i = 0; i < TM; ++i) { const int lr = EPI_M(TM, i);
            if (lr < mrows) { const int e = pr.ee[i]; const float rs = pr.rsv[i], cw = pr.cwv[i]; bf16_t* ar = abuf + (long)e * 256 + hid0;
                u2 pk[4];
#pragma unroll
                for (int q = 0; q < 4; ++q) { float o[4];
#pragma unroll
                    for (int k = 0; k < 4; ++k) { const float g = acc[i][0][4 * q + k] * rs, u = acc[i][1][4 * q + k] * rs; o[k] = g * frcp(1.f + fexp2(-g * LOG2E)) * u * cw; }
                    pk[q] = pack4(o[0], o[1], o[2], o[3]); }
                gst16(ar + 4 * (lane >> 5), pair_swap(pk[0], pk[1])); gst16(ar + 16 + 4 * (lane >> 5), pair_swap(pk[2], pk[3])); } }
    }
};
struct GemmMoe2 {
    const bf16_t* abuf; const int* list; const bf16_t* B0; const bf16_t* B1; bf16_t* xb; float* xout; float* ssq_out;
    DEV const bf16_t* a_row(int r) const { return abuf + (long)(*(const GAS int*)(list + r)) * 512; }
    DEV long a_kstride() const { return 64; }
    DEV const bf16_t* b_base(int kt) const { return kt < 4 ? B0 + kt * 64 : B1 + (kt - 4) * 64; }
    DEV long ldb() const { return 256; }
    DEV int nk() const { return 8; }
    template <int TM> struct Pre { int tok[TM]; u4 xw[TM][2][2]; };
    template <int TM> DEV void pre1(Pre<TM>& pr, int m0, int n0, int mrows, int wm, int wn, int lane) const {
#pragma unroll
        for (int i = 0; i < TM; ++i) { const int lr = EPI_M(TM, i); pr.tok[i] = *(const GAS int*)(list + m0 + (lr < mrows ? lr : 0)); } }
    template <int TM> DEV void pre2(Pre<TM>& pr, int m0, int n0, int mrows, int wm, int wn, int lane) const {
#pragma unroll
        for (int i = 0; i < TM; ++i) { const long ro = (long)pr.tok[i] * 1024 + n0;
#pragma unroll
            for (int j = 0; j < 2; ++j)
#pragma unroll
                for (int qp = 0; qp < 2; ++qp) pr.xw[i][j][qp] = gld16(xb + ro + wn * 64 + j * 32 + 16 * qp + 8 * (lane >> 5)); } }
    template <int TM> DEV void epi(f32x16 (&acc)[TM][2], int m0, int n0, int mrows, int wm, int wn, int lane, const Pre<TM>& pr) const {
#pragma unroll
        for (int i = 0; i < TM; ++i) { const int lr = EPI_M(TM, i); const bool ok = lr < mrows; float ss = 0.f;
            if (ok) { const long ro = (long)pr.tok[i] * 1024 + n0;
#pragma unroll
                for (int j = 0; j < 2; ++j)
#pragma unroll
                    for (int qp = 0; qp < 2; ++qp) {
                        u2 rr[2]; pair_unswap(pr.xw[i][j][qp], rr[0], rr[1]); u2 pk[2];
#pragma unroll
                        for (int h = 0; h < 2; ++h) { const int q = 2 * qp + h; const u2 r = rr[h];
                            const float y0 = __uint_as_float(r.x << 16) + acc[i][j][4 * q], y1 = __uint_as_float(r.x & 0xffff0000u) + acc[i][j][4 * q + 1], y2 = __uint_as_float(r.y << 16) + acc[i][j][4 * q + 2], y3 = __uint_as_float(r.y & 0xffff0000u) + acc[i][j][4 * q + 3];
                            if (xout) { u4 xo; xo.x = __float_as_uint(y0); xo.y = __float_as_uint(y1); xo.z = __float_as_uint(y2); xo.w = __float_as_uint(y3); gst16(xout + ro + EPI_NB(j, q), xo); }
                            else { pk[h] = pack4(y0, y1, y2, y3); ss += y0 * y0 + y1 * y1 + y2 * y2 + y3 * y3; } }
                        if (!xout) gst16(xb + ro + wn * 64 + j * 32 + 16 * qp + 8 * (lane >> 5), pair_swap(pk[0], pk[1])); } }
            if (!xout) { ss = hsum(ss); if (lane < 32) LDS_F(LDS_EPI + (lr * 4 + wn) * 4) = ok ? ss : 0.f; } }
        if (!xout) {
            __syncthreads();
            const int t = threadIdx.x;
            if (t < 32 * TM * 2 && t < mrows) { const u4 pv = LDS_U4(LDS_EPI + t * 16); const int tok = *(const GAS int*)(list + m0 + t);
                *(GAS float*)(ssq_out + (long)(n0 >> 8) * T_ + tok) = (__uint_as_float(pv.x) + __uint_as_float(pv.y)) + (__uint_as_float(pv.z) + __uint_as_float(pv.w)); }
            __syncthreads();
        }
    }
};

namespace pg8 {
#define PG8_LAS __attribute__((address_space(3)))
typedef unsigned short bf16_t;
typedef short bf16x8 __attribute__((ext_vector_type(8)));
typedef float f32x4 __attribute__((ext_vector_type(4)));
typedef unsigned u32x4 __attribute__((ext_vector_type(4)));
constexpr int BM = 256, BK = 64, HALF = 128, HTB = HALF * BK * 2  , STAGE_BYTES = 8 * HTB, NXCD = 8, WGM = 8;

__host__ __device__ __forceinline__ int lds_byte(int r, int c) { const int st = (r >> 4) * 2 + (c >> 5), rr = r & 15, cc = c & 31, ob = rr * 64 + cc * 2; return st * 1024 + (ob ^ (((ob >> 9) & 1) << 5)); }
__host__ __device__ __forceinline__ void stage_rc(int b, int& R, int& C) { const int st = b / 1024, sb = b % 1024, swz = sb ^ (((sb >> 9) & 1) << 5); R = (st >> 1) * 16 + swz / 64; C = (st & 1) * 32 + (swz % 64) / 2; }
__host__ __device__ __forceinline__ int perm32(int rho) { const int n = rho >> 4, i = rho & 15; return 8 * (i >> 2) + 4 * n + (i & 3); }

struct Unit { int pm, pn; };
struct Gemm { const bf16_t* A; const bf16_t* Bt; int M, N, K; };

struct StaticOrder {
    int nM, nN, nwg, G, c;
    __host__ __device__ void init(int M, int N, int G_, int c_) { nM = M / BM; nN = N / BM; nwg = nM * nN; G = G_; c = c_; }
    __host__ __device__ bool next(int i, Unit& u) const {
        const long L = (long)i * G + c; if (L >= nwg) return false;
        int wgid = (int)L; { const int q = nwg / NXCD, r = nwg % NXCD, xcd = wgid % NXCD, off = wgid / NXCD; wgid = (xcd < r ? xcd * (q + 1) : r * (q + 1) + (xcd - r) * q) + off; }
        const int nig = WGM * nN, gid = wgid / nig, fm = gid * WGM, gsz = (nM - fm) < WGM ? (nM - fm) : WGM;
        u.pm = fm + ((wgid % nig) % gsz); u.pn = (wgid % nig) / gsz; return true;
    }
    __device__ __forceinline__ void a_ready(const Unit&) const {}
    __device__ __forceinline__ void done(const Unit&) const {}
};
__device__ __forceinline__ unsigned cvt_pk_bf16(float lo, float hi) { unsigned r; asm volatile("v_cvt_pk_bf16_f32 %0, %1, %2" : "=v"(r) : "v"(lo), "v"(hi)); return r; }

struct EpiProj {
    static constexpr bool PERM = true, AFTER_DRAIN = false;
    bf16_t* O; int ldc; int ncols; const float* ssq; int nparts; int T;
    __device__ __forceinline__ void operator()(const f32x4 (&acc)[2][2][4][2], const Unit& u, int wr, int wc, int fr, int fq) const {
        const int row0 = u.pm * BM + wr * 64 + fr, col0 = u.pn * BM + wc * 32 + 8 * fq;
        float rs[2][4];
#pragma unroll
        for (int ai = 0; ai < 2; ++ai)
#pragma unroll
            for (int m = 0; m < 4; ++m) { const int row = row0 + ai * HALF + m * 16; float sq = ssq[row]; if (nparts == 4) sq = ((sq + ssq[T + row]) + ssq[2 * T + row]) + ssq[3 * T + row]; rs[ai][m] = sq; }
#pragma unroll
        for (int ai = 0; ai < 2; ++ai)
#pragma unroll
            for (int m = 0; m < 4; ++m) rs[ai][m] = __builtin_amdgcn_rsqf(rs[ai][m] * (1.f / 1024.f) + 1e-6f);
#pragma unroll
        for (int bj = 0; bj < 2; ++bj) {
            if (u.pn * BM + bj * HALF >= ncols) continue;
#pragma unroll
            for (int ai = 0; ai < 2; ++ai)
#pragma unroll
                for (int m = 0; m < 4; ++m) { bf16_t* rowp = O + (size_t)(row0 + ai * HALF + m * 16) * ldc + col0 + bj * HALF; const f32x4 v0 = acc[ai][bj][m][0] * rs[ai][m], v1 = acc[ai][bj][m][1] * rs[ai][m];
                    u32x4 w; w.x = cvt_pk_bf16(v0[0], v0[1]); w.y = cvt_pk_bf16(v0[2], v0[3]); w.z = cvt_pk_bf16(v1[0], v1[1]); w.w = cvt_pk_bf16(v1[2], v1[3]); *(u32x4*)rowp = w; }
        }
    }
};
struct EpiResid {
    static constexpr bool PERM = true, AFTER_DRAIN = false;
    bf16_t* xb; int ldc;
    __device__ __forceinline__ void operator()(const f32x4 (&acc)[2][2][4][2], const Unit& u, int wr, int wc, int fr, int fq) const {
        const int row0 = u.pm * BM + wr * 64 + fr, col0 = u.pn * BM + wc * 32 + 8 * fq;
        u4 xr[2][4][2];
#pragma unroll
        for (int ai = 0; ai < 2; ++ai)
#pragma unroll
            for (int m = 0; m < 4; ++m) { const size_t ro = (size_t)(row0 + ai * HALF + m * 16) * ldc + col0;
#pragma unroll
                for (int bj = 0; bj < 2; ++bj) xr[ai][m][bj] = gld16(xb + ro + bj * HALF); }
#pragma unroll
        for (int ai = 0; ai < 2; ++ai)
#pragma unroll
            for (int m = 0; m < 4; ++m) { const size_t ro = (size_t)(row0 + ai * HALF + m * 16) * ldc + col0;
#pragma unroll
                for (int bj = 0; bj < 2; ++bj) { const u4 r = xr[ai][m][bj]; const f32x4 a0 = acc[ai][bj][m][0], a1 = acc[ai][bj][m][1]; u4 w;
                    w.x = cvt_pk_bf16(__uint_as_float(r.x << 16) + a0[0], __uint_as_float(r.x & 0xffff0000u) + a0[1]); w.y = cvt_pk_bf16(__uint_as_float(r.y << 16) + a0[2], __uint_as_float(r.y & 0xffff0000u) + a0[3]);
                    w.z = cvt_pk_bf16(__uint_as_float(r.z << 16) + a1[0], __uint_as_float(r.z & 0xffff0000u) + a1[1]); w.w = cvt_pk_bf16(__uint_as_float(r.w << 16) + a1[2], __uint_as_float(r.w & 0xffff0000u) + a1[3]);
                    gst16(xb + ro + bj * HALF, w); } }
    }
};

template <class Epi, class Sched, bool ALIGN_EPI = false, bool SP2 = false>
__device__ __forceinline__ void gemm_phase(PG8_LAS unsigned char* lds, const Gemm g, const Sched& S, const Epi& E) {
    const int tid = threadIdx.x, wid = __builtin_amdgcn_readfirstlane(tid >> 6), lane = tid & 63, wr = wid >> 2, wc = wid & 3, fr = lane & 15, fq = lane >> 4;
    const int K = g.K, nt = K / BK;
    unsigned voffA[2], voffB[2];
#pragma unroll
    for (int i = 0; i < 2; ++i) { int R, C; stage_rc(tid * 16 + i * 8192, R, C); const int Rb = Epi::PERM ? ((R & ~31) + perm32(R & 31)) : R;
        voffA[i] = (unsigned)(R * K + C) * 2u; voffB[i] = (unsigned)(Rb * K + C) * 2u; }
    const size_t kstep = (size_t)(BK * 2);
    const size_t hstep = (size_t)HALF * K * 2;
    const size_t tstep = 2 * hstep;
    const unsigned ldsw = (unsigned)wid * 1024u;
    const int aoff = lds_byte(wr * 64 + fr, fq * 8), boff = lds_byte(wc * 32 + fr, fq * 8);
#define PG8_SA(b, h) (((b) * 2 + (h)) * HTB)
#define PG8_SB(b, h) ((4 + (b) * 2 + (h)) * HTB)
#define PG8_STAGE(bufoff, gbase, voff) do { _Pragma("unroll") for (int _i = 0; _i < 2; ++_i) \
        __builtin_amdgcn_global_load_lds((const unsigned*)((const char*)(gbase) + (voff)[_i]), (PG8_LAS unsigned*)(lds + (bufoff) + ldsw + _i * 8192), 16, 0, 0); } while (0)
#define PG8_LDA(dst, b, h) do { _Pragma("unroll") for (int m = 0; m < 4; ++m) _Pragma("unroll") for (int k = 0; k < 2; ++k) dst[m][k] = *(const PG8_LAS bf16x8*)(lds + PG8_SA(b, h) + aoff + m * 2048 + k * 1024); } while (0)
#define PG8_LDB(dst, b, h) do { _Pragma("unroll") for (int n = 0; n < 2; ++n) _Pragma("unroll") for (int k = 0; k < 2; ++k) dst[n][k] = *(const PG8_LAS bf16x8*)(lds + PG8_SB(b, h) + boff + n * 2048 + k * 1024); } while (0)
#define PG8_MMA(ai, bj, At, Bt) do { __builtin_amdgcn_s_setprio(1); _Pragma("unroll") for (int m = 0; m < 4; ++m) _Pragma("unroll") for (int n = 0; n < 2; ++n) _Pragma("unroll") for (int k = 0; k < 2; ++k) \
        acc[ai][bj][m][n] = __builtin_amdgcn_mfma_f32_16x16x32_bf16(Bt[n][k], At[m][k], acc[ai][bj][m][n], 0, 0, 0); __builtin_amdgcn_s_setprio(0); } while (0)
#define PG8_WAIT_V(n) asm volatile("s_waitcnt vmcnt(" #n ")" ::: "memory")
#define PG8_WAIT_L(n) asm volatile("s_waitcnt lgkmcnt(" #n ")" ::: "memory")
#define PG8_BAR __builtin_amdgcn_s_barrier()
#define PG8_SCHED __builtin_amdgcn_sched_barrier(0)
    Unit cur, nxt; int ui = 0;
    if (!S.next(0, cur)) return;
    f32x4 acc[2][2][4][2];
#pragma unroll
    for (int a = 0; a < 2; ++a)
#pragma unroll
        for (int b = 0; b < 2; ++b)
#pragma unroll
            for (int m = 0; m < 4; ++m)
#pragma unroll
                for (int n = 0; n < 2; ++n) acc[a][b][m][n] = (f32x4){0.f, 0.f, 0.f, 0.f};
    bf16x8 At[4][2], B0[2][2], B1[2][2];
    const char* cA = (const char*)g.A + (size_t)cur.pm * tstep; const char* cB = (const char*)g.Bt + (size_t)cur.pn * tstep;
    S.a_ready(cur);
    if constexpr (SP2) {
        PG8_STAGE(PG8_SB(0, 0), cB, voffB); PG8_STAGE(PG8_SB(0, 1), cB + hstep, voffB); PG8_STAGE(PG8_SA(0, 0), cA, voffA); PG8_STAGE(PG8_SA(0, 1), cA + hstep, voffA);
        if (wr == 1) PG8_BAR;
        PG8_WAIT_V(2); PG8_BAR;
        PG8_STAGE(PG8_SB(1, 0), cB + kstep, voffB); PG8_STAGE(PG8_SA(1, 0), cA + kstep, voffA); PG8_STAGE(PG8_SB(1, 1), cB + hstep + kstep, voffB);
        PG8_WAIT_V(6); PG8_BAR;
    } else {
        PG8_STAGE(PG8_SB(0, 0), cB, voffB); PG8_STAGE(PG8_SA(0, 0), cA, voffA); PG8_STAGE(PG8_SB(0, 1), cB + hstep, voffB); PG8_STAGE(PG8_SA(0, 1), cA + hstep, voffA);
        if (wr == 1) PG8_BAR;
        PG8_WAIT_V(4); PG8_BAR;
        PG8_STAGE(PG8_SB(1, 0), cB + kstep, voffB); PG8_STAGE(PG8_SA(1, 0), cA + kstep, voffA); PG8_STAGE(PG8_SB(1, 1), cB + hstep + kstep, voffB);
        PG8_WAIT_V(6); PG8_BAR;
    }
    for (;;) {
        const bool has_next = S.next(ui + 1, nxt);
        const char* nA = has_next ? (const char*)g.A + (size_t)nxt.pm * tstep : cA; const char* nB = has_next ? (const char*)g.Bt + (size_t)nxt.pn * tstep : cB;
        for (int t = 0; t < nt; t += 2) {
            const bool last = (t == nt - 2);
            const char* a1 = cA + (size_t)(t + 1) * kstep;
            const char* a2 = last ? nA : cA + (size_t)(t + 2) * kstep; const char* b2 = last ? nB : cB + (size_t)(t + 2) * kstep;
            const char* a3 = a2 + kstep; const char* b3 = b2 + kstep;
            if (last && has_next) S.a_ready(nxt);
            if constexpr (SP2) {
            PG8_LDB(B0, 0, 0); PG8_LDB(B1, 0, 1); PG8_SCHED; PG8_LDA(At, 0, 0); PG8_STAGE(PG8_SA(1, 1), a1 + hstep, voffA);
            PG8_WAIT_V(8); PG8_WAIT_L(0); PG8_BAR; PG8_MMA(0, 0, At, B0); PG8_MMA(0, 1, At, B1); PG8_BAR; PG8_SCHED;
            PG8_LDA(At, 0, 1); PG8_STAGE(PG8_SB(0, 0), b2, voffB); PG8_STAGE(PG8_SB(0, 1), b2 + hstep, voffB); PG8_STAGE(PG8_SA(0, 0), a2, voffA);
            PG8_WAIT_V(8); PG8_WAIT_L(0); PG8_BAR; PG8_MMA(1, 0, At, B0); PG8_MMA(1, 1, At, B1); PG8_BAR; PG8_SCHED;
            PG8_LDB(B0, 1, 0); PG8_LDB(B1, 1, 1); PG8_SCHED; PG8_LDA(At, 1, 0); PG8_STAGE(PG8_SA(0, 1), a2 + hstep, voffA);
            PG8_WAIT_V(8); PG8_WAIT_L(0); PG8_BAR; PG8_MMA(0, 0, At, B0); PG8_MMA(0, 1, At, B1); PG8_BAR; PG8_SCHED;
            PG8_LDA(At, 1, 1); PG8_STAGE(PG8_SB(1, 0), b3, voffB); PG8_STAGE(PG8_SB(1, 1), b3 + hstep, voffB); PG8_STAGE(PG8_SA(1, 0), a3, voffA);
            PG8_WAIT_V(8); PG8_WAIT_L(0); PG8_BAR; PG8_MMA(1, 0, At, B0); PG8_MMA(1, 1, At, B1); PG8_BAR; PG8_SCHED;
            } else {
            PG8_LDB(B0, 0, 0); PG8_SCHED; PG8_LDA(At, 0, 0); PG8_STAGE(PG8_SA(1, 1), a1 + hstep, voffA);
            PG8_WAIT_L(8); PG8_BAR; PG8_WAIT_L(0); PG8_MMA(0, 0, At, B0); PG8_BAR; PG8_SCHED;
            PG8_LDB(B1, 0, 1); PG8_STAGE(PG8_SB(0, 0), b2, voffB);
            PG8_BAR; PG8_WAIT_L(0); PG8_MMA(0, 1, At, B1); PG8_BAR;
            PG8_LDA(At, 0, 1); PG8_STAGE(PG8_SA(0, 0), a2, voffA);
            PG8_BAR; PG8_WAIT_L(0); PG8_MMA(1, 0, At, B0); PG8_BAR; PG8_SCHED;
            PG8_STAGE(PG8_SB(0, 1), b2 + hstep, voffB);
            PG8_WAIT_V(6); PG8_BAR; PG8_MMA(1, 1, At, B1); PG8_BAR;
            PG8_LDB(B0, 1, 0); PG8_SCHED; PG8_LDA(At, 1, 0); PG8_STAGE(PG8_SA(0, 1), a2 + hstep, voffA);
            PG8_WAIT_L(8); PG8_BAR; PG8_WAIT_L(0); PG8_MMA(0, 0, At, B0); PG8_BAR; PG8_SCHED;
            PG8_LDB(B1, 1, 1); PG8_STAGE(PG8_SB(1, 0), b3, voffB);
            PG8_BAR; PG8_WAIT_L(0); PG8_MMA(0, 1, At, B1); PG8_BAR;
            PG8_LDA(At, 1, 1); PG8_STAGE(PG8_SA(1, 0), a3, voffA);
            PG8_BAR; PG8_WAIT_L(0); PG8_MMA(1, 0, At, B0); PG8_BAR; PG8_SCHED;
            PG8_STAGE(PG8_SB(1, 1), b3 + hstep, voffB);
            PG8_WAIT_V(6); PG8_BAR; PG8_MMA(1, 1, At, B1); PG8_BAR;
            }
        }
        if constexpr (ALIGN_EPI) { if (wr == 0) PG8_BAR; }
        if constexpr (!Epi::AFTER_DRAIN) { E(acc, cur, wr, wc, fr, fq); S.done(cur); }
        if (!has_next) break;
#pragma unroll
        for (int a = 0; a < 2; ++a)
#pragma unroll
            for (int b = 0; b < 2; ++b)
#pragma unroll
                for (int m = 0; m < 4; ++m)
#pragma unroll
                    for (int n = 0; n < 2; ++n) acc[a][b][m][n] = (f32x4){0.f, 0.f, 0.f, 0.f};
        cur = nxt; cA = nA; cB = nB; ++ui;
        if constexpr (ALIGN_EPI) { if (wr == 1) PG8_BAR; }
    }
    PG8_WAIT_V(0);
    if constexpr (!ALIGN_EPI) { if (wr == 0) PG8_BAR; }
    PG8_BAR;
    if constexpr (Epi::AFTER_DRAIN) { E.fused(acc, cur, wr, wc, fr, fq, lds, wid, lane); S.done(cur); }
#undef PG8_SA
#undef PG8_SB
#undef PG8_STAGE
#undef PG8_LDA
#undef PG8_LDB
#undef PG8_MMA
#undef PG8_WAIT_V
#undef PG8_WAIT_L
#undef PG8_BAR
#undef PG8_SCHED
}
}
constexpr int AT_K0 = LDS_PH, AT_K1 = LDS_PH + 12288, AT_V0 = LDS_PH + 24576, AT_V1 = AT_V0 + 8192, AT_LUT = AT_V1 + 8192,
              AT_UN = AT_LUT + 8192, AT_ALIVE = AT_UN + 16, AT_ITEM = AT_ALIVE + 16, AT_IMP = AT_ITEM + 16, AT_END = AT_IMP + 8 * 16 * 129 * 4,
              SB_O = AT_IMP, SB_L = SB_O + 256 * 65 * 4, SB_SM = SB_L + 1024, SB_LIST = SB_SM + 2048, SB_CTR = SB_LIST + 1024, SB_VX = SB_CTR + 16, SB_END = SB_VX + 3 * 8192;
constexpr float NEG_INF = -__builtin_inff();
static_assert(AT_END <= LDS_BYTES && SB_END <= LDS_BYTES, "attention LDS map");

template <int DK> DEV void att_gload(u4& k0, u4& k1, u4& v, const bf16_t* kt, const bf16_t* vt, const int tid__) {
    const int tid = tid__;
    k0 = gld16(kt + tid * 8);
    if (DK == 96) { if (tid < 256) k1 = gld16(kt + (512 + tid) * 8); }
    v = gld16(vt + tid * 8);
}
template <int DK> DEV void att_lstore(const u4& k0, const u4& k1, const u4& v, int buf, const int tid__) {
    const int tid = tid__; const unsigned ks = buf ? AT_K1 : AT_K0, vs = buf ? AT_V1 : AT_V0;
    LDS_U4(ks + tid * 16) = k0;
    if (DK == 96) { if (tid < 256) LDS_U4(ks + (512 + tid) * 16) = k1; }
    LDS_U4(vs + tid * 16) = v;
}
template <int DK> DEV void att_dma(const bf16_t* kt, const bf16_t* vt, int buf, const int tid__) {
    const int tid = tid__; const unsigned ks = AT_K0 + buf * 12288, vs = AT_V0 + buf * 8192;
    GLDS16(kt + tid * 8, ks + tid * 16);
    if (DK == 96) { if (tid < 256) GLDS16(kt + (512 + tid) * 8, ks + (512 + tid) * 16); }
    GLDS16(vt + tid * 8, vs + tid * 16);
}
template <int DK> DEV void att_qk(f32x16& s0, f32x16& s1, int buf, const bf16x8 (&qf)[DK / 16], int lane) {
    const unsigned kb = (buf ? AT_K1 : AT_K0) + (lane >> 5) * 1024 + (lane & 31) * 16;
    s0 = f32x16{}; s1 = f32x16{};
#pragma unroll
    for (int d0 = 0; d0 < DK / 16; ++d0) { const bf16x8 a0 = LDS_BF8(kb + d0 * 2048), a1 = LDS_BF8(kb + d0 * 2048 + 512); s0 = MFMA32(a0, qf[d0], s0); s1 = MFMA32(a1, qf[d0], s1); }
}
#define PACK8(p, sp) __builtin_bit_cast(bf16x8, (u4){cvtpk((p)[8 * (sp) + 0], (p)[8 * (sp) + 1]), cvtpk((p)[8 * (sp) + 2], (p)[8 * (sp) + 3]), cvtpk((p)[8 * (sp) + 4], (p)[8 * (sp) + 5]), cvtpk((p)[8 * (sp) + 6], (p)[8 * (sp) + 7])})
DEV bf16x8 att_vfrag(unsigned a) { const s16x4 lo = lds_tr(a), h4 = lds_tr(a + 512); return (bf16x8){lo[0], lo[1], lo[2], lo[3], h4[0], h4[1], h4[2], h4[3]}; }
DEV void att_pv(f32x16& o0, f32x16& o1, int buf, const f32x16& p0, const f32x16& p1, int lane) {
    const unsigned vb = (buf ? AT_V1 : AT_V0) + (4 * (lane >> 5) + ((lane & 15) >> 2)) * 64 + ((lane >> 4) & 1) * 32 + (lane & 3) * 8;
#pragma unroll
    for (int kb = 0; kb < 2; ++kb)
#pragma unroll
        for (int sp = 0; sp < 2; ++sp) {
            const bf16x8 pf = kb ? PACK8(p1, sp) : PACK8(p0, sp); const unsigned a = vb + (32 * kb + 16 * sp) * 64;
            o0 = MFMA32(att_vfrag(a), pf, o0); o1 = MFMA32(att_vfrag(a + 4096), pf, o1);
        }
}
DEV float att_rowmax(const f32x16& p0, const f32x16& p1) {
    float m = __builtin_fmaxf(p0[0], p1[0]);
#pragma unroll
    for (int r = 1; r < 16; ++r) m = __builtin_fmaxf(m, __builtin_fmaxf(p0[r], p1[r]));
    return hmax(m);
}
template <bool BIAS> DEV void att_logits(f32x16& p0, f32x16& p1, int tq, int n0, int kmul, int kadd, int W, float c, int lutoff, bool selbit, int hi) {
#pragma unroll
    for (int r = 0; r < 16; ++r) {
        const int n = n0 + crow(r, hi);
        { const int dist = tq - (kmul * n + kadd); const bool ok = selbit && dist >= 0 && dist < W; float t = p0[r] * c;
          if (BIAS) { const int idx = dist < 0 ? 0 : (dist > 1023 ? 1023 : dist); t += LDS_F(AT_LUT + lutoff + idx * 4); }
          p0[r] = ok ? t : NEG_INF; }
        { const int dist = tq - (kmul * (n + 32) + kadd); const bool ok = selbit && dist >= 0 && dist < W; float t = p1[r] * c;
          if (BIAS) { const int idx = dist < 0 ? 0 : (dist > 1023 ? 1023 : dist); t += LDS_F(AT_LUT + lutoff + idx * 4); }
          p1[r] = ok ? t : NEG_INF; }
    }
}
DEV float att_rowmax_local(const f32x16& p0, const f32x16& p1) {
    float a = __builtin_fmaxf(p0[0], p1[0]), b = __builtin_fmaxf(p0[1], p1[1]);
#pragma unroll
    for (int r = 2; r < 16; r += 2) { a = __builtin_fmaxf(a, __builtin_fmaxf(p0[r], p1[r])); b = __builtin_fmaxf(b, __builtin_fmaxf(p0[r + 1], p1[r + 1])); }
    return __builtin_fmaxf(a, b);
}
typedef float f32x2 __attribute__((ext_vector_type(2)));
#define PAIR(p, k) ((f32x2){(p)[2 * (k)], (p)[2 * (k) + 1]})
#define UNPAIR(p, k, v) do { (p)[2 * (k)] = (v)[0]; (p)[2 * (k) + 1] = (v)[1]; } while (0)
template <bool FAST, bool FIXED = false> DEV void att_softmax(f32x16& p0, f32x16& p1, float& m, float& l, f32x16& o0, f32x16& o1, float c, float off0, bool sb) {
    if constexpr (FIXED) {
        const f32x2 c2 = {c, c}; f32x2 sa = {0.f, 0.f}, sc = {0.f, 0.f};
        if (FAST) { const float off = sb ? off0 - m : NEG_INF; const f32x2 off2 = {off, off};
#pragma unroll
            for (int k = 0; k < 8; ++k) { f32x2 u = PAIR(p0, k) * c2 + off2, v = PAIR(p1, k) * c2 + off2; u[0] = fexp2(u[0]); u[1] = fexp2(u[1]); v[0] = fexp2(v[0]); v[1] = fexp2(v[1]);
                sa += u; sc += v; UNPAIR(p0, k, u); UNPAIR(p1, k, v); }
        } else { const f32x2 mn2 = {m, m};
#pragma unroll
            for (int k = 0; k < 8; ++k) { f32x2 u = PAIR(p0, k) - mn2, v = PAIR(p1, k) - mn2; u[0] = fexp2(u[0]); u[1] = fexp2(u[1]); v[0] = fexp2(v[0]); v[1] = fexp2(v[1]);
                sa += u; sc += v; UNPAIR(p0, k, u); UNPAIR(p1, k, v); }
        }
        sa += sc; l += sa[0] + sa[1];
        return;
    }
    float mx; const f32x2 c2 = {c, c};
    if (FAST) {
        float a, b;
        { const f32x2 t0 = PAIR(p0, 0) * c2, t1 = PAIR(p1, 0) * c2; a = __builtin_fmaxf(t0[0], t0[1]); b = __builtin_fmaxf(t1[0], t1[1]); }
#pragma unroll
        for (int k = 1; k < 8; ++k) { const f32x2 t0 = PAIR(p0, k) * c2, t1 = PAIR(p1, k) * c2; a = __builtin_fmaxf(__builtin_fmaxf(a, t0[0]), t0[1]); b = __builtin_fmaxf(__builtin_fmaxf(b, t1[0]), t1[1]); }
        mx = hmax(__builtin_fmaxf(a, b)); mx = sb ? mx + off0 : NEG_INF;
    } else mx = hmax(att_rowmax_local(p0, p1));
    float mn = __builtin_fmaxf(m, mx);
    if (__any(mx > m + 8.f)) {
    const float al = fexp2(m - mn); l *= al; const f32x2 al2 = {al, al};
#pragma unroll
    for (int k = 0; k < 8; ++k) { const f32x2 x = PAIR(o0, k) * al2, y = PAIR(o1, k) * al2; UNPAIR(o0, k, x); UNPAIR(o1, k, y); }
    m = mn;
    } else mn = m;
    f32x2 sa = {0.f, 0.f}, sc = {0.f, 0.f};
    if (FAST) { const float off = sb ? off0 - mn : NEG_INF; const f32x2 off2 = {off, off};
#pragma unroll
        for (int k = 0; k < 8; ++k) { f32x2 u = PAIR(p0, k) * c2 + off2, v = PAIR(p1, k) * c2 + off2; u[0] = fexp2(u[0]); u[1] = fexp2(u[1]); v[0] = fexp2(v[0]); v[1] = fexp2(v[1]);
            sa += u; sc += v; UNPAIR(p0, k, u); UNPAIR(p1, k, v); }
    } else { const f32x2 mn2 = {mn, mn};
#pragma unroll
        for (int k = 0; k < 8; ++k) { f32x2 u = PAIR(p0, k) - mn2, v = PAIR(p1, k) - mn2; u[0] = fexp2(u[0]); u[1] = fexp2(u[1]); v[0] = fexp2(v[0]); v[1] = fexp2(v[1]);
            sa += u; sc += v; UNPAIR(p0, k, u); UNPAIR(p1, k, v); }
    }
    sa += sc; l += sa[0] + sa[1];
}
DEV int att_next(int j, int thi, bool usemask) {
    if (usemask) { while (j <= thi && !((LDS_U(AT_UN + (j >> 5) * 4) >> (j & 31)) & 1u)) ++j; }
    return j;
}
template <int DK, bool BIAS, bool FAST, bool FIXED = false>
DEV void att_seg(const bf16_t* Kimg, const bf16_t* Vimg, int j0, int j1, int thi, const bf16x8 (&qf)[DK / 16], int tq, int W, float c, int lutoff, float bfar,
                 float& m, float& l, f32x16& o0, f32x16& o1, const int tid__, int& buf, int kmul, int kadd) {
    const int lane = tid__ & 63, hi = lane >> 5;
    for (int j = j0; j <= j1; ++j) {
        if (j < thi) att_dma<DK>(Kimg + (long)(j + 1) * (DK * 64), Vimg + (long)(j + 1) * 4096, buf ^ 1, tid__);
        bool skip = false, wfast = false;
        if (!FAST) { const int wlo = __builtin_amdgcn_readlane(tq, 0), whi = __builtin_amdgcn_readlane(tq, 31);
            const int pmin = kmul * (64 * j) + kadd, pmax = kmul * (64 * j + 63) + kadd;
            skip = pmin > whi || wlo - pmax >= W;
            if (!BIAS) wfast = pmax <= wlo && whi - pmin < W; }
        if (!skip) {
        f32x16 p0, p1;
        att_qk<DK>(p0, p1, buf, qf, lane);
        if (FAST || wfast) att_softmax<true, FIXED>(p0, p1, m, l, o0, o1, c, bfar, true);
        else { int tq_ = tq, hi_ = hi; asm volatile("" : "+v"(tq_), "+v"(hi_));
               att_logits<BIAS>(p0, p1, tq_, 64 * j, kmul, kadd, W, c, lutoff, true, hi_); att_softmax<false, FIXED>(p0, p1, m, l, o0, o1, c, 0.f, true); }
        att_pv(o0, o1, buf, p0, p1, lane);
        }
        __syncthreads();
        buf ^= 1;
    }
}
template <int DK, bool BIAS, bool SEL, bool FASTB = false, bool FIXED = false>
DEV void att_run(const bf16_t* Kimg, const bf16_t* Vimg, int tlo, int thi, const bf16x8 (&qf)[DK / 16], int tq, int W, float c, int lutoff,
                 const unsigned (&sw)[4], float& m, float& l, f32x16& o0, f32x16& o1, const int tid__, int q0, int qspan, int kmul = 1, int kadd = 0) {
    static_assert(!SEL, "mask-driven tile walks are handled by the compacted selected branch");
    if (tlo > thi) return;
    int buf = 0;
    att_dma<DK>(Kimg + (long)tlo * (DK * 64), Vimg + (long)tlo * 4096, 0, tid__);
    const float bfar = BIAS ? LDS_F(AT_LUT + lutoff + 1023 * 4) : 0.f;
    __syncthreads();
    int jf = tlo - 1;
    if ((!BIAS || FASTB) && W == (1 << 30)) { const int thr = BIAS ? 790 : 0; const int num = q0 - thr - kadd - 63 * kmul;
        if (num >= 0) { jf = num / (64 * kmul); jf = jf > thi ? thi : jf; } }
    if (!BIAS || FASTB) att_seg<DK, BIAS, true, FIXED>(Kimg, Vimg, tlo, jf, thi, qf, tq, W, c, lutoff, bfar, m, l, o0, o1, tid__, buf, kmul, kadd);
    att_seg<DK, BIAS, false, FIXED>(Kimg, Vimg, jf + 1 > tlo ? jf + 1 : tlo, thi, thi, qf, tq, W, c, lutoff, bfar, m, l, o0, o1, tid__, buf, kmul, kadd);
}
DEV void att_store_out(bf16_t* orow, const f32x16& o0, const f32x16& o1, int hi) {
#pragma unroll
    for (int a = 0; a < 4; a += 2) {
        gst16(orow + 8 * a + 8 * hi, pair_swap(pack4(o0[4 * a], o0[4 * a + 1], o0[4 * a + 2], o0[4 * a + 3]), pack4(o0[4 * a + 4], o0[4 * a + 5], o0[4 * a + 6], o0[4 * a + 7])));
        gst16(orow + 32 + 8 * a + 8 * hi, pair_swap(pack4(o1[4 * a], o1[4 * a + 1], o1[4 * a + 2], o1[4 * a + 3]), pack4(o1[4 * a + 4], o1[4 * a + 5], o1[4 * a + 6], o1[4 * a + 7])));
    }
}
template <int NQ> DEV void att_loadq(bf16x8 (&qf)[NQ], const bf16_t* qrow, int hi) {
#pragma unroll
    for (int d0 = 0; d0 < NQ; ++d0) qf[d0] = __builtin_bit_cast(bf16x8, gld16(qrow + d0 * 16 + hi * 8));
}
DEV void att_load_lut(const float* lut2, const int tid__) {
    for (int i = tid__; i < 2048; i += 512) LDS_F(AT_LUT + i * 4) = gldf(lut2 + i);
}

DEV void attn_swa(const int tid__, const Args& a, int l, int b, int hk, int qb) {
    unsigned char* ws = a.ws; const int lane = tid__ & 63, wid = __builtin_amdgcn_readfirstlane(tid__ >> 6), l31 = lane & 31, hi = lane >> 5, g = l31 >> 4;
    const int h = hk * 2 + g, q0 = qb * 128, tq = q0 + 16 * wid + (l31 & 15);
    att_load_lut((const float*)(ws + W_LUT) + (hk * 2) * 1024, tid__);
    bf16x8 qf[4]; att_loadq<4>(qf, (const bf16_t*)(ws + X_QSW) + ((long)(b * 4 + h) * S_ + tq) * 64, hi);
    float m = gldf(a.in[6] + l * 4 + h) * LOG2E, ls = hi ? 0.f : 1.f; f32x16 o0 = f32x16{}, o1 = f32x16{};
    const unsigned sw[4] = {0, 0, 0, 0};
    __syncthreads();
    const int tlo = q0 / 64 - 2 < 0 ? 0 : q0 / 64 - 2;
    att_run<64, true, false>((const bf16_t*)(ws + A_KSW) + (long)(b * 2 + hk) * 128 * 4096, (const bf16_t*)(ws + A_VSW) + (long)(b * 2 + hk) * 128 * 4096,
                             tlo, q0 / 64 + 1, qf, tq, 128, 0.125f * LOG2E, g * 4096, sw, m, ls, o0, o1, tid__, q0, 128);
    const float inv = frcp(hsum(ls));
#pragma unroll
    for (int r = 0; r < 16; ++r) { o0[r] *= inv; o1[r] *= inv; }
    att_store_out((bf16_t*)(ws + P_ORAW) + (long)(b * S_ + tq) * 1024 + 256 + h * 64, o0, o1, hi);
    __syncthreads();
}
DEV void attn_mla(const int tid__, const Args& a, int l, int b, int h, int qb) {
    unsigned char* ws = a.ws; const int lane = tid__ & 63, wid = __builtin_amdgcn_readfirstlane(tid__ >> 6), l31 = lane & 31, hi = lane >> 5;
    const int q0 = qb * 256, tq = q0 + 32 * wid + l31;
    bf16x8 qf[6]; att_loadq<6>(qf, (const bf16_t*)(ws + A_QM) + ((long)(b * 4 + h) * S_ + tq) * 96, hi);
    float m = -1e30f, ls = 0.f; f32x16 o0 = f32x16{}, o1 = f32x16{};
    const unsigned sw[4] = {0, 0, 0, 0};
    const float mb = gldf((const float*)(ws + W_MLAB) + l);
    if (mb <= 60.f) { m = mb;
    att_run<96, false, false, false, true>((const bf16_t*)(ws + A_KM) + (long)(b * 4 + h) * 128 * 6144, (const bf16_t*)(ws + A_VM) + (long)(b * 4 + h) * 128 * 4096,
                              0, q0 / 64 + 3, qf, tq, 1 << 30, 0.10206207261596577f * LOG2E, 0, sw, m, ls, o0, o1, tid__, q0, 256);
    } else
    att_run<96, false, false>((const bf16_t*)(ws + A_KM) + (long)(b * 4 + h) * 128 * 6144, (const bf16_t*)(ws + A_VM) + (long)(b * 4 + h) * 128 * 4096,
                              0, q0 / 64 + 3, qf, tq, 1 << 30, 0.10206207261596577f * LOG2E, 0, sw, m, ls, o0, o1, tid__, q0, 256);
    const float inv = frcp(hsum(ls));
#pragma unroll
    for (int r = 0; r < 16; ++r) { o0[r] *= inv; o1[r] *= inv; }
    att_store_out((bf16_t*)(ws + P_ORAW) + (long)(b * S_ + tq) * 1024 + 768 + h * 64, o0, o1, hi);
}
DEV void attn_sb(const int tid__, const Args& a, int l, int b, int h, int qb) {
    unsigned char* ws = a.ws; const int lane = tid__ & 63, wid = __builtin_amdgcn_readfirstlane(tid__ >> 6), l31 = lane & 31, hi = lane >> 5;
    const int q0 = qb * 256, tq = q0 + 32 * wid + l31;
    bf16x8 qf[4]; att_loadq<4>(qf, (const bf16_t*)(ws + X_QSB) + ((long)(b * 4 + h) * S_ + tq) * 64, hi);
    const bf16_t* Kimg = (const bf16_t*)(ws + X_KSB) + (long)(b * 4 + h) * 128 * 4096; const bf16_t* Vimg = (const bf16_t*)(ws + X_VSB) + (long)(b * 4 + h) * 128 * 4096;
    f32x16 o0 = f32x16{}, o1 = f32x16{}; float carry = 1.f;
    if (tid__ < 3) LDS_I(AT_ALIVE + tid__ * 4) = 0;
    u4 k0, k1, v; int buf = 0, j = q0 / 64 + 3, it = 0;
    att_gload<64>(k0, k1, v, Kimg + (long)j * 4096, Vimg + (long)j * 4096, tid__); att_lstore<64>(k0, k1, v, 0, tid__);
    __syncthreads();
    for (;;) {
        const int jn = j - 1;
        if (jn >= 0) att_gload<64>(k0, k1, v, Kimg + (long)jn * 4096, Vimg + (long)jn * 4096, tid__);
        if (tid__ == 0) LDS_I(AT_ALIVE + ((it + 1) % 3) * 4) = 0;
        const bool skip = 64 * j >= __builtin_amdgcn_readfirstlane(tq - l31) + 31;
        if (!skip) {
        f32x16 p0, p1, g0, g1;
        att_qk<64>(p0, p1, buf, qf, lane);
#pragma unroll
        for (int r = 0; r < 16; ++r) {
            const int key = 64 * j + crow(r, hi);
            { const bool ok = key < tq; const float e = fexp2(__builtin_fminf(p0[r] * (0.125f * LOG2E), 80.f * LOG2E)), rr = frcp(1.f + e); p0[r] = ok ? rr : 1.f; g0[r] = ok ? e * rr : 0.f; }
            { const bool ok = key + 32 < tq; const float e = fexp2(__builtin_fminf(p1[r] * (0.125f * LOG2E), 80.f * LOG2E)), rr = frcp(1.f + e); p1[r] = ok ? rr : 1.f; g1[r] = ok ? e * rr : 0.f; }
        }
        float gp[2][4], go[2][4], sg[2][4];
#pragma unroll
        for (int q = 0; q < 4; ++q) { gp[0][q] = p0[4 * q] * p0[4 * q + 1] * p0[4 * q + 2] * p0[4 * q + 3]; gp[1][q] = p1[4 * q] * p1[4 * q + 1] * p1[4 * q + 2] * p1[4 * q + 3]; }
#pragma unroll
        for (int kb = 0; kb < 2; ++kb)
#pragma unroll
            for (int q = 0; q < 4; ++q) go[kb][q] = hother(gp[kb][q], hi);
        float run = carry;
#pragma unroll
        for (int kb = 1; kb >= 0; --kb)
#pragma unroll
            for (int q = 3; q >= 0; --q) {
                const float gh1 = hi ? gp[kb][q] : go[kb][q], gh0 = hi ? go[kb][q] : gp[kb][q];
                const float s1 = run; run *= gh1; const float s0 = run; run *= gh0; sg[kb][q] = hi ? s1 : s0;
            }
        carry = run;
#pragma unroll
        for (int q = 0; q < 4; ++q) {
            { const float e3 = sg[0][q], e2 = e3 * p0[4 * q + 3], e1 = e2 * p0[4 * q + 2], e0 = e1 * p0[4 * q + 1];
              p0[4 * q] = g0[4 * q] * e0; p0[4 * q + 1] = g0[4 * q + 1] * e1; p0[4 * q + 2] = g0[4 * q + 2] * e2; p0[4 * q + 3] = g0[4 * q + 3] * e3; }
            { const float e3 = sg[1][q], e2 = e3 * p1[4 * q + 3], e1 = e2 * p1[4 * q + 2], e0 = e1 * p1[4 * q + 1];
              p1[4 * q] = g1[4 * q] * e0; p1[4 * q + 1] = g1[4 * q + 1] * e1; p1[4 * q + 2] = g1[4 * q + 2] * e2; p1[4 * q + 3] = g1[4 * q + 3] * e3; }
        }
        att_pv(o0, o1, buf, p0, p1, lane);
        }
        if (__any(carry >= 1e-30f) && lane == 0) LDS_I(AT_ALIVE + (it % 3) * 4) = 1;
        if (jn >= 0) att_lstore<64>(k0, k1, v, buf ^ 1, tid__);
        __syncthreads();
        const int alive = LDS_I(AT_ALIVE + (it % 3) * 4);
        if (jn < 0 || !alive) break;
        j = jn; buf ^= 1; ++it;
    }
    att_store_out((bf16_t*)(ws + P_ORAW) + (long)(b * S_ + tq) * 1024 + h * 64, o0, o1, hi);
    __syncthreads();
}

#define RLX_AGENT __ATOMIC_RELAXED, __HIP_MEMORY_SCOPE_AGENT
DEV void att_store_out_wt(bf16_t* orow, const f32x16& o0, const f32x16& o1, int hi) {
#pragma unroll
    for (int q = 0; q < 4; ++q) {
        const unsigned long long w0 = (unsigned long long)cvtpk(o0[4 * q], o0[4 * q + 1]) | ((unsigned long long)cvtpk(o0[4 * q + 2], o0[4 * q + 3]) << 32);
        const unsigned long long w1 = (unsigned long long)cvtpk(o1[4 * q], o1[4 * q + 1]) | ((unsigned long long)cvtpk(o1[4 * q + 2], o1[4 * q + 3]) << 32);
        __hip_atomic_store((GAS unsigned long long*)(orow + 8 * q + 4 * hi), w0, RLX_AGENT); __hip_atomic_store((GAS unsigned long long*)(orow + 32 + 8 * q + 4 * hi), w1, RLX_AGENT);
    }
}
#ifndef PROBE_NSA
#define PROBE_NSA 0
#endif
DEV void attn_nsa_a(const int tid__, const Args& a, int l, int b, int hk, int qb) {
    unsigned char* ws = a.ws; const int lane = tid__ & 63, wid = __builtin_amdgcn_readfirstlane(tid__ >> 6), l31 = lane & 31, hi = lane >> 5, g = l31 >> 4;
    const int h = hk * 2 + g, q0 = qb * 128, tq = q0 + 16 * wid + (l31 & 15);
    const float c = 0.125f * LOG2E; const int lutoff = g * 4096;
    att_load_lut((const float*)(ws + W_LUT) + (4 + hk * 2) * 1024, tid__);
    if (tid__ < 4) LDS_U(AT_UN + tid__ * 4) = 0u;
    for (int i = lane; i < 16 * 129; i += 64) LDS_F(AT_IMP + wid * (16 * 129 * 4) + i * 4) = 0.f;
    const bf16_t* qrow = (const bf16_t*)(ws + A_QN) + ((long)(b * 4 + h) * S_ + tq) * 64;
    const float* gt = (const float*)(ws + A_GATES) + (long)(b * S_ + tq) * 12 + h;
#define NSA_LOADQ() bf16x8 qf[4]; { const bf16_t* q_ = qrow; asm volatile("" : "+v"(q_)); att_loadq<4>(qf, q_, hi); }
    const int sbase = b * 2 + hk;
    const bf16_t* Kc = (const bf16_t*)(ws + A_KC) + (long)sbase * 8 * 4096; const bf16_t* Vc = (const bf16_t*)(ws + A_VC) + (long)sbase * 8 * 4096;
    __syncthreads();
    const int Tmax = ((q0 + 127 - 31) >> 4) >> 6;
    const unsigned sw[4] = {0u, 0u, 0u, 0u};
    float m = -1e30f, ls = 0.f; u4 kp0;
    const float gate_c = gldf(gt);
    for (int rep_ = 0; rep_ < ((PROBE_NSA & 16) ? 3 : 1); ++rep_)
    {
        m = -1e30f; ls = 0.f;
        f32x16 o0 = f32x16{}, o1 = f32x16{}; NSA_LOADQ();
        att_run<64, true, false, true>(Kc, Vc, 0, Tmax, qf, tq, 1 << 30, c, lutoff, sw, m, ls, o0, o1, tid__, q0, 128, 16, 31);
        kp0 = gld16(Kc + tid__ * 8);
        const float lt0 = hsum(ls); const float sc = lt0 > 0.f ? gate_c * frcp(lt0) : 0.f;
#pragma unroll
        for (int r = 0; r < 16; ++r) { o0[r] *= sc; o1[r] *= sc; }
        att_store_out_wt((bf16_t*)(ws + P_ORAW) + (long)(b * S_ + tq) * 1024 + 512 + h * 64, o0, o1, hi);
    }
    const float lt = hsum(ls); const float mm = lt > 0.f ? m + __builtin_amdgcn_logf(lt) : __builtin_inff();
    {
        const unsigned ib = AT_IMP + wid * (16 * 129 * 4) + (l31 & 15) * (129 * 4); NSA_LOADQ();
        int buf = 0; float carry = 0.f;
        LDS_U4(AT_K0 + tid__ * 16) = kp0;
        __syncthreads();
        for (int T = 0; T <= Tmax; ++T) {
            if (T < Tmax) kp0 = gld16(Kc + (long)(T + 1) * 4096 + tid__ * 8);
            f32x16 p0, p1; att_qk<64>(p0, p1, buf, qf, lane);
            if (q0 - (16 * (64 * T + 63) + 31) >= 790) {
                const float off = LDS_F(AT_LUT + lutoff + 1023 * 4) - mm;
#pragma unroll
                for (int r = 0; r < 16; ++r) { p0[r] = fexp2(__builtin_fmaf(p0[r], c, off)); p1[r] = fexp2(__builtin_fmaf(p1[r], c, off)); }
            } else {
                { int tq_ = tq, hi_ = hi; asm volatile("" : "+v"(tq_), "+v"(hi_)); att_logits<true>(p0, p1, tq_, 64 * T, 16, 31, 1 << 30, c, lutoff, true, hi_); }
#pragma unroll
                for (int r = 0; r < 16; ++r) { p0[r] = fexp2(p0[r] - mm); p1[r] = fexp2(p1[r] - mm); }
            }
            float tprev = carry;
#pragma unroll
            for (int kb = 0; kb < 2; ++kb)
#pragma unroll
                for (int q = 0; q < 4; ++q) {
                    const float e3 = kb ? p1[4 * q + 3] : p0[4 * q + 3];
                    const float sum4 = kb ? (p1[4 * q] + p1[4 * q + 1]) + (p1[4 * q + 2] + e3) : (p0[4 * q] + p0[4 * q + 1]) + (p0[4 * q + 2] + e3);
                    const float tq_ = hother(e3, hi);
                    float e = sum4 + (hi ? tq_ : tprev);
                    e += __shfl_xor(e, 16);
                    if (g == 0) LDS_F(ib + (16 * T + 8 * kb + 2 * q + hi) * 4) = e;
                    tprev = tq_;
                }
            carry = tprev;
            if (T < Tmax) LDS_U4((buf ? AT_K0 : AT_K1) + tid__ * 16) = kp0;
            __syncthreads();
            buf ^= 1;
        }
    }
    for (int rep_ = 0; rep_ < ((PROBE_NSA & 8) ? 3 : 1); ++rep_)
    {
        const int qq = lane & 15, part = lane >> 4; const int tqq = q0 + 16 * wid + qq, cur = tqq >> 6; unsigned kk[32];
        const unsigned ib = AT_IMP + wid * (16 * 129 * 4) + qq * (129 * 4) + part * 128;
#pragma unroll
        for (int i = 0; i < 32; ++i) {
            const float v = LDS_F(ib + i * 4); const int j = 32 * part + i; const bool valid = j <= cur, forced = (j == 0) || (j == cur) || (j == cur - 1);
            kk[i] = !valid ? 0u : (forced ? (0x7fffff00u | (unsigned)(255 - j)) : ((__float_as_uint(v) & 0xffffff00u) | (unsigned)(255 - j)));
        }
        unsigned thr = 0u, ncur = 255u;
        {
            const unsigned cand = 1u << 30; unsigned cnt = 0u;
#pragma unroll
            for (int i = 0; i < 32; ++i) cnt += (kk[i] >= cand) ? 1u : 0u;
            cnt += __shfl_xor(cnt, 16); cnt += __shfl_xor(cnt, 32);
            if (cnt >= 16u) { thr = cand; ncur = cnt; }
        }
#pragma unroll 1
        for (int bit = 28; bit >= 0; bit -= 2) {
            if (__all(ncur == 16u)) break;
            const unsigned c1 = thr | (1u << bit), c2 = thr | (2u << bit), c3 = thr | (3u << bit); unsigned cnt = 0u;
#pragma unroll
            for (int i = 0; i < 32; ++i) cnt += ((kk[i] >= c1) ? 1u : 0u) + ((kk[i] >= c2) ? 0x100u : 0u) + ((kk[i] >= c3) ? 0x10000u : 0u);
            cnt += __shfl_xor(cnt, 16); cnt += __shfl_xor(cnt, 32);
            const unsigned n3 = (cnt >> 16) & 0xffu, n2 = (cnt >> 8) & 0xffu, n1 = cnt & 0xffu;
            if (n3 >= 16u) { thr = c3; ncur = n3; } else if (n2 >= 16u) { thr = c2; ncur = n2; } else if (n1 >= 16u) { thr = c1; ncur = n1; }
        }
        thr = thr < 1u ? 1u : thr;
        unsigned w = 0u;
#pragma unroll
        for (int i = 0; i < 32; ++i) w |= (kk[i] >= thr ? 1u : 0u) << i;
        __hip_atomic_store((GAS unsigned*)((unsigned*)(ws + MS_SELM) + ((long)sbase * 8192 + tqq) * 4 + part), w, RLX_AGENT);
        atomicOr((unsigned*)(smem + AT_UN + part * 4), w);
    }
    __syncthreads();
    if (tid__ < 4) __hip_atomic_store((GAS unsigned*)((unsigned*)(ws + MS_UNM) + (sbase * 64 + qb) * 4 + tid__), LDS_U(AT_UN + tid__ * 4), RLX_AGENT);
    asm volatile("s_waitcnt vmcnt(0)" ::: "memory");
    __syncthreads();
    if (tid__ == 0) __hip_atomic_store((GAS unsigned*)((unsigned*)(ws + WS_CTL) + CW_NSAF + l * 1024 + sbase * 64 + qb), 1u, RLX_AGENT);
    __syncthreads();
}
DEV float sb_bmax(const float* rel_bias, int h) {
    float m = gldf(rel_bias + 4 + h);
#pragma unroll 4
    for (int k = 1; k < 32; ++k) m = __builtin_fmaxf(m, gldf(rel_bias + k * 8 + 4 + h));
    return m;
}
DEV void attn_nsa_b(const int tid__, const Args& a, int l, int b, int hk, int qb) {
    unsigned char* ws = a.ws; const int lane = tid__ & 63, wid = __builtin_amdgcn_readfirstlane(tid__ >> 6), l31 = lane & 31, hi = lane >> 5, g = l31 >> 4;
    const int h = hk * 2 + g, q0 = qb * 128, tq = q0 + 16 * wid + (l31 & 15);
    const float c = 0.125f * LOG2E; const int lutoff = g * 4096; const int sbase = b * 2 + hk;
    att_load_lut((const float*)(ws + W_LUT) + (4 + hk * 2) * 1024, tid__);
    if (tid__ == 0) { GAS unsigned* f = (GAS unsigned*)((unsigned*)(ws + WS_CTL) + CW_NSAF + l * 1024 + sbase * 64 + qb); unsigned sp = 0;
        while (__hip_atomic_load(f, RLX_AGENT) == 0u && ++sp < (1u << 22)) __builtin_amdgcn_s_sleep(2); }
    __syncthreads();
    if (tid__ < 4) LDS_U(AT_UN + tid__ * 4) = __hip_atomic_load((GAS unsigned*)((unsigned*)(ws + MS_UNM) + (sbase * 64 + qb) * 4 + tid__), RLX_AGENT);
    unsigned sw[4];
    { GAS unsigned long long* mp = (GAS unsigned long long*)((unsigned*)(ws + MS_SELM) + ((long)sbase * 8192 + tq) * 4);
      const unsigned long long m0 = __hip_atomic_load(mp, RLX_AGENT), m1 = __hip_atomic_load(mp + 1, RLX_AGENT);
      sw[0] = (unsigned)m0; sw[1] = (unsigned)(m0 >> 32); sw[2] = (unsigned)m1; sw[3] = (unsigned)(m1 >> 32); }
    const bf16_t* qrow = (const bf16_t*)(ws + A_QN) + ((long)(b * 4 + h) * S_ + tq) * 64;
    const float* gt = (const float*)(ws + A_GATES) + (long)(b * S_ + tq) * 12 + h;
    const unsigned stash = AT_IMP + wid * (16 * 129 * 4) + lane * 4;
    __syncthreads();
    for (int rep_ = 0; rep_ < ((PROBE_NSA & 2) ? 2 : 1); ++rep_)
    {
        for (int i = tid__; i < 512; i += 512) LDS_U(SB_SM + i * 4) = __hip_atomic_load((GAS unsigned*)((unsigned*)(ws + MS_SELM) + ((long)sbase * 8192 + q0) * 4 + i), RLX_AGENT);
        for (int i = tid__; i < 256 * 65 + 256; i += 512) LDS_I(SB_O + i * 4) = 0;
        if (tid__ == 0) LDS_I(SB_CTR) = 0;
        float gq = __builtin_fabsf(gldf(a.in[7] + l * 64 + lane)), gk = __builtin_fabsf(gldf(a.in[8] + (l * 3 + 1) * 64 + lane));
#pragma unroll
        for (int mk = 1; mk < 64; mk <<= 1) { gq = __builtin_fmaxf(gq, __shfl_xor(gq, mk)); gk = __builtin_fmaxf(gk, __shfl_xor(gk, mk)); }
        __syncthreads();
        const unsigned vpriv = wid < 5 ? AT_K0 + wid * 8192 : SB_VX + (wid - 5) * 8192;
        const bf16_t* Kimg = (const bf16_t*)(ws + A_KNS) + (long)sbase * 128 * 4096; const bf16_t* Vimg = (const bf16_t*)(ws + A_VNS) + (long)sbase * 128 * 4096;
        const bf16_t* Qb = (const bf16_t*)(ws + A_QN) + ((long)(b * 4 + h) * S_ + q0) * 64 + hi * 8;
        const float mref = (8.0f * gq * gk + 0.01f) * LOG2E + sb_bmax(a.in[1], h) * LOG2E;
        const int jmax = (q0 + 127) >> 6;
        constexpr float SCL_L = 2095000.f;
        const float vmax = __builtin_fmaxf(__uint_as_float(xb_ld((unsigned*)(ws + WS_CTL) + CW_VMAX + l * 16 + sbase)), 1e-20f); const float scl_o = 2095000.f / vmax; const float lscl = __builtin_amdgcn_logf(scl_o);
        for (;;) {
            int ti = 0; if (lane == 0) ti = atomicAdd((int*)(smem + SB_CTR), 1);
            ti = __builtin_amdgcn_readfirstlane(ti);
            if (ti > jmax) break;
            const int j = jmax < 4 ? ti : (ti < 3 ? jmax - ti : (ti == 3 ? 0 : jmax - ti + 1));
            const unsigned wa = LDS_U(SB_SM + (lane * 4 + (j >> 5)) * 4), wb = LDS_U(SB_SM + ((lane + 64) * 4 + (j >> 5)) * 4);
            const unsigned long long ma = __ballot((wa >> (j & 31)) & 1u), mb = __ballot((wb >> (j & 31)) & 1u);
            const int na = __popcll(ma), n = na + __popcll(mb);
            if (n == 0) continue;
            const unsigned long long below = (1ull << lane) - 1ull;
            if ((ma >> lane) & 1ull) *(LAS unsigned char*)((LAS char*)smem + SB_LIST + wid * 128 + __popcll(ma & below)) = (unsigned char)lane;
            if ((mb >> lane) & 1ull) *(LAS unsigned char*)((LAS char*)smem + SB_LIST + wid * 128 + na + __popcll(mb & below)) = (unsigned char)(lane + 64);
            const bf16_t* kt = Kimg + (long)j * 4096 + hi * 512 + l31 * 8; bf16x8 kf[8];
#pragma unroll
            for (int d0 = 0; d0 < 4; ++d0) { kf[2 * d0] = __builtin_bit_cast(bf16x8, gld16(kt + d0 * 1024)); kf[2 * d0 + 1] = __builtin_bit_cast(bf16x8, gld16(kt + d0 * 1024 + 256)); }
            { const bf16_t* vt = Vimg + (long)j * 4096;
#pragma unroll
              for (int i = 0; i < 8; ++i) LDS_U4(vpriv + (lane + 64 * i) * 16) = gld16(vt + (lane + 64 * i) * 8); }
            const bool far = q0 - (64 * j + 63) >= 790; const float bfar = LDS_F(AT_LUT + lutoff + 1023 * 4);
            const int ntask = (n + 15) >> 4;
            bf16x8 qq[4]; int qi = *(LAS unsigned char*)((LAS char*)smem + SB_LIST + wid * 128 + ((l31 & 15) < n ? (l31 & 15) : 0));
#pragma unroll
            for (int d0 = 0; d0 < 4; ++d0) qq[d0] = __builtin_bit_cast(bf16x8, gld16(Qb + (long)qi * 64 + d0 * 16));
            for (int task = 0; task < ntask; ++task) {
                const int idx = 16 * task + (l31 & 15); const bool valid = idx < n;
                const int tqq = q0 + qi, colg = qi * 2 + g;
                const int idn = idx + 16; const int qin = *(LAS unsigned char*)((LAS char*)smem + SB_LIST + wid * 128 + (idn < n ? idn : 0)); bf16x8 qn[4];
#pragma unroll
                for (int d0 = 0; d0 < 4; ++d0) qn[d0] = __builtin_bit_cast(bf16x8, gld16(Qb + (long)qin * 64 + d0 * 16));
                f32x16 p0 = f32x16{}, p1 = f32x16{};
#pragma unroll
                for (int d0 = 0; d0 < 4; ++d0) { p0 = MFMA32(kf[2 * d0], qq[d0], p0); p1 = MFMA32(kf[2 * d0 + 1], qq[d0], p1); }
                float ssum; const float offv = (valid ? lscl : NEG_INF) - mref;
                if (far) {
                    const f32x2 c2 = {c, c}, off2 = {bfar + offv, bfar + offv}; f32x2 sa = {0.f, 0.f}, sc2 = {0.f, 0.f};
#pragma unroll
                    for (int k = 0; k < 8; ++k) { f32x2 u = PAIR(p0, k) * c2 + off2, v = PAIR(p1, k) * c2 + off2; u[0] = fexp2(u[0]); u[1] = fexp2(u[1]); v[0] = fexp2(v[0]); v[1] = fexp2(v[1]);
                        sa += u; sc2 += v; UNPAIR(p0, k, u); UNPAIR(p1, k, v); }
                    sa += sc2; ssum = sa[0] + sa[1];
                } else {
                    ssum = 0.f;
#pragma unroll
                    for (int r = 0; r < 16; ++r) {
                        const int d0_ = tqq - (64 * j + crow(r, hi)), d1_ = d0_ - 32;
                        const float b0 = LDS_F(AT_LUT + lutoff + (d0_ < 0 ? 0 : (d0_ > 1023 ? 1023 : d0_)) * 4), b1 = LDS_F(AT_LUT + lutoff + (d1_ < 0 ? 0 : (d1_ > 1023 ? 1023 : d1_)) * 4);
                        p0[r] = d0_ >= 0 ? fexp2(__builtin_fmaf(p0[r], c, b0 + offv)) : 0.f;
                        p1[r] = d1_ >= 0 ? fexp2(__builtin_fmaf(p1[r], c, b1 + offv)) : 0.f;
                        ssum += p0[r] + p1[r];
                    }
                }
                f32x16 o0 = f32x16{}, o1 = f32x16{};
                {   const unsigned vb = vpriv + (4 * hi + ((lane & 15) >> 2)) * 64 + ((lane >> 4) & 1) * 32 + (lane & 3) * 8;
#pragma unroll
                    for (int kb = 0; kb < 2; ++kb)
#pragma unroll
                        for (int sp = 0; sp < 2; ++sp) { const bf16x8 pf = kb ? PACK8(p1, sp) : PACK8(p0, sp); const unsigned av = vb + (32 * kb + 16 * sp) * 64;
                            o0 = MFMA32(att_vfrag(av), pf, o0); o1 = MFMA32(att_vfrag(av + 4096), pf, o1); } }
                if (valid) {
                    atomicAdd((int*)(smem + SB_L + colg * 4), (int)__builtin_rintf(ssum * vmax));
                    const unsigned ob = SB_O + (colg * 65 + 4 * hi) * 4;
#pragma unroll
                    for (int r = 0; r < 16; ++r) { atomicAdd((int*)(smem + ob + ((r & 3) + 8 * (r >> 2)) * 4), (int)o0[r]); atomicAdd((int*)(smem + ob + (32 + (r & 3) + 8 * (r >> 2)) * 4), (int)o1[r]); }
                }
                qi = qin;
#pragma unroll
                for (int d0 = 0; d0 < 4; ++d0) qq[d0] = qn[d0];
            }
        }
        __syncthreads();
        {
            const int colg = (16 * wid + (l31 & 15)) * 2 + g; const float t2 = (float)LDS_I(SB_L + colg * 4) * (1.f / SCL_L); const float sc = t2 > 0.f ? gldf(gt + 4) * frcp(t2) * frcp(scl_o) : 0.f;
            f32x16 o0, o1; const unsigned ob = SB_O + (colg * 65 + 4 * hi) * 4;
#pragma unroll
            for (int r = 0; r < 16; ++r) { o0[r] = sc * (float)LDS_I(ob + ((r & 3) + 8 * (r >> 2)) * 4); o1[r] = sc * (float)LDS_I(ob + (32 + (r & 3) + 8 * (r >> 2)) * 4); }
            __syncthreads();
#pragma unroll
            for (int r = 0; r < 16; ++r) { LDS_F(stash + r * 256) = o0[r]; LDS_F(stash + 4096 + r * 256) = o1[r]; }
        }
        __syncthreads();
    }
    f32x16 f0, f1;
    for (int rep_ = 0; rep_ < ((PROBE_NSA & 4) ? 2 : 1); ++rep_)
    {
        float mw = -1e30f, l3 = 0.f; f32x16 o0 = f32x16{}, o1 = f32x16{}; NSA_LOADQ();
        const int tlo = q0 / 64 - 8 < 0 ? 0 : q0 / 64 - 8;
        att_run<64, true, false>((const bf16_t*)(ws + A_KNW) + (long)sbase * 128 * 4096, (const bf16_t*)(ws + A_VNW) + (long)sbase * 128 * 4096,
                                 tlo, q0 / 64 + 1, qf, tq, 512, c, lutoff, sw, mw, l3, o0, o1, tid__, q0, 128);
        const float t3 = hsum(l3); const float sc = t3 > 0.f ? gldf(gt + 8) * frcp(t3) : 0.f;
#pragma unroll
        for (int r = 0; r < 16; ++r) { f0[r] = LDS_F(stash + r * 256) + sc * o0[r]; f1[r] = LDS_F(stash + 4096 + r * 256) + sc * o1[r]; }
    }
    bf16_t* orow = (bf16_t*)(ws + P_ORAW) + (long)(b * S_ + tq) * 1024 + 512 + h * 64;
#pragma unroll
    for (int q = 0; q < 4; ++q) {
        const unsigned long long c0 = __hip_atomic_load((GAS unsigned long long*)(orow + 8 * q + 4 * hi), RLX_AGENT), c1 = __hip_atomic_load((GAS unsigned long long*)(orow + 32 + 8 * q + 4 * hi), RLX_AGENT);
        f0[4 * q] += bflo((unsigned)c0); f0[4 * q + 1] += bfhi((unsigned)c0); f0[4 * q + 2] += bflo((unsigned)(c0 >> 32)); f0[4 * q + 3] += bfhi((unsigned)(c0 >> 32));
        f1[4 * q] += bflo((unsigned)c1); f1[4 * q + 1] += bfhi((unsigned)c1); f1[4 * q + 2] += bflo((unsigned)(c1 >> 32)); f1[4 * q + 3] += bfhi((unsigned)(c1 >> 32));
    }
    att_store_out(orow, f0, f1, hi);
    __syncthreads();
}
DEV void unpack8(const u4& u, float (&v)[8]) { v[0] = bflo(u.x); v[1] = bfhi(u.x); v[2] = bflo(u.y); v[3] = bfhi(u.y); v[4] = bflo(u.z); v[5] = bfhi(u.z); v[6] = bflo(u.w); v[7] = bfhi(u.w); }
DEV u4 pack8f(const float (&v)[8]) { u4 o; o.x = cvtpk(v[0], v[1]); o.y = cvtpk(v[2], v[3]); o.z = cvtpk(v[4], v[5]); o.w = cvtpk(v[6], v[7]); return o; }
DEV long kimg_off(int nstream, int s, int chunk, int nchunk) { return ((long)nstream * 128 + (s >> 6)) * (nchunk * 512) + chunk * 512 + (s & 63) * 8; }
DEV long vimg_off(int nstream, int s, int chunk) { return ((long)nstream * 128 + (s >> 6)) * 4096 + (chunk >> 2) * 2048 + (s & 63) * 32 + (chunk & 3) * 8; }
DEV void phase_prep(const Args& a, int l) {
    unsigned char* ws = a.ws; const int lane = threadIdx.x & 63, wv = threadIdx.x >> 6, tj = lane >> 3, ch = lane & 7;
    const bf16_t* proj = (const bf16_t*)(ws + P_PROJ);
    if (threadIdx.x < 64) LDS_U(LDS_PH + threadIdx.x * 4) = 0u;
    __syncthreads();
    int it = -1;
    for (int grp = blockIdx.x * 8 + wv; grp < T_ / 8; grp += gridDim.x * 8) {
        ++it;
        const int t = grp * 8 + tj, b = t >> 13, s = t & 8191; const bf16_t* pr = proj + (long)t * PLD + ch * 8;
        u4 rawall[42];
#pragma unroll
        for (int k = 0; k < 42; ++k) rawall[k] = gld16(pr + k * 64);
#pragma unroll
        for (int h0 = 0; h0 < 36; h0 += 6) {
            u4 raw[6];
#pragma unroll
            for (int k = 0; k < 6; ++k) raw[k] = rawall[h0 + k];
#pragma unroll
            for (int k = 0; k < 6; ++k) {
                const int hd = h0 + k; float v[8]; unpack8(raw[k], v);
                const float* gn = nullptr;
                if (hd >= 12 && hd < 16) gn = a.in[4] + l * 64; else if (hd >= 16 && hd < 18) gn = a.in[5] + l * 64; else if (hd >= 20 && hd < 24) gn = a.in[7] + l * 64;
                else if (hd >= 28 && hd < 30) gn = a.in[8] + (l * 3 + 1) * 64; else if (hd >= 32 && hd < 34) gn = a.in[8] + (l * 3 + 2) * 64;
                u4 o = raw[k];
                if (gn) { float ss = 0.f;
#pragma unroll
                    for (int e = 0; e < 8; ++e) ss += v[e] * v[e];
                    ss += __shfl_xor(ss, 1); ss += __shfl_xor(ss, 2); ss += __shfl_xor(ss, 4);
                    const float rs = __builtin_amdgcn_rsqf(ss * (1.f / 64.f) + EPS); const u4 g0 = gld16(gn + ch * 8), g1 = gld16(gn + ch * 8 + 4);
                    v[0] *= rs * __uint_as_float(g0.x); v[1] *= rs * __uint_as_float(g0.y); v[2] *= rs * __uint_as_float(g0.z); v[3] *= rs * __uint_as_float(g0.w);
                    v[4] *= rs * __uint_as_float(g1.x); v[5] *= rs * __uint_as_float(g1.y); v[6] *= rs * __uint_as_float(g1.z); v[7] *= rs * __uint_as_float(g1.w);
                    o = pack8f(v); }
                if (hd < 4) gst16((bf16_t*)(ws + X_QSB) + ((long)(b * 4 + hd) * S_ + s) * 64 + ch * 8, o);
                else if (hd < 8) gst16((bf16_t*)(ws + X_KSB) + kimg_off(b * 4 + hd - 4, s, ch, 8), o);
                else if (hd < 12) gst16((bf16_t*)(ws + X_VSB) + vimg_off(b * 4 + hd - 8, s, ch), o);
                else if (hd < 16) gst16((bf16_t*)(ws + X_QSW) + ((long)(b * 4 + hd - 12) * S_ + s) * 64 + ch * 8, o);
                else if (hd < 18) gst16((bf16_t*)(ws + A_KSW) + kimg_off(b * 2 + hd - 16, s, ch, 8), o);
                else if (hd < 20) gst16((bf16_t*)(ws + A_VSW) + vimg_off(b * 2 + hd - 18, s, ch), o);
                else if (hd < 24) gst16((bf16_t*)(ws + A_QN) + ((long)(b * 4 + hd - 20) * S_ + s) * 64 + ch * 8, o);
                else if (hd < 28) gst16((bf16_t*)(ws + A_XC) + (long)t * 256 + (hd - 24) * 64 + ch * 8, o);
                else if (hd < 30) gst16((bf16_t*)(ws + A_KNS) + kimg_off(b * 2 + hd - 28, s, ch, 8), o);
                else if (hd < 32) { gst16((bf16_t*)(ws + A_VNS) + vimg_off(b * 2 + hd - 30, s, ch), o);
                    float mx = 0.f;
#pragma unroll
                    for (int e = 0; e < 8; ++e) mx = __builtin_fmaxf(mx, __builtin_fabsf(v[e]));
#pragma unroll
                    for (int mk = 1; mk < 64; mk <<= 1) mx = __builtin_fmaxf(mx, __shfl_xor(mx, mk));
                    if (lane == 0) { const unsigned sl = LDS_PH + (it * 2 + hd - 30) * 8; atomicMax((unsigned*)(smem + sl), __float_as_uint(mx));
                        if (atomicAdd((unsigned*)(smem + sl + 4), 1u) == 7u) atomicMax((unsigned*)(ws + WS_CTL) + CW_VMAX + l * 16 + (grp >> 10) * 2 + hd - 30, atomicMax((unsigned*)(smem + sl), 0u)); } }
                else if (hd < 34) gst16((bf16_t*)(ws + A_KNW) + kimg_off(b * 2 + hd - 32, s, ch, 8), o);
                else gst16((bf16_t*)(ws + A_VNW) + vimg_off(b * 2 + hd - 34, s, ch), o);
            }
        }
        {
            u4 raw[6]; float v[6][8];
#pragma unroll
            for (int k = 0; k < 6; ++k) raw[k] = rawall[36 + k];
            float sq = 0.f, sk = 0.f;
#pragma unroll
            for (int k = 0; k < 6; ++k) { unpack8(raw[k], v[k]);
                if (k < 5) { float ss = 0.f;
#pragma unroll
                    for (int e = 0; e < 8; ++e) ss += v[k][e] * v[k][e];
                    if (k < 3) sq += ss; else sk += ss; } }
            sq += __shfl_xor(sq, 1); sq += __shfl_xor(sq, 2); sq += __shfl_xor(sq, 4); sk += __shfl_xor(sk, 1); sk += __shfl_xor(sk, 2); sk += __shfl_xor(sk, 4);
            const float rq = __builtin_amdgcn_rsqf(sq * (1.f / 192.f) + EPS), rk = __builtin_amdgcn_rsqf(sk * (1.f / 128.f) + EPS);
#pragma unroll
            for (int k = 0; k < 5; ++k) { const float rs = k < 3 ? rq : rk;
#pragma unroll
                for (int e = 0; e < 8; ++e) v[k][e] *= rs;
                if (k < 3) gst16((bf16_t*)(ws + A_CQN) + (long)t * 192 + k * 64 + ch * 8, pack8f(v[k]));
                else gst16((bf16_t*)(ws + A_CKVN) + (long)t * 128 + (k - 3) * 64 + ch * 8, pack8f(v[k])); }
            if (ch < 4) gst16((bf16_t*)(ws + A_KPE) + (long)t * 32 + ch * 8, raw[5]);
            else if (ch < 6) { float* gt = (float*)(ws + A_GATES) + (long)t * 12 + (ch - 4) * 8; const int ne = ch == 4 ? 8 : 4;
#pragma unroll
                for (int e = 0; e < 8; ++e) if (e < ne) *(GAS float*)(gt + e) = frcp(1.f + fexp2(-v[5][e] * LOG2E)); }
        }
    }
}

DEV void phase_mla_fin(const Args& a, int l) {
    unsigned char* ws = a.ws; const int lane = threadIdx.x & 63, wv = threadIdx.x >> 6, tj = lane >> 3, ch = lane & 7;
    const float* qg = a.in[16] + l * 96; const float* kg = a.in[17] + l * 96;
    for (int grp = blockIdx.x * 8 + wv; grp < T_ / 8; grp += gridDim.x * 8) {
        const int t = grp * 8 + tj, b = t >> 13, s = t & 8191;
        u4 rq[6], rkv[8], rpe;
#pragma unroll
        for (int k = 0; k < 6; ++k) rq[k] = gld16((const bf16_t*)(ws + P_QRAW) + (long)t * 384 + k * 64 + ch * 8);
#pragma unroll
        for (int k = 0; k < 8; ++k) rkv[k] = gld16((const bf16_t*)(ws + P_KVRAW) + (long)t * 512 + k * 64 + ch * 8);
        rpe = gld16((const bf16_t*)(ws + A_KPE) + (long)t * 32 + (ch & 3) * 8);
        const float* rp = (const float*)(ws + W_ROPE) + (long)s * 32;
        float cs[8], sn[8];
        { const int i0 = (ch & 1) * 8;
#pragma unroll
          for (int e = 0; e < 8; e += 2) { const u4 cc = gld16(rp + 2 * (i0 + e)); cs[e] = __uint_as_float(cc.x); sn[e] = __uint_as_float(cc.y); cs[e + 1] = __uint_as_float(cc.z); sn[e + 1] = __uint_as_float(cc.w); } }
        const bool x2half = (ch & 2) != 0;
        float vq[6][8], hs[4] = {0.f, 0.f, 0.f, 0.f};
#pragma unroll
        for (int k = 0; k < 6; ++k) { unpack8(rq[k], vq[k]); float ss = 0.f;
#pragma unroll
            for (int e = 0; e < 8; ++e) ss += vq[k][e] * vq[k][e];
            if (k == 0) hs[0] += ss; else if (k == 1) { hs[0] += ch < 4 ? ss : 0.f; hs[1] += ch < 4 ? 0.f : ss; } else if (k == 2) hs[1] += ss;
            else if (k == 3) hs[2] += ss; else if (k == 4) { hs[2] += ch < 4 ? ss : 0.f; hs[3] += ch < 4 ? 0.f : ss; } else hs[3] += ss; }
#pragma unroll
        for (int h = 0; h < 4; ++h) { hs[h] += __shfl_xor(hs[h], 1); hs[h] += __shfl_xor(hs[h], 2); hs[h] += __shfl_xor(hs[h], 4); hs[h] = __builtin_amdgcn_rsqf(hs[h] * (1.f / 96.f) + EPS); }
#pragma unroll
        for (int k = 0; k < 6; ++k) {
            const int piece = 8 * k + ch; const int h = (k == 0) ? 0 : (k == 1 ? (ch < 4 ? 0 : 1) : (k == 2 ? 1 : (k == 3 ? 2 : (k == 4 ? (ch < 4 ? 2 : 3) : 3)))); const int ph = piece - 12 * h;
            const float rs = h == 0 ? hs[0] : (h == 1 ? hs[1] : (h == 2 ? hs[2] : hs[3]));
            float o[8]; { const u4 ga = gld16(qg + ph * 8), gb = gld16(qg + ph * 8 + 4);
                o[0] = vq[k][0] * rs * __uint_as_float(ga.x); o[1] = vq[k][1] * rs * __uint_as_float(ga.y); o[2] = vq[k][2] * rs * __uint_as_float(ga.z); o[3] = vq[k][3] * rs * __uint_as_float(ga.w);
                o[4] = vq[k][4] * rs * __uint_as_float(gb.x); o[5] = vq[k][5] * rs * __uint_as_float(gb.y); o[6] = vq[k][6] * rs * __uint_as_float(gb.z); o[7] = vq[k][7] * rs * __uint_as_float(gb.w); }
            const bool rope_reg = (k == 1 || k == 2 || k == 4 || k == 5);
            if (rope_reg) { const bool is_rope = ph >= 8;
#pragma unroll
                for (int e = 0; e < 8; ++e) { const float other = __shfl_xor(o[e], 2); const float r1 = x2half ? other : o[e], r2 = x2half ? o[e] : other;
                    const float res = x2half ? (r1 * sn[e] + r2 * cs[e]) : (r1 * cs[e] - r2 * sn[e]); o[e] = is_rope ? res : o[e]; } }
            gst16((bf16_t*)(ws + A_QM) + ((long)(b * 4 + h) * S_ + s) * 96 + ph * 8, pack8f(o));
        }
        float vpe[8]; unpack8(rpe, vpe); float spe = 0.f;
#pragma unroll
        for (int e = 0; e < 8; ++e) spe += vpe[e] * vpe[e];
        spe = ch < 4 ? spe : 0.f; spe += __shfl_xor(spe, 1); spe += __shfl_xor(spe, 2); spe += __shfl_xor(spe, 4);
        float gkn[8], gkr[8];
        { const u4 a0 = gld16(kg + ch * 8), a1 = gld16(kg + ch * 8 + 4), b0 = gld16(kg + 64 + (ch & 3) * 8), b1 = gld16(kg + 64 + (ch & 3) * 8 + 4);
          gkn[0] = __uint_as_float(a0.x); gkn[1] = __uint_as_float(a0.y); gkn[2] = __uint_as_float(a0.z); gkn[3] = __uint_as_float(a0.w); gkn[4] = __uint_as_float(a1.x); gkn[5] = __uint_as_float(a1.y); gkn[6] = __uint_as_float(a1.z); gkn[7] = __uint_as_float(a1.w);
          gkr[0] = __uint_as_float(b0.x); gkr[1] = __uint_as_float(b0.y); gkr[2] = __uint_as_float(b0.z); gkr[3] = __uint_as_float(b0.w); gkr[4] = __uint_as_float(b1.x); gkr[5] = __uint_as_float(b1.y); gkr[6] = __uint_as_float(b1.z); gkr[7] = __uint_as_float(b1.w); }
#pragma unroll
        for (int h = 0; h < 4; ++h) {
            float vk[8]; unpack8(rkv[2 * h], vk); float ss = 0.f;
#pragma unroll
            for (int e = 0; e < 8; ++e) ss += vk[e] * vk[e];
            ss += __shfl_xor(ss, 1); ss += __shfl_xor(ss, 2); ss += __shfl_xor(ss, 4);
            const float rk = __builtin_amdgcn_rsqf((ss + spe) * (1.f / 96.f) + EPS);
            float o[8];
#pragma unroll
            for (int e = 0; e < 8; ++e) o[e] = vk[e] * rk * gkn[e];
            gst16((bf16_t*)(ws + A_KM) + kimg_off(b * 4 + h, s, ch, 12), pack8f(o));
            float pe[8];
#pragma unroll
            for (int e = 0; e < 8; ++e) pe[e] = vpe[e] * rk * gkr[e];
#pragma unroll
            for (int e = 0; e < 8; ++e) { const float other = __shfl_xor(pe[e], 2); const float r1 = x2half ? other : pe[e], r2 = x2half ? pe[e] : other;
                pe[e] = x2half ? (r1 * sn[e] + r2 * cs[e]) : (r1 * cs[e] - r2 * sn[e]); }
            if (ch < 4) gst16((bf16_t*)(ws + A_KM) + kimg_off(b * 4 + h, s, 8 + ch, 12), pack8f(pe));
            gst16((bf16_t*)(ws + A_VM) + vimg_off(b * 4 + h, s, ch), rkv[2 * h + 1]);
        }
    }
}

DEV void phase_combine(const Args& a) {
    const int lane = threadIdx.x & 63, wv = threadIdx.x >> 6; bf16_t* oraw = (bf16_t*)(a.ws + P_ORAW);
    for (int t = blockIdx.x * 8 + wv; t < T_; t += gridDim.x * 8) {
        bf16_t* p = oraw + (long)t * 1024 + lane * 16;
        float v0[8], v1[8]; unpack8(gld16(p), v0); unpack8(gld16(p + 8), v1);
        float ss = 0.f;
#pragma unroll
        for (int e = 0; e < 8; ++e) ss += v0[e] * v0[e] + v1[e] * v1[e];
        ss += __shfl_xor(ss, 1); ss += __shfl_xor(ss, 2); ss += __shfl_xor(ss, 4); ss += __shfl_xor(ss, 8);
        const float rs = __builtin_amdgcn_rsqf(ss * (1.f / 256.f) + EPS);
#pragma unroll
        for (int e = 0; e < 8; ++e) { v0[e] *= rs; v1[e] *= rs; }
        gst16(p, pack8f(v0)); gst16(p + 8, pack8f(v1));
    }
}

DEV int pair_index(int lo, int hi) { return 7 * lo - (lo * (lo - 1)) / 2 + (hi - lo - 1); }
DEV void phase_router(const Args& a, int l, bool dry = false) {
    unsigned char* ws = a.ws; const int lane = threadIdx.x & 63, wv = threadIdx.x >> 6, r16 = lane & 15, q4 = lane >> 4;
    const float* WrT = (const float*)(ws + W_R) + (long)l * 48 * 1024; const bf16_t* xb = (const bf16_t*)(ws + X_XB);
    constexpr unsigned RT_WBUF = 53248;
    unsigned* ctl = (unsigned*)(ws + WS_CTL); const unsigned lg = LDS_PH + 2 * RT_WBUF + wv * 3072;
    const float* bg = a.in[22] + l * 4; const float* be = a.in[24] + l * 32;
    constexpr int WLD = 272;
    constexpr unsigned RT_CNT = LDS_PH + 2 * 53248 + 8 * 3072, RT_BASE = RT_CNT + 1024;
    for (int rnd = blockIdx.x; rnd < T_ / 256; rnd += gridDim.x) {
        f32x4 acc[2][3]; float ss[2] = {0.f, 0.f};
#pragma unroll
        for (int u = 0; u < 2; ++u) { acc[u][0] = f32x4{}; acc[u][1] = f32x4{}; acc[u][2] = f32x4{}; }
        if (threadIdx.x < 160) LDS_I(RT_CNT + threadIdx.x * 4) = 0;
        u4 wst[6];
#pragma unroll
        for (int k = 0; k < 6; ++k) { const int i = threadIdx.x + 512 * k, row = i >> 6, c4 = i & 63; wst[k] = gld16(WrT + (long)row * 1024 + c4 * 4); }
        __syncthreads();
#pragma unroll
        for (int k = 0; k < 6; ++k) { const int i = threadIdx.x + 512 * k, row = i >> 6, c4 = i & 63; LDS_U4(LDS_PH + (row * WLD + c4 * 4) * 4) = wst[k]; }
        __syncthreads();
#pragma unroll 1
        for (int kc = 0; kc < 4; ++kc) {
            const unsigned wbuf = LDS_PH + (kc & 1) * RT_WBUF;
            if (kc < 3) {
#pragma unroll
                for (int k = 0; k < 6; ++k) { const int i = threadIdx.x + 512 * k, row = i >> 6, c4 = i & 63; wst[k] = gld16(WrT + (long)row * 1024 + (kc + 1) * 256 + c4 * 4); } }
#pragma unroll
            for (int u = 0; u < 2; ++u) {
                const int t0 = rnd * 256 + (wv + 8 * u) * 16; const bf16_t* xr = xb + (long)(t0 + r16) * 1024 + kc * 256 + 4 * q4;
                const unsigned wl = wbuf + (r16 * WLD + 4 * q4) * 4;
#pragma unroll 4
                for (int i = 0; i < 16; ++i) {
                    const u2 xv = gld8(xr + 16 * i); const u4 w0 = LDS_U4(wl + i * 64), w1 = LDS_U4(wl + 16 * WLD * 4 + i * 64), w2 = LDS_U4(wl + 32 * WLD * 4 + i * 64);
                    const float x0 = __uint_as_float(xv.x << 16), x1 = __uint_as_float(xv.x & 0xffff0000u), x2 = __uint_as_float(xv.y << 16), x3 = __uint_as_float(xv.y & 0xffff0000u);
                    ss[u] += x0 * x0 + x1 * x1 + x2 * x2 + x3 * x3;
                    acc[u][0] = __builtin_amdgcn_mfma_f32_16x16x4f32(x0, __uint_as_float(w0.x), acc[u][0], 0, 0, 0); acc[u][1] = __builtin_amdgcn_mfma_f32_16x16x4f32(x0, __uint_as_float(w1.x), acc[u][1], 0, 0, 0); acc[u][2] = __builtin_amdgcn_mfma_f32_16x16x4f32(x0, __uint_as_float(w2.x), acc[u][2], 0, 0, 0);
                    acc[u][0] = __builtin_amdgcn_mfma_f32_16x16x4f32(x1, __uint_as_float(w0.y), acc[u][0], 0, 0, 0); acc[u][1] = __builtin_amdgcn_mfma_f32_16x16x4f32(x1, __uint_as_float(w1.y), acc[u][1], 0, 0, 0); acc[u][2] = __builtin_amdgcn_mfma_f32_16x16x4f32(x1, __uint_as_float(w2.y), acc[u][2], 0, 0, 0);
                    acc[u][0] = __builtin_amdgcn_mfma_f32_16x16x4f32(x2, __uint_as_float(w0.z), acc[u][0], 0, 0, 0); acc[u][1] = __builtin_amdgcn_mfma_f32_16x16x4f32(x2, __uint_as_float(w1.z), acc[u][1], 0, 0, 0); acc[u][2] = __builtin_amdgcn_mfma_f32_16x16x4f32(x2, __uint_as_float(w2.z), acc[u][2], 0, 0, 0);
                    acc[u][0] = __builtin_amdgcn_mfma_f32_16x16x4f32(x3, __uint_as_float(w0.w), acc[u][0], 0, 0, 0); acc[u][1] = __builtin_amdgcn_mfma_f32_16x16x4f32(x3, __uint_as_float(w1.w), acc[u][1], 0, 0, 0); acc[u][2] = __builtin_amdgcn_mfma_f32_16x16x4f32(x3, __uint_as_float(w2.w), acc[u][2], 0, 0, 0);
                }
            }
            if (kc < 3) {
#pragma unroll
                for (int k = 0; k < 6; ++k) { const int i = threadIdx.x + 512 * k, row = i >> 6, c4 = i & 63; LDS_U4(LDS_PH + ((kc + 1) & 1) * RT_WBUF + (row * WLD + c4 * 4) * 4) = wst[k]; }
                __syncthreads(); }
        }
        int sv_e0[2] = {0, 0}, sv_e1[2] = {0, 0}, sv_p[2] = {0, 0}, sv_r0[2] = {0, 0}, sv_r1[2] = {0, 0}, sv_r3[2] = {0, 0};
#pragma unroll
        for (int u = 0; u < 2; ++u) {
            const int t0 = rnd * 256 + (wv + 8 * u) * 16;
            float ssu = ss[u]; ssu += __shfl_xor(ssu, 16); ssu += __shfl_xor(ssu, 32);
            const float rstd = __builtin_amdgcn_rsqf(ssu * (1.f / 1024.f) + EPS);
#pragma unroll
            for (int rg = 0; rg < 4; ++rg) { const unsigned o = lg + ((q4 * 4 + rg) * 48 + r16) * 4; LDS_F(o) = acc[u][0][rg]; LDS_F(o + 64) = acc[u][1][rg]; LDS_F(o + 128) = acc[u][2][rg]; }
            if (lane < 16) {
            const int tk = t0 + lane; const unsigned row = lg + lane * 192;
            float gl[4]; int gs = 0; float gm;
#pragma unroll
            for (int j = 0; j < 4; ++j) gl[j] = LDS_F(row + j * 4) * rstd + gldf(bg + j);
            gm = gl[0];
#pragma unroll
            for (int j = 1; j < 4; ++j) if (gl[j] > gm) { gm = gl[j]; gs = j; }
            float gden = 0.f;
#pragma unroll
            for (int j = 0; j < 4; ++j) gden += fexp2((gl[j] - gm) * LOG2E);
            const float gw = frcp(gden);
            float el[8];
#pragma unroll
            for (int j = 0; j < 8; ++j) el[j] = LDS_F(row + (4 + gs * 8 + j) * 4) * rstd + gldf(be + gs * 8 + j);
            int i1 = 0; float m1 = el[0];
#pragma unroll
            for (int j = 1; j < 8; ++j) if (el[j] > m1) { m1 = el[j]; i1 = j; }
            int i2 = -1; float m2 = -3.0e38f;
#pragma unroll
            for (int j = 0; j < 8; ++j) if (j != i1 && el[j] > m2) { m2 = el[j]; i2 = j; }
            const float p2 = fexp2((m2 - m1) * LOG2E); const float w1 = gw * frcp(1.f + p2), w2 = gw - w1;
            const int lo = i1 < i2 ? i1 : i2, hi2 = i1 < i2 ? i2 : i1; const float wlo = i1 < i2 ? w1 : w2, whi = i1 < i2 ? w2 : w1;
            const int elo = gs * 8 + lo, ehi = gs * 8 + hi2, pr = gs * 28 + pair_index(lo, hi2);
            *(GAS float*)((float*)(ws + M_WSLOT) + 2 * tk) = wlo; *(GAS float*)((float*)(ws + M_WSLOT) + 2 * tk + 1) = whi;
            *(GAS float*)((float*)(ws + M_RSTD2) + tk) = rstd;
            sv_e0[u] = elo; sv_e1[u] = ehi; sv_p[u] = pr;
            sv_r0[u] = atomicAdd((int*)(smem + RT_CNT + elo * 4), 1); sv_r1[u] = atomicAdd((int*)(smem + RT_CNT + ehi * 4), 1); sv_r3[u] = atomicAdd((int*)(smem + RT_CNT + (32 + pr) * 4), 1);
        }
        }
        __syncthreads();
        if (!dry && threadIdx.x < 160) { const int t = threadIdx.x; const int c = LDS_I(RT_CNT + t * 4); int base = 0;
            if (c > 0 && t < 32 + NPAIR) base = (int)atomicAdd(t < 32 ? ctl + CW_CNTE + l * 32 + t : ctl + CW_CNTP + l * 128 + (t - 32), (unsigned)c);
            LDS_I(RT_BASE + t * 4) = base; }
        __syncthreads();
        if (!dry && lane < 16) {
#pragma unroll
            for (int u = 0; u < 2; ++u) { const int tk = rnd * 256 + (wv + 8 * u) * 16 + lane;
                *(GAS int*)((int*)(ws + M_LISTE) + (long)sv_e0[u] * 65536 + LDS_I(RT_BASE + sv_e0[u] * 4) + sv_r0[u]) = tk * 2;
                *(GAS int*)((int*)(ws + M_LISTE) + (long)sv_e1[u] * 65536 + LDS_I(RT_BASE + sv_e1[u] * 4) + sv_r1[u]) = tk * 2 + 1;
                *(GAS int*)((int*)(ws + M_LISTP) + (long)sv_p[u] * 65536 + LDS_I(RT_BASE + (32 + sv_p[u]) * 4) + sv_r3[u]) = tk; }
        }
    }
}

DEV void phase_moe1(const Args& a, int l) {
    unsigned char* ws = a.ws; unsigned* cnt = (unsigned*)(ws + WS_CTL) + CW_CNTE + l * 32;
    if (threadIdx.x < 32) LDS_I(LDS_EPI + 4096 + threadIdx.x * 4) = (int)xb_ld(cnt + threadIdx.x);
    __syncthreads();
    if (threadIdx.x == 0) { int af = 0, ah = 0; for (int e = 0; e < 32; ++e) { const int c = LDS_I(LDS_EPI + 4096 + e * 4); LDS_I(LDS_SCHED + e * 4) = af; LDS_I(LDS_SCHED + 256 + e * 4) = ah; af += (c >> 8) * 2; ah += (((c & 255) + 127) >> 7) * 2; }
        LDS_I(LDS_SCHED + 32 * 4) = af; LDS_I(LDS_SCHED + 256 + 32 * 4) = ah; }
    __syncthreads();
    const int nfull = LDS_I(LDS_SCHED + 32 * 4), total = nfull + LDS_I(LDS_SCHED + 256 + 32 * 4);
    for (int t = blockIdx.x; t < total; t += gridDim.x) {
        const bool full = t < nfull; const int v = full ? t : t - nfull; const unsigned tab = LDS_SCHED + (full ? 0 : 256);
        int e = 0; while (e < 31 && v >= LDS_I(tab + (e + 1) * 4)) ++e;
        const int loc = v - LDS_I(tab + e * 4), mt = loc >> 1, nt = loc & 1; const int ce = LDS_I(LDS_EPI + 4096 + e * 4);
        GemmMoe1 p{(const bf16_t*)(ws + X_XB), (const int*)(ws + M_LISTE) + (long)e * 65536, (const bf16_t*)(ws + W_GU) + ((long)(l * 32 + e) * 512) * 1024,
                   (const float*)(ws + M_RSTD2), (const float*)(ws + M_WSLOT), (bf16_t*)(ws + M_ABUF)};
        if (full) gemm_tile<4, 4>(p, mt * 256, nt * 256, 256);
        else { const int row0 = (ce >> 8) * 256 + mt * 128; const int mrows = ce - row0 < 128 ? ce - row0 : 128; gemm_tile3<2, 4>(p, row0, nt * 256, mrows); }
    }
}
DEV void phase_moe2(const Args& a, int l, float* xout, float* ssqo) {
    unsigned char* ws = a.ws; unsigned* cnt = (unsigned*)(ws + WS_CTL) + CW_CNTP + l * 128;
    if (threadIdx.x < NPAIR) LDS_I(LDS_EPI + 4096 + threadIdx.x * 4) = (int)xb_ld(cnt + threadIdx.x);
    __syncthreads();
    if (threadIdx.x == 0) { int acc = 0; for (int e = 0; e < NPAIR; ++e) { LDS_I(LDS_SCHED + e * 4) = acc; acc += ((LDS_I(LDS_EPI + 4096 + e * 4) + 127) >> 7) * 4; } LDS_I(LDS_SCHED + NPAIR * 4) = acc; }
    __syncthreads();
    const int total = LDS_I(LDS_SCHED + NPAIR * 4);
    for (int t = blockIdx.x; t < total; t += gridDim.x) {
        int e = 0; while (e < NPAIR - 1 && t >= LDS_I(LDS_SCHED + (e + 1) * 4)) ++e;
        const int loc = t - LDS_I(LDS_SCHED + e * 4), mt = loc >> 2, nt = loc & 3; const int ce = LDS_I(LDS_EPI + 4096 + e * 4); const int mrows = ce - mt * 128 < 128 ? ce - mt * 128 : 128;
        const int gs = e / 28; int q = e % 28, lo = 0; while (q >= 7 - lo) { q -= 7 - lo; ++lo; } const int hi2 = lo + 1 + q;
        const bf16_t* Wd = (const bf16_t*)(ws + W_DN) + (long)(l * 32) * 262144;
        GemmMoe2 p{(const bf16_t*)(ws + M_ABUF), (const int*)(ws + M_LISTP) + (long)e * 65536, Wd + (long)(gs * 8 + lo) * 262144, Wd + (long)(gs * 8 + hi2) * 262144, (bf16_t*)(ws + X_XB), xout, ssqo};
        gemm_tile3<2, 4>(p, mt * 128, nt * 256, mrows);
    }
}

#ifndef ATT_ONLY
#define ATT_ONLY 15
#endif
#define ATT_QUEUE_X(XQ, NPER, BODY) { int tid__ = threadIdx.x; asm volatile("" : "+v"(tid__)); const int x0_ = (int)(xb_xcc_id() & 7u); \
    for (int xi_ = 0; xi_ < 8; ++xi_) { const int xq = (x0_ + xi_) & 7; for (;;) { if (tid__ == 0) LDS_I(AT_ITEM) = (int)atomicAdd(qx + (XQ) + xq, 1u); __syncthreads(); \
        const int item = __builtin_amdgcn_readfirstlane(LDS_I(AT_ITEM)); __syncthreads(); if (item >= (NPER)) break; BODY } } }
#define ATT_QUEUE(QIDX, NITEMS, BODY) ATT_QUEUE_F(QIDX, NITEMS, false, BODY)
#define ATT_QUEUE_F(QIDX, NITEMS, FIRST, BODY) { int tid__ = threadIdx.x; asm volatile("" : "+v"(tid__)); const int q0_ = (FIRST) ? (int)gridDim.x : 0; int nx_ = 0; \
    if (FIRST) nx_ = (int)blockIdx.x; else if (tid__ == 0) nx_ = (int)atomicAdd(qc + (QIDX), 1u); \
    for (;;) { if (tid__ == 0) LDS_I(AT_ITEM) = nx_; __syncthreads(); \
        const int item = __builtin_amdgcn_readfirstlane(LDS_I(AT_ITEM)); __syncthreads(); if (item >= (NITEMS)) break; \
        if (tid__ == 0) nx_ = q0_ + (int)atomicAdd(qc + (QIDX), 1u);        \
        BODY } }
DEV void phase_attn(const Args& a, int l) {
    unsigned* qc = (unsigned*)(a.ws + WS_CTL) + CW_ATTQ + l * 16; unsigned* qx = (unsigned*)(a.ws + WS_CTL) + CW_ATTQ + 64 + l * 32;
#ifndef PROBE_ATT
#define PROBE_ATT 0
#endif
    if (PROBE_ATT & 1) ATT_QUEUE(8, 1024, { attn_mla(tid__, a, l, (item & 31) >> 2, item & 3, 31 - (item >> 5)); })
    if (PROBE_ATT & 2) ATT_QUEUE(9, 1024, { attn_nsa_b(tid__, a, l, (item & 15) >> 1, item & 1, 63 - (item >> 4)); })
    if (PROBE_ATT & 4) ATT_QUEUE(10, 1024, { attn_sb(tid__, a, l, item >> 7, (item >> 5) & 3, item & 31); })
    if (PROBE_ATT & 8) ATT_QUEUE(11, 1024, { attn_swa(tid__, a, l, item >> 7, (item >> 6) & 1, item & 63); })
    if (ATT_ONLY & 2) ATT_QUEUE_F(4, 1024, (gridDim.x <= 1024), { attn_nsa_a(tid__, a, l, (item & 15) >> 1, item & 1, 63 - (item >> 4)); if (PROBE_NSA & 1) attn_nsa_a(tid__, a, l, (item & 15) >> 1, item & 1, 63 - (item >> 4)); })
    if (ATT_ONLY & 1) ATT_QUEUE_X(0, 128, { const int st_ = xq * 4 + (item & 3); attn_mla(tid__, a, l, st_ >> 2, st_ & 3, 31 - (item >> 2)); })
    if (ATT_ONLY & 2) ATT_QUEUE(1, 1024, { attn_nsa_b(tid__, a, l, (item & 15) >> 1, item & 1, 63 - (item >> 4)); })
    if (ATT_ONLY & 4) ATT_QUEUE(2, 1024, { attn_sb(tid__, a, l, item >> 7, (item >> 5) & 3, item & 31); })
    if (ATT_ONLY & 8) ATT_QUEUE(3, 1024, { attn_swa(tid__, a, l, item >> 7, (item >> 6) & 1, item & 63); })
}

constexpr int NPHASE = 1 + 11 * L_;
#define XCD_REMAP(t) ((((t) & ~255)) + (((t) & 7) << 5) + (((t) & 255) >> 3))
#ifndef PROBE_PH
#define PROBE_PH 0
#endif
#ifndef PH_ONLY
#define PH_ONLY -1
#endif
#define IN(k) (a0.ph_lo <= (k) && (k) < a0.ph_hi && (PH_ONLY < 0 || PH_ONLY == ((k) == 0 ? 0 : 1 + ((k) - 1) % 11)))
#define GB(k) do { if (IN(k) && IN((k) + 1)) { xcd_barrier(bar); if (PROBE_PH & 2048) { xcd_barrier(bar); xcd_barrier(bar); } } } while (0)
#define GB2(k) do { if (IN(k) && IN((k) + 2)) xcd_barrier(bar); } while (0)
#define LAUNDER() do { unsigned char* w_ = a0.ws; float* o_ = a0.out; const float* x_ = xin0; asm volatile("" : "+s"(w_), "+s"(o_), "+s"(x_)); a.ws = w_; a.out = o_; ws = w_; xin = x_; } while (0)
template <int l> DEV void run_layer(const Args& a0, const XcdBarrier& bar) {
    Args a = a0; unsigned char* ws = a0.ws;
    const int pb = 1 + 11 * l;
    const float* xin0 = l == 0 ? a0.in[0] : (const float*)a0.out; const float* xin = xin0;
    if (IN(pb + 1)) { LAUNDER();
        pg8::Gemm g{(const bf16_t*)(ws + X_XB), (const bf16_t*)(ws + W_WIN) + (long)l * PLD * 1024, T_, 2816, 1024};
        pg8::StaticOrder S; S.init(T_, 2816, (int)gridDim.x, (int)blockIdx.x);
        pg8::EpiProj E{(bf16_t*)(ws + P_PROJ), PLD, PLD, l == 0 ? (const float*)(ws + MS_RSTD1) : (const float*)(ws + MS_SSQP), l == 0 ? 1 : 4, T_};
        for (int rep = 0; rep < ((PROBE_PH & 1) ? 2 : 1); ++rep)
        pg8::gemm_phase<pg8::EpiProj, pg8::StaticOrder, true, true>((LAS unsigned char*)((LAS char*)smem + LDS_PH), g, S, E);
    }
    GB(pb + 1);
    if (IN(pb + 2)) { LAUNDER(); phase_prep(a, l); if (PROBE_PH & 2) phase_prep(a, l); }
    GB(pb + 2);
    if (IN(pb + 3)) { LAUNDER();
        for (int rep = 0; rep < ((PROBE_PH & 16) ? 2 : 1); ++rep)
        {
            if (blockIdx.x < 64) { const int u = blockIdx.x, w = u >> 5; GemmCmp1 p{(const bf16_t*)(ws + A_XC), w, (const bf16_t*)(ws + W_C1) + (long)(l * 2 + w) * 128 * 2048, (const float*)(ws + W_B1) + (l * 2 + w) * 128, (bf16_t*)(ws + A_H1) + (long)w * 8192 * 128};
                gemm_tile3<2, 2>(p, (u & 31) * 256, 0, 256); }
            const bf16_t* wq = (const bf16_t*)(ws + W_QUP) + (long)l * 384 * 192; const bf16_t* wkv = (const bf16_t*)(ws + W_KVUP) + (long)l * 512 * 128;
            auto mk = [&](int u, GemmPlain& p, int& m0, int& n0) {
                if (u < 768) { p = GemmPlain{(const bf16_t*)(ws + A_CQN), 192, wq, 192, 3, (bf16_t*)(ws + P_QRAW), 384}; m0 = (u / 3) * 256; n0 = (u % 3) * 128; }
                else { const int v = u - 768; p = GemmPlain{(const bf16_t*)(ws + A_CKVN), 128, wkv, 128, 2, (bf16_t*)(ws + P_KVRAW), 512}; m0 = (v / 4) * 256; n0 = (v % 4) * 128; } };
            if (gridDim.x == 256) {
                if (blockIdx.x < 64) gemm_smallk_run(mk, (int)blockIdx.x, 64, 256); else gemm_smallk_run(mk, 256 + ((int)blockIdx.x - 64), 192, 1792);
            } else gemm_smallk_run(mk, (int)blockIdx.x, (int)gridDim.x, 1792);
        }
    }
    GB(pb + 3);
    if (IN(pb + 4)) { LAUNDER();
        phase_mla_fin(a, l);
        if (PROBE_PH & 32) phase_mla_fin(a, l);
        __syncthreads();
        for (int t = blockIdx.x; t < 64; t += gridDim.x) { const int w = t >> 5;
            GemmCmp2 p{(const bf16_t*)(ws + A_H1) + (long)w * 8192 * 128, w, (const bf16_t*)(ws + W_C2) + (long)(l * 2 + w) * 128 * 128, a.in[8] + (l * 3) * 64, (bf16_t*)(ws + A_KC), (bf16_t*)(ws + A_VC)};
            gemm_tile3<2, 2>(p, (t & 31) * 256, 0, 256); }
    }
    GB(pb + 4);
    if (IN(pb + 5)) { LAUNDER(); phase_attn(a, l); }
    GB(pb + 5);
    if (IN(pb + 6)) { LAUNDER(); phase_combine(a); if (PROBE_PH & 64) phase_combine(a); }
    GB(pb + 6);
    if (IN(pb + 7)) { LAUNDER();
        pg8::Gemm g{(const bf16_t*)(ws + P_ORAW), (const bf16_t*)(ws + W_WOUT) + (long)l * 1048576, T_, 1024, 1024};
        pg8::StaticOrder S; S.init(T_, 1024, (int)gridDim.x, (int)blockIdx.x);
        pg8::EpiResid E{(bf16_t*)(ws + X_XB), 1024};
        for (int rep = 0; rep < (((PROBE_PH & 128) && l == 0) ? 2 : 1); ++rep)
        pg8::gemm_phase<pg8::EpiResid, pg8::StaticOrder, true, true>((LAS unsigned char*)((LAS char*)smem + LDS_PH), g, S, E);
    }
    GB(pb + 7);
    if (IN(pb + 8)) { LAUNDER(); phase_router(a, l); if (PROBE_PH & 512) phase_router(a, l, true); }
    GB(pb + 8);
    if (IN(pb + 9)) { LAUNDER(); phase_moe1(a, l); if (PROBE_PH & 4) { __syncthreads(); phase_moe1(a, l); } }
    GB(pb + 9);
    if (IN(pb + 10)) { LAUNDER(); phase_moe2(a, l, l + 1 < L_ ? nullptr : a.out, (float*)(ws + MS_SSQP)); if (PROBE_PH & 1024) { __syncthreads(); phase_moe2(a, l, (float*)(ws + P_PROJ), nullptr); } }
    if (l + 1 < L_) GB2(pb + 10);
}
__global__ void __launch_bounds__(512, 2) hymba_fwd(Args a0) {
    if (threadIdx.x == 0) { LDS_U(0) = 0u; LDS_U(4) = 0u; LDS_U(8) = 0u; LDS_U(12) = 0u; }
    __syncthreads();
    XcdBarrier bar; bar.bar = (unsigned*)(a0.ws + WS_CTL) + CW_BAR; bar.x = 0; bar.st = (volatile LAS unsigned*)((LAS char*)smem);
    if (a0.ph_hi - a0.ph_lo > 1) bar = xcd_barrier_post((unsigned*)(a0.ws + WS_CTL) + CW_BAR, (volatile LAS unsigned*)((LAS char*)smem));
    if (IN(0)) { phase_p0(a0); if (PROBE_PH & 256) { __syncthreads(); phase_p0(a0); } phase_rowstat(a0.in[0], (bf16_t*)(a0.ws + X_XB), (float*)(a0.ws + MS_RSTD1)); }
    GB2(0);
    run_layer<0>(a0, bar);
    run_layer<1>(a0, bar);
}

extern "C" void kernel_launch(void* const* d_in, const int* in_sizes, int n_in, void* d_out, int out_size, void* d_ws, size_t ws_size, hipStream_t stream) {
    static int grid = 0;
    if (grid == 0) {
        if (n_in != 28 || out_size != T_ * D_ || ws_size < WS_END) { fprintf(stderr, "kernel_launch: unexpected shapes (n_in %d out %d ws %zu)\n", n_in, out_size, ws_size); grid = -1; return; }
        int dev = 0, cus = 0, per_cu = 0;
        if (hipGetDevice(&dev) != hipSuccess || hipDeviceGetAttribute(&cus, hipDeviceAttributeMultiprocessorCount, dev) != hipSuccess) { grid = -1; return; }
        if (hipFuncSetAttribute((const void*)hymba_fwd, hipFuncAttributeMaxDynamicSharedMemorySize, LDS_BYTES) != hipSuccess) { fprintf(stderr, "kernel_launch: hipFuncSetAttribute failed\n"); grid = -1; return; }
        if (hipOccupancyMaxActiveBlocksPerMultiprocessor(&per_cu, (const void*)hymba_fwd, 512, LDS_BYTES) != hipSuccess || per_cu < 1) { fprintf(stderr, "kernel_launch: occupancy query reports %d\n", per_cu); per_cu = 1; }
        (void)hipGetLastError();
        grid = cus;
    }
    if (grid < 0) return;
    (void)hipMemsetAsync((char*)d_ws + WS_CTL, 0, CTL_BYTES, stream);
    Args a{};
    for (int i = 0; i < 28; ++i) a.in[i] = (const float*)d_in[i];
    a.out = (float*)d_out; a.ws = (unsigned char*)d_ws;
#if MK_LAUNCHES == 1
    a.ph_lo = 0; a.ph_hi = NPHASE;
    hipLaunchKernelGGL(hymba_fwd, dim3(grid), dim3(512), LDS_BYTES, stream, a);
#else
    for (int k = 0; k < NPHASE; ++k) { a.ph_lo = k; a.ph_hi = k + 1; hipLaunchKernelGGL(hymba_fwd, dim3(grid), dim3(512), LDS_BYTES, stream, a); }
#endif
}
```

```cpp
#include <hip/hip_runtime.h>
#include <hip/hip_bf16.h>
#include <stdint.h>
#include <stdio.h>

#ifndef MK_LAUNCHES
#define MK_LAUNCHES 1
#endif

#define DEV __device__ __forceinline__
#define GAS __attribute__((address_space(1)))
#define LAS __attribute__((address_space(3)))

typedef unsigned short bf16_t;
typedef __attribute__((ext_vector_type(8))) short bf16x8;
typedef __attribute__((ext_vector_type(4))) short s16x4;
typedef short v4i16_t __attribute__((ext_vector_type(4)));
typedef __attribute__((ext_vector_type(16))) float f32x16;
typedef __attribute__((ext_vector_type(4))) float f32x4;
typedef __attribute__((ext_vector_type(2))) float f32x2_t;
typedef __attribute__((ext_vector_type(2))) __bf16 bf16x2_t;
typedef __attribute__((ext_vector_type(4))) unsigned u4;
typedef __attribute__((ext_vector_type(2))) unsigned u2;

constexpr int B_ = 8, S_ = 8192, T_ = B_ * S_, D_ = 1024, L_ = 2;
constexpr int INC = 2668;
constexpr int PLD = 2688;
constexpr int C_SBQ = 0, C_SBK = 256, C_SBV = 512, C_SWQ = 768, C_SWK = 1024, C_SWV = 1152, C_NQ = 1280, C_NKC = 1536, C_NVC = 1664,
              C_NKS = 1792, C_NVS = 1920, C_NKW = 2048, C_NVW = 2176, C_CQ = 2304, C_CKV = 2496, C_KPE = 2624, C_NG = 2656;
constexpr float EPS = 1e-6f;
constexpr float LOG2E = 1.4426950408889634f;
constexpr int NPAIR = 112;

constexpr size_t MiB = 1048576;
constexpr size_t WS_CTL = 0;
constexpr size_t CTL_BYTES = 65536;
constexpr int CW_BAR = 0;
constexpr int CW_ATTQ = 4096;
constexpr int CW_CNTE = 4224;
constexpr int CW_CNTP = 4352;
constexpr int CW_VMAX = 4608;
constexpr int CW_NSAF = 8192;
constexpr size_t W_WIN = 1 * MiB;   static_assert(CTL_BYTES <= MiB, "control region");
constexpr size_t W_WOUT = W_WIN + (size_t)L_ * PLD * 1024 * 2;
constexpr size_t W_QUP = W_WOUT + (size_t)L_ * 1024 * 1024 * 2;
constexpr size_t W_KVUP = W_QUP + (size_t)L_ * 384 * 192 * 2;
constexpr size_t W_C1 = W_KVUP + (size_t)L_ * 512 * 128 * 2;
constexpr size_t W_C2 = W_C1 + (size_t)L_ * 2 * 128 * 2048 * 2;
constexpr size_t W_B1 = W_C2 + (size_t)L_ * 2 * 128 * 128 * 2;
constexpr size_t W_R = W_B1 + (size_t)L_ * 2 * 128 * 4;
constexpr size_t W_GU = W_R + (size_t)L_ * 48 * 1024 * 4;
constexpr size_t W_DN = W_GU + (size_t)L_ * 32 * 512 * 1024 * 2;
constexpr size_t W_LUT = W_DN + (size_t)L_ * 32 * 1024 * 256 * 2;
constexpr size_t W_ROPE = W_LUT + 8 * 1024 * 4;
constexpr size_t W_MLAB = W_ROPE + (size_t)S_ * 16 * 2 * 4;
constexpr size_t W_END = W_MLAB + 256;
static_assert(W_END <= 124 * MiB, "weights region");
constexpr size_t R_X = 124 * MiB;
constexpr size_t X_XB = R_X;
constexpr size_t R_Q = R_X + 128 * MiB;
constexpr size_t X_QSB = R_Q;
constexpr size_t X_KSB = R_Q + 32 * MiB;
constexpr size_t X_VSB = R_Q + 64 * MiB;
constexpr size_t X_QSW = R_Q + 96 * MiB;
constexpr size_t R_P = R_Q + 128 * MiB;
constexpr size_t P_PROJ = R_P;
constexpr size_t P_QRAW = R_P;
constexpr size_t P_KVRAW = R_P + 48 * MiB;
constexpr size_t P_ORAW = R_P + 112 * MiB;
constexpr size_t A_QM = R_P + 240 * MiB;
constexpr size_t A_KM = R_P + 288 * MiB;
constexpr size_t R_A = R_P + 336 * MiB;
constexpr size_t A_KSW = R_A;
constexpr size_t A_VSW = R_A + 16 * MiB;
constexpr size_t A_QN = R_A + 32 * MiB;
constexpr size_t A_KNS = R_A + 64 * MiB;
constexpr size_t A_VNS = R_A + 80 * MiB;
constexpr size_t A_KNW = R_A + 96 * MiB;
constexpr size_t A_VNW = R_A + 112 * MiB;
constexpr size_t A_CQN = R_A + 128 * MiB;
constexpr size_t A_CKVN = R_A + 152 * MiB;
constexpr size_t A_KPE = R_A + 168 * MiB;
constexpr size_t A_VM = R_A + 172 * MiB;
constexpr size_t A_XC = R_A + 204 * MiB;
constexpr size_t A_GATES = R_A + 236 * MiB;
constexpr size_t A_KC = R_A + 239 * MiB;
constexpr size_t A_VC = R_A + 240 * MiB;
constexpr size_t A_H1 = R_A + 241 * MiB;
constexpr size_t A_END = R_A + 245 * MiB;
constexpr size_t M_ABUF = R_A;
constexpr size_t M_LISTE = R_A + 64 * MiB;
constexpr size_t M_LISTP = R_A + 72 * MiB;
constexpr size_t M_WSLOT = R_A + 100 * MiB;
constexpr size_t M_RSTD2 = R_A + 101 * MiB;
constexpr size_t R_MISC = A_END;
constexpr size_t MS_RSTD1 = R_MISC;
constexpr size_t MS_SELM = R_MISC + 1 * MiB;
constexpr size_t MS_UNM = R_MISC + 3 * MiB;
constexpr size_t MS_SSQP = R_MISC + 3 * MiB + 262144;
constexpr size_t WS_END = R_MISC + 5 * MiB;
static_assert(WS_END <= 1024 * MiB, "workspace");

DEV unsigned cvtpk(float lo, float hi) { f32x2_t v = {lo, hi}; bf16x2_t b = __builtin_convertvector(v, bf16x2_t); return __builtin_bit_cast(unsigned, b); }
DEV float bflo(unsigned u) { return __uint_as_float(u << 16); }
DEV float bfhi(unsigned u) { return __uint_as_float(u & 0xffff0000u); }
DEV u4 gld16(const void* p) { return *(const GAS u4*)p; }
DEV void gst16(void* p, u4 v) { *(GAS u4*)p = v; }
DEV u2 gld8(const void* p) { return *(const GAS u2*)p; }
DEV void gst8(void* p, u2 v) { *(GAS u2*)p = v; }
DEV float gldf(const void* p) { return *(const GAS float*)p; }
DEV int crow(int r, int hi) { return (r & 3) + 8 * (r >> 2) + 4 * hi; }
DEV float fexp2(float x) { return __builtin_amdgcn_exp2f(x); }
DEV float frcp(float x) { return __builtin_amdgcn_rcpf(x); }
DEV float hsum(float v) { auto rr = __builtin_amdgcn_permlane32_swap(__float_as_uint(v), __float_as_uint(v), false, false); return __uint_as_float(rr[0]) + __uint_as_float(rr[1]); }
DEV float hmax(float v) { auto rr = __builtin_amdgcn_permlane32_swap(__float_as_uint(v), __float_as_uint(v), false, false); return __builtin_fmaxf(__uint_as_float(rr[0]), __uint_as_float(rr[1])); }
DEV float hother(float v, int hi) { auto rr = __builtin_amdgcn_permlane32_swap(__float_as_uint(v), __float_as_uint(v), false, false); return __uint_as_float(hi ? rr[0] : rr[1]); }
DEV unsigned hother_u(unsigned v, int hi) { auto rr = __builtin_amdgcn_permlane32_swap(v, v, false, false); return hi ? rr[0] : rr[1]; }
#define MFMA32(a, b, c) __builtin_amdgcn_mfma_f32_32x32x16_bf16(a, b, c, 0, 0, 0)

extern __shared__ __attribute__((aligned(16))) char smem[];
#define LDS_U4(off) (*(LAS u4*)((LAS char*)smem + (off)))
#define LDS_U2(off) (*(LAS u2*)((LAS char*)smem + (off)))
#define LDS_F(off) (*(LAS float*)((LAS char*)smem + (off)))
#define LDS_I(off) (*(LAS int*)((LAS char*)smem + (off)))
#define LDS_U(off) (*(LAS unsigned*)((LAS char*)smem + (off)))
#define LDS_BF8(off) (*(LAS bf16x8*)((LAS char*)smem + (off)))
DEV s16x4 lds_tr(unsigned off) { return __builtin_bit_cast(s16x4, __builtin_amdgcn_ds_read_tr16_b64_v4i16((LAS v4i16_t*)((LAS char*)smem + off))); }

constexpr int LDS_PH = 1024;
constexpr int LDS_BYTES = 155648;
constexpr int LDS_SCHED = LDS_PH + 147456, LDS_EPI = LDS_SCHED + 512;

#define XB_TMO      128
#define XB_XCNT(j)  (256  + 64 * (j))
#define XB_XSUB(j)  (1280 + 64 * (j))
#define XB_XGEN(j)  (2304 + 64 * (j))
#define XB_TOP      3328
#define XB_TOPGEN   3392
#define XCD_BAR_WORDS 3456
#define XB_SPIN_CAP (1u << 22)
DEV unsigned xb_ld(unsigned* p)              { return __hip_atomic_load(p, __ATOMIC_RELAXED, __HIP_MEMORY_SCOPE_AGENT); }
DEV unsigned xb_add(unsigned* p, unsigned v) { return __hip_atomic_fetch_add(p, v, __ATOMIC_RELAXED, __HIP_MEMORY_SCOPE_AGENT); }
DEV unsigned xb_xcc_id() { return (unsigned)__builtin_amdgcn_s_getreg((3 << 11) | 20) & 0xFu; }
#define XB_SPIN(cond, bar) do { unsigned _sp = 0; while (cond) { __builtin_amdgcn_s_sleep(1); \
    if ((++_sp & 255u) == 0u) { if (xb_ld(&(bar)[XB_TMO])) break; if (_sp > XB_SPIN_CAP) { atomicAdd(&(bar)[XB_TMO], 1u); break; } } } } while (0)
struct XcdBarrier { unsigned* bar; unsigned x; volatile LAS unsigned* st; };
DEV XcdBarrier xcd_barrier_post(unsigned* bar, volatile LAS unsigned* st) {
    XcdBarrier b; b.bar = bar; b.x = xb_xcc_id(); b.st = st;
    if (threadIdx.x == 0) (void)xb_add(&bar[XB_XCNT(b.x)], 1u);
    return b;
}
DEV void xcd_barrier_complete(unsigned* bar, unsigned x, unsigned& nloc, unsigned& nx) {
    const unsigned G = gridDim.x * gridDim.y * gridDim.z;
    unsigned sum, cnt, mine, sp = 0u;
    for (;;) {
        sum = 0u; cnt = 0u; mine = 0u;
#pragma unroll
        for (unsigned j = 0; j < 16; ++j) { const unsigned c = xb_ld(&bar[XB_XCNT(j)]); sum += c; cnt += (c > 0u) ? 1u : 0u; mine = (j == x) ? c : mine; }
        if (sum == G) break;
        __builtin_amdgcn_s_sleep(1);
        if ((++sp & 255u) == 0u) { if (xb_ld(&bar[XB_TMO])) break; if (sp > XB_SPIN_CAP) { atomicAdd(&bar[XB_TMO], 1u); break; } }
    }
    nloc = mine > 0u ? mine : 1u; nx = cnt > 0u ? cnt : 1u;
}
DEV void xcd_barrier(const XcdBarrier& b) {
    asm volatile("s_waitcnt vmcnt(0)" ::: "memory");
    __syncthreads();
    if (threadIdx.x == 0) {
        unsigned* bar = b.bar;
        __builtin_amdgcn_s_waitcnt(0);
        unsigned nloc = b.st[0], nx = b.st[1];
        if (nloc == 0u) { xcd_barrier_complete(bar, b.x, nloc, nx); b.st[0] = nloc; b.st[1] = nx; }
        const unsigned old = xb_add(&bar[XB_XSUB(b.x)], 1u);
        const unsigned gen = old / nloc;
        if (old + 1u == (gen + 1u) * nloc) {
            __builtin_amdgcn_fence(__ATOMIC_RELEASE, "agent");
            asm volatile("s_waitcnt vmcnt(0)" ::: "memory");
            const unsigned og = xb_add(&bar[XB_TOP], 1u);
            const unsigned tg = og / nx;
            if (og + 1u == (tg + 1u) * nx) xb_add(&bar[XB_TOPGEN], 1u);
            else XB_SPIN(xb_ld(&bar[XB_TOPGEN]) == tg, bar);
            __builtin_amdgcn_fence(__ATOMIC_ACQUIRE, "agent");
            xb_add(&bar[XB_XGEN(b.x)], 1u);
            asm volatile("s_waitcnt vmcnt(0)" ::: "memory");
        } else {
            XB_SPIN(xb_ld(&bar[XB_XGEN(b.x)]) == gen, bar);
            __builtin_amdgcn_fence(__ATOMIC_ACQUIRE, "agent");
            asm volatile("s_waitcnt vmcnt(0)" ::: "memory");
        }
    }
    __syncthreads();
}

struct Args {
    const float* in[28];
    float* out;
    unsigned char* ws;
    int ph_lo, ph_hi;
};

template <class F> DEV void xpose64(const F& f, int k0, int n0, bf16_t* dst, long dld, int slot, int half, float (&rg)[8]) {
    const int tid = threadIdx.x; const unsigned base = LDS_PH + slot * (64 * 65 * 4);
    if (half == 0) {
#pragma unroll
        for (int r = 0; r < 2; ++r) { const int idx = tid + 512 * r, i = idx >> 4, j4 = (idx & 15) * 4; float o4[4]; f.ld4(k0 + i, n0 + j4, o4); rg[4 * r] = o4[0]; rg[4 * r + 1] = o4[1]; rg[4 * r + 2] = o4[2]; rg[4 * r + 3] = o4[3]; }
    } else if (half == 2) {
#pragma unroll
        for (int r = 0; r < 2; ++r) { const int idx = tid + 512 * r, i = idx >> 4, j4 = (idx & 15) * 4;
#pragma unroll
            for (int e = 0; e < 4; ++e) LDS_F(base + (i * 65 + j4 + e) * 4) = rg[4 * r + e]; }
    } else {
        const int j = tid >> 3, ch = tid & 7; float v[8];
#pragma unroll
        for (int e = 0; e < 8; ++e) v[e] = LDS_F(base + ((ch * 8 + e) * 65 + j) * 4);
        u4 o; o.x = cvtpk(v[0], v[1]); o.y = cvtpk(v[2], v[3]); o.z = cvtpk(v[4], v[5]); o.w = cvtpk(v[6], v[7]);
        gst16(dst + (long)(n0 + j) * dld + k0 + ch * 8, o);
    }
}
struct FWin { const float* w; const float* g; DEV float operator()(int k, int n) const {
    const int oc = n < 2304 ? n : (n < 2656 ? n + 12 : (n < 2668 ? n - 352 : -1));
    return oc < 0 ? 0.f : gldf(g + k) * gldf(w + (long)k * INC + oc); }
    DEV void ld4(int k, int n, float (&o)[4]) const {
        const int oc = n < 2304 ? n : (n < 2656 ? n + 12 : (n < 2668 ? n - 352 : -1)); u4 v = {0u, 0u, 0u, 0u}; float gk = 0.f;
        if (oc >= 0) { v = gld16(w + (long)k * INC + oc); gk = gldf(g + k); }
        o[0] = gk * __uint_as_float(v.x); o[1] = gk * __uint_as_float(v.y); o[2] = gk * __uint_as_float(v.z); o[3] = gk * __uint_as_float(v.w); } };
struct FScaled { const float* w; const float* g; int ld; DEV float operator()(int k, int n) const { return gldf(g + k) * gldf(w + (long)k * ld + n); }
    DEV void ld4(int k, int n, float (&o)[4]) const { const u4 v = gld16(w + (long)k * ld + n); const float gk = gldf(g + k);
        o[0] = gk * __uint_as_float(v.x); o[1] = gk * __uint_as_float(v.y); o[2] = gk * __uint_as_float(v.z); o[3] = gk * __uint_as_float(v.w); } };
struct FPlain { const float* w; int ld; DEV float operator()(int k, int n) const { return gldf(w + (long)k * ld + n); }
    DEV void ld4(int k, int n, float (&o)[4]) const { const u4 v = gld16(w + (long)k * ld + n); o[0] = __uint_as_float(v.x); o[1] = __uint_as_float(v.y); o[2] = __uint_as_float(v.z); o[3] = __uint_as_float(v.w); } };
struct FC2 { const float* w; DEV float operator()(int k, int n) const { return n < 64 ? gldf(w + k * 64 + n) : 0.f; }
    DEV void ld4(int k, int n, float (&o)[4]) const { u4 v = {0u, 0u, 0u, 0u}; if (n < 64) v = gld16(w + k * 64 + n); o[0] = __uint_as_float(v.x); o[1] = __uint_as_float(v.y); o[2] = __uint_as_float(v.z); o[3] = __uint_as_float(v.w); } };
struct FGU { const float* wg; const float* wu; const float* g; DEV float operator()(int k, int n) const {
    const int j = 32 * (n >> 6) + (n & 31); const float* w = (const float*)((uintptr_t)wg + (uintptr_t)((n >> 5) & 1) * ((uintptr_t)wu - (uintptr_t)wg)); return gldf(g + k) * gldf(w + (long)k * 256 + j); }
    DEV void ld4(int k, int n, float (&o)[4]) const {
        const int j = 32 * (n >> 6) + (n & 31); const float* w = (const float*)((uintptr_t)wg + (uintptr_t)((n >> 5) & 1) * ((uintptr_t)wu - (uintptr_t)wg)); const u4 v = gld16(w + (long)k * 256 + j); const float gk = gldf(g + k);
        o[0] = gk * __uint_as_float(v.x); o[1] = gk * __uint_as_float(v.y); o[2] = gk * __uint_as_float(v.z); o[3] = gk * __uint_as_float(v.w); } };

__constant__ float c_invf[16] = {1.0f, 0.5623413324356079f, 0.3162277638912201f, 0.17782793939113617f, 0.10000000149011612f, 0.05623413249850273f,
    0.03162277489900589f, 0.017782794311642647f, 0.009999999776482582f, 0.005623413249850273f, 0.003162277629598975f, 0.0017782794311642647f,
    0.0010000000474974513f, 0.000562341301701963f, 0.0003162277571391314f, 0.00017782794020604342f};
DEV int t5_bucket(int n) {
    if (n < 16) return n;
    int b = 16;
    b += (n >= 21) + (n >= 27) + (n >= 35) + (n >= 46) + (n >= 59) + (n >= 77) + (n >= 99) + (n >= 128) + (n >= 166) + (n >= 216) + (n >= 280) + (n >= 363) + (n >= 470) + (n >= 609) + (n >= 790);
    return b;
}

DEV void rowstat_token(const float* x, bf16_t* xb, float* rstd, int t, int lane) {
    const float* xr = x + (long)t * 1024; float ss = 0.f;
#pragma unroll
    for (int i = 0; i < 2; ++i) {
        const u4 u = gld16(xr + i * 512 + lane * 8), w = gld16(xr + i * 512 + lane * 8 + 4);
        const float v0 = __uint_as_float(u.x), v1 = __uint_as_float(u.y), v2 = __uint_as_float(u.z), v3 = __uint_as_float(u.w), v4 = __uint_as_float(w.x), v5 = __uint_as_float(w.y), v6 = __uint_as_float(w.z), v7 = __uint_as_float(w.w);
        ss += (v0 * v0 + v1 * v1 + v2 * v2 + v3 * v3) + (v4 * v4 + v5 * v5 + v6 * v6 + v7 * v7);
        u4 o; o.x = cvtpk(v0, v1); o.y = cvtpk(v2, v3); o.z = cvtpk(v4, v5); o.w = cvtpk(v6, v7); gst16(xb + (long)t * 1024 + i * 512 + lane * 8, o);
    }
#pragma unroll
    for (int m = 1; m < 64; m <<= 1) ss += __shfl_xor(ss, m);
    if (lane == 0) rstd[t] = ss;
}
namespace p0c {
constexpr int N_WIN = L_ * 16 * 42, N_WOUT = L_ * 256, N_QUP = L_ * 18, N_KVUP = L_ * 16, N_C1 = L_ * 2 * 64, N_C2 = L_ * 2 * 4, N_GU = L_ * 32 * 128, N_DN = L_ * 32 * 64;
constexpr int O1 = N_WIN, O2 = O1 + N_WOUT, O3 = O2 + N_QUP, O4 = O3 + N_KVUP, O5 = O4 + N_C1, O6 = O5 + N_C2, O7 = O6 + N_GU, O8 = O7 + N_DN;
}
DEV void p0_tile(const Args& a, int t, int u, int half, float (&rg)[8]) {
    using namespace p0c; unsigned char* ws = a.ws;
        if (t < O1) { const int l = t / 672, r = t % 672, kt = r / 42, nt = r % 42;
            FWin f{a.in[3] + (long)l * 1024 * INC, a.in[2] + l * 1024}; xpose64(f, kt * 64, nt * 64, (bf16_t*)(ws + W_WIN) + (long)l * PLD * 1024, 1024, u, half, rg);
        } else if (t < O2) { const int u2 = t - O1, l = u2 / 256, r = u2 % 256, kt = r / 16, nt = r % 16;
            FScaled f{a.in[19] + (long)l * 1048576, a.in[18] + l * 1024, 1024}; xpose64(f, kt * 64, nt * 64, (bf16_t*)(ws + W_WOUT) + (long)l * 1048576, 1024, u, half, rg);
        } else if (t < O3) { const int u2 = t - O2, l = u2 / 18, r = u2 % 18, kt = r / 6, nt = r % 6;
            FScaled f{a.in[13] + (long)l * 192 * 384, a.in[12] + l * 192, 384}; xpose64(f, kt * 64, nt * 64, (bf16_t*)(ws + W_QUP) + (long)l * 384 * 192, 192, u, half, rg);
        } else if (t < O4) { const int u2 = t - O3, l = u2 / 16, r = u2 % 16, kt = r / 8, nt = r % 8;
            FScaled f{a.in[15] + (long)l * 128 * 512, a.in[14] + l * 128, 512}; xpose64(f, kt * 64, nt * 64, (bf16_t*)(ws + W_KVUP) + (long)l * 512 * 128, 128, u, half, rg);
        } else if (t < O5) { const int u2 = t - O4, lw = u2 / 64, r = u2 % 64, kt = r / 2, nt = r % 2;
            FPlain f{a.in[10] + (long)lw * 2048 * 128, 128}; xpose64(f, kt * 64, nt * 64, (bf16_t*)(ws + W_C1) + (long)lw * 128 * 2048, 2048, u, half, rg);
        } else if (t < O6) { const int u2 = t - O5, lw = u2 / 4, r = u2 % 4, kt = r / 2, nt = r % 2;
            FC2 f{a.in[11] + (long)lw * 128 * 64}; xpose64(f, kt * 64, nt * 64, (bf16_t*)(ws + W_C2) + (long)lw * 128 * 128, 128, u, half, rg);
        } else if (t < O7) { const int u2 = t - O6, le = u2 / 128, r = u2 % 128, kt = r / 8, nt = r % 8;
            FGU f{a.in[25] + (long)le * 262144, a.in[26] + (long)le * 262144, a.in[20] + (le / 32) * 1024}; xpose64(f, kt * 64, nt * 64, (bf16_t*)(ws + W_GU) + (long)le * 524288, 1024, u, half, rg);
        } else { const int u2 = t - O7, le = u2 / 64, r = u2 % 64, kt = r / 16, nt = r % 16;
            FPlain f{a.in[27] + (long)le * 262144, 1024}; xpose64(f, kt * 64, nt * 64, (bf16_t*)(ws + W_DN) + (long)le * 262144, 256, u, half, rg);
        }
}
DEV void phase_p0(const Args& a) {
    using namespace p0c; unsigned char* ws = a.ws;
    {
        float rg[6][8]; const int tstep = (int)gridDim.x * 6;
        const float* rx = a.in[0]; bf16_t* rxb = (bf16_t*)(ws + X_XB); float* rss = (float*)(ws + MS_RSTD1);
        const int rlane = threadIdx.x & 63, rstep = (int)gridDim.x * 8; int rt = (int)blockIdx.x * 8 + (threadIdx.x >> 6);
        int t0 = (int)blockIdx.x * 6;
#pragma unroll
        for (int u = 0; u < 6; ++u) if (t0 + u < O8) p0_tile(a, t0 + u, u, 0, rg[u]);
        for (; t0 < O8; t0 += tstep) {
#pragma unroll
            for (int u = 0; u < 6; ++u) if (t0 + u < O8) p0_tile(a, t0 + u, u, 2, rg[u]);
            __syncthreads();
            const int t1 = t0 + tstep;
#pragma unroll
            for (int u = 0; u < 6; ++u) if (t1 + u < O8) p0_tile(a, t1 + u, u, 0, rg[u]);
            if (rt + 3 * rstep < T_) {
                u4 rb[4][4];
#pragma unroll
                for (int q = 0; q < 4; ++q) { const float* xr = rx + (long)(rt + q * rstep) * 1024 + rlane * 8; rb[q][0] = gld16(xr); rb[q][1] = gld16(xr + 4); rb[q][2] = gld16(xr + 512); rb[q][3] = gld16(xr + 516); }
#pragma unroll
                for (int q = 0; q < 4; ++q) { const int t = rt + q * rstep; float ss = 0.f;
#pragma unroll
                    for (int i = 0; i < 2; ++i) { const u4 u = rb[q][2 * i], w = rb[q][2 * i + 1];
                        const float v0 = __uint_as_float(u.x), v1 = __uint_as_float(u.y), v2 = __uint_as_float(u.z), v3 = __uint_as_float(u.w), v4 = __uint_as_float(w.x), v5 = __uint_as_float(w.y), v6 = __uint_as_float(w.z), v7 = __uint_as_float(w.w);
                        ss += (v0 * v0 + v1 * v1 + v2 * v2 + v3 * v3) + (v4 * v4 + v5 * v5 + v6 * v6 + v7 * v7);
                        u4 o; o.x = cvtpk(v0, v1); o.y = cvtpk(v2, v3); o.z = cvtpk(v4, v5); o.w = cvtpk(v6, v7); gst16(rxb + (long)t * 1024 + i * 512 + rlane * 8, o); }
#pragma unroll
                    for (int m = 1; m < 64; m <<= 1) ss += __shfl_xor(ss, m);
                    if (rlane == 0) rss[t] = ss; }
                rt += 4 * rstep;
            }
#pragma unroll
            for (int u = 0; u < 6; ++u) if (t0 + u < O8) p0_tile(a, t0 + u, u, 1, rg[u]);
            __syncthreads();
        }
        for (; rt < T_; rt += rstep) rowstat_token(rx, rxb, rss, rt, rlane);
    }
    const int gtid = blockIdx.x * 512 + threadIdx.x, gsz = gridDim.x * 512;
    for (int i = blockIdx.x * 8 + (threadIdx.x >> 6); i < L_ * 2 * 128; i += gridDim.x * 8) {
        const int lw = i >> 7, f = i & 127, ln = threadIdx.x & 63; const float* pos = a.in[9] + (long)lw * 2048; const float* w1 = a.in[10] + (long)lw * 2048 * 128;
        float s = 0.f;
#pragma unroll 8
        for (int k = ln; k < 2048; k += 64) s += gldf(pos + k) * gldf(w1 + (long)k * 128 + f);
#pragma unroll
        for (int mk = 32; mk >= 1; mk >>= 1) s += __shfl_xor(s, mk);
        if (ln == 0) ((float*)(ws + W_B1))[i] = s;
    }
    for (int i = gtid; i < L_ * 48 * 1024; i += gsz) {
        const int l = i / 49152, r = i % 49152, j = r >> 10, k = r & 1023;
        float v = 0.f; if (j < 4) v = gldf(a.in[21] + (long)l * 4096 + k * 4 + j); else if (j < 36) v = gldf(a.in[23] + (long)l * 32768 + k * 32 + (j - 4));
        const float vv = v * gldf(a.in[20] + l * 1024 + k);
        const unsigned hb = cvtpk(vv, 0.f) & 0xffffu; const unsigned lb = cvtpk(vv - __uint_as_float(hb << 16), 0.f) & 0xffffu;
        *(GAS bf16_t*)((bf16_t*)(ws + W_R) + ((long)(l * 2 + 0) * 48 + j) * 1024 + k) = (bf16_t)hb; *(GAS bf16_t*)((bf16_t*)(ws + W_R) + ((long)(l * 2 + 1) * 48 + j) * 1024 + k) = (bf16_t)lb;
    }
    for (int i = gtid; i < L_; i += gsz) {
        float gq = 0.f, gk = 0.f; for (int j = 0; j < 96; ++j) { gq = __builtin_fmaxf(gq, __builtin_fabsf(gldf(a.in[16] + i * 96 + j))); gk = __builtin_fmaxf(gk, __builtin_fabsf(gldf(a.in[17] + i * 96 + j))); }
        ((float*)(ws + W_MLAB))[i] = 96.f * gq * gk * (0.10206207261596577f * LOG2E) * 1.02f + 0.1f; }
    for (int i = gtid; i < 8 * 1024; i += gsz) { const int h = i >> 10, d = i & 1023; ((float*)(ws + W_LUT))[i] = gldf(a.in[1] + t5_bucket(d) * 8 + h) * LOG2E; }
    for (int i = gtid; i < S_ * 16; i += gsz) { const int s = i >> 4, f = i & 15;
        const float ang = (float)s * c_invf[f]; double rev = (double)ang * 0.15915494309189535; rev -= __builtin_rint(rev);
        const float rv = (float)rev; ((float*)(ws + W_ROPE))[2 * i] = __builtin_amdgcn_cosf(rv); ((float*)(ws + W_ROPE))[2 * i + 1] = __builtin_amdgcn_sinf(rv); }
}


#define GLDS16(gp, ldsoff) __builtin_amdgcn_global_load_lds((const unsigned*)(gp), (unsigned*)(smem + (ldsoff)), 16, 0, 0)
template <class P, int TM, class = void> struct GemmPre { struct type {}; static constexpr bool on = false; };
template <class P, int TM> struct GemmPre<P, TM, decltype((void)sizeof(typename P::template Pre<TM>))> { typedef typename P::template Pre<TM> type; static constexpr bool on = true; };
template <int TM, int WN, class P>
DEV void gemm_tile(const P& p, int m0, int n0, int mrows) {
    constexpr int WM = 8 / WN, BM = 32 * TM * WM, BN = 64 * WN, STG = (BM + BN) * 128, NA = BM / 64, NB = BN / 64;
    const int tid = threadIdx.x, lane = tid & 63, wid = tid >> 6, wm = wid / WN, wn = wid % WN, l31 = lane & 31, hi = lane >> 5;
    typename GemmPre<P, TM>::type pre;
    if constexpr (GemmPre<P, TM>::on) p.template pre1<TM>(pre, m0, n0, mrows, wm, wn, lane);
    const bf16_t* ap[NA]; long bo[NB];
#pragma unroll
    for (int i = 0; i < NA; ++i) { const int row = (tid + 512 * i) >> 3, pc = tid & 7; const int rr = row < mrows ? row : mrows - 1;
        ap[i] = p.a_row(m0 + rr) + ((pc ^ ((row >> 1) & 7)) << 3); }
#pragma unroll
    for (int i = 0; i < NB; ++i) { const int n = (tid + 512 * i) >> 3, pc = tid & 7; bo[i] = (long)(n0 + n) * p.ldb() + ((pc ^ ((n >> 1) & 7)) << 3); }
    unsigned rab[TM], rasw[TM], rbb[2], rbsw[2];
#pragma unroll
    for (int i = 0; i < TM; ++i) { const int row = wm * 32 * TM + i * 32 + l31; rab[i] = row * 128; rasw[i] = (row >> 1) & 7; }
#pragma unroll
    for (int j = 0; j < 2; ++j) { const int n = wn * 64 + j * 32 + l31; rbb[j] = BM * 128 + n * 128; rbsw[j] = (n >> 1) & 7; }
    f32x16 acc[TM][2];
#pragma unroll
    for (int i = 0; i < TM; ++i) { acc[i][0] = f32x16{}; acc[i][1] = f32x16{}; }
    const int nk = p.nk(); const long aks = p.a_kstride();
    {   const bf16_t* bb = p.b_base(0);
#pragma unroll
        for (int i = 0; i < NA; ++i) GLDS16(ap[i], LDS_PH + (tid + 512 * i) * 16);
#pragma unroll
        for (int i = 0; i < NB; ++i) GLDS16(bb + bo[i], LDS_PH + BM * 128 + (tid + 512 * i) * 16);
    }
    if constexpr (GemmPre<P, TM>::on) p.template pre2<TM>(pre, m0, n0, mrows, wm, wn, lane);
    __syncthreads();
    for (int kt = 0; kt < nk; ++kt) {
        const unsigned cur = LDS_PH + (kt & 1) * STG, nxt = LDS_PH + ((kt + 1) & 1) * STG;
        if (kt + 1 < nk) { const bf16_t* bb = p.b_base(kt + 1);
#pragma unroll
            for (int i = 0; i < NA; ++i) GLDS16(ap[i] + (long)(kt + 1) * aks, nxt + (tid + 512 * i) * 16);
#pragma unroll
            for (int i = 0; i < NB; ++i) GLDS16(bb + bo[i], nxt + BM * 128 + (tid + 512 * i) * 16); }
        bf16x8 af[2][TM], bf[2][2];
#pragma unroll
        for (int i = 0; i < TM; ++i) af[0][i] = LDS_BF8(cur + rab[i] + (((0 + hi) ^ rasw[i]) << 4));
#pragma unroll
        for (int j = 0; j < 2; ++j) bf[0][j] = LDS_BF8(cur + rbb[j] + (((0 + hi) ^ rbsw[j]) << 4));
#pragma unroll
        for (int ks = 0; ks < 4; ++ks) {
            if (ks < 3) {
#pragma unroll
                for (int i = 0; i < TM; ++i) af[(ks + 1) & 1][i] = LDS_BF8(cur + rab[i] + (((2 * (ks + 1) + hi) ^ rasw[i]) << 4));
#pragma unroll
                for (int j = 0; j < 2; ++j) bf[(ks + 1) & 1][j] = LDS_BF8(cur + rbb[j] + (((2 * (ks + 1) + hi) ^ rbsw[j]) << 4));
                __builtin_amdgcn_sched_barrier(0);
            }
#pragma unroll
            for (int i = 0; i < TM; ++i)
#pragma unroll
                for (int j = 0; j < 2; ++j) acc[i][j] = MFMA32(bf[ks & 1][j], af[ks & 1][i], acc[i][j]);
            __builtin_amdgcn_sched_barrier(0);
        }
        __syncthreads();
    }
    if constexpr (GemmPre<P, TM>::on) p.template epi<TM>(acc, m0, n0, mrows, wm, wn, lane, pre); else p.template epi<TM>(acc, m0, n0, mrows, wm, wn, lane);
}
template <int TM, int WN, class P>
DEV void gemm_tile3(const P& p, int m0, int n0, int mrows) {
    constexpr int WM = 8 / WN, BM = 32 * TM * WM, BN = 64 * WN, STG = (BM + BN) * 128, NA = BM / 64, NB = BN / 64;
    const int tid = threadIdx.x, lane = tid & 63, wid = tid >> 6, wm = wid / WN, wn = wid % WN, l31 = lane & 31, hi = lane >> 5;
    typename GemmPre<P, TM>::type pre;
    if constexpr (GemmPre<P, TM>::on) p.template pre1<TM>(pre, m0, n0, mrows, wm, wn, lane);
    const bf16_t* ap[NA]; long bo[NB];
#pragma unroll
    for (int i = 0; i < NA; ++i) { const int row = (tid + 512 * i) >> 3, pc = tid & 7; const int rr = row < mrows ? row : mrows - 1;
        ap[i] = p.a_row(m0 + rr) + ((pc ^ ((row >> 1) & 7)) << 3); }
#pragma unroll
    for (int i = 0; i < NB; ++i) { const int n = (tid + 512 * i) >> 3, pc = tid & 7; bo[i] = (long)(n0 + n) * p.ldb() + ((pc ^ ((n >> 1) & 7)) << 3); }
    unsigned rab[TM], rasw[TM], rbb[2], rbsw[2];
#pragma unroll
    for (int i = 0; i < TM; ++i) { const int row = wm * 32 * TM + i * 32 + l31; rab[i] = row * 128; rasw[i] = (row >> 1) & 7; }
#pragma unroll
    for (int j = 0; j < 2; ++j) { const int n = wn * 64 + j * 32 + l31; rbb[j] = BM * 128 + n * 128; rbsw[j] = (n >> 1) & 7; }
    f32x16 acc[TM][2];
#pragma unroll
    for (int i = 0; i < TM; ++i) { acc[i][0] = f32x16{}; acc[i][1] = f32x16{}; }
    const int nk = p.nk(); const long aks = p.a_kstride();
    static_assert(NA + NB == 6, "counted waits below assume 6 LDS-DMA instructions per thread and stage");
#pragma unroll
    for (int st = 0; st < 2; ++st) { const bf16_t* bb = p.b_base(st);
#pragma unroll
        for (int i = 0; i < NA; ++i) GLDS16(ap[i] + (long)st * aks, LDS_PH + st * STG + (tid + 512 * i) * 16);
#pragma unroll
        for (int i = 0; i < NB; ++i) GLDS16(bb + bo[i], LDS_PH + st * STG + BM * 128 + (tid + 512 * i) * 16);
    }
    asm volatile("s_waitcnt vmcnt(6)" ::: "memory");
    if constexpr (GemmPre<P, TM>::on) p.template pre2<TM>(pre, m0, n0, mrows, wm, wn, lane);
    __builtin_amdgcn_s_barrier();
    int cs = 0;
    for (int kt = 0; kt < nk; ++kt) {
        const unsigned cur = LDS_PH + cs * STG; const int ns = cs >= 1 ? cs - 1 : 2;
        const unsigned nxt = LDS_PH + ns * STG;
        if (kt + 2 < nk) { const bf16_t* bb = p.b_base(kt + 2);
#pragma unroll
            for (int i = 0; i < NA; ++i) GLDS16(ap[i] + (long)(kt + 2) * aks, nxt + (tid + 512 * i) * 16);
#pragma unroll
            for (int i = 0; i < NB; ++i) GLDS16(bb + bo[i], nxt + BM * 128 + (tid + 512 * i) * 16); }
        bf16x8 af[2][TM], bf[2][2];
#pragma unroll
        for (int i = 0; i < TM; ++i) af[0][i] = LDS_BF8(cur + rab[i] + (((0 + hi) ^ rasw[i]) << 4));
#pragma unroll
        for (int j = 0; j < 2; ++j) bf[0][j] = LDS_BF8(cur + rbb[j] + (((0 + hi) ^ rbsw[j]) << 4));
#pragma unroll
        for (int ks = 0; ks < 4; ++ks) {
            if (ks < 3) {
#pragma unroll
                for (int i = 0; i < TM; ++i) af[(ks + 1) & 1][i] = LDS_BF8(cur + rab[i] + (((2 * (ks + 1) + hi) ^ rasw[i]) << 4));
#pragma unroll
                for (int j = 0; j < 2; ++j) bf[(ks + 1) & 1][j] = LDS_BF8(cur + rbb[j] + (((2 * (ks + 1) + hi) ^ rbsw[j]) << 4));
                __builtin_amdgcn_sched_barrier(0);
            }
#pragma unroll
            for (int i = 0; i < TM; ++i)
#pragma unroll
                for (int j = 0; j < 2; ++j) acc[i][j] = MFMA32(bf[ks & 1][j], af[ks & 1][i], acc[i][j]);
            __builtin_amdgcn_sched_barrier(0);
        }
        if (kt + 2 < nk) asm volatile("s_waitcnt vmcnt(6) lgkmcnt(0)" ::: "memory"); else asm volatile("s_waitcnt vmcnt(0) lgkmcnt(0)" ::: "memory");
        __builtin_amdgcn_s_barrier();
        cs = cs == 2 ? 0 : cs + 1;
    }
    __syncthreads();
    if constexpr (GemmPre<P, TM>::on) p.template epi<TM>(acc, m0, n0, mrows, wm, wn, lane, pre); else p.template epi<TM>(acc, m0, n0, mrows, wm, wn, lane);
}
#define EPI_M(TM, i) (wm * 32 * TM + (i) * 32 + (lane & 31))
#define EPI_NB(j, q) (wn * 64 + (j) * 32 + 8 * (q) + 4 * (lane >> 5))
#define EPI_JQ _Pragma("unroll") for (int j = 0; j < 2; ++j) _Pragma("unroll") for (int q = 0; q < 4; ++q)
DEV u2 pack4(float a, float b, float c, float d) { u2 o; o.x = cvtpk(a, b); o.y = cvtpk(c, d); return o; }
DEV u4 pair_swap(u2 a, u2 b) { auto r = __builtin_amdgcn_permlane32_swap(a.x, b.x, false, false); auto t = __builtin_amdgcn_permlane32_swap(a.y, b.y, false, false);
    u4 w; w.x = r[0]; w.y = t[0]; w.z = r[1]; w.w = t[1]; return w; }
DEV void pair_unswap(u4 w, u2& a, u2& b) { auto r = __builtin_amdgcn_permlane32_swap(w.x, w.z, false, false); auto t = __builtin_amdgcn_permlane32_swap(w.y, w.w, false, false);
    a.x = r[0]; a.y = t[0]; b.x = r[1]; b.y = t[1]; }
DEV void st_bf16(bf16_t* p, float v) { *(GAS bf16_t*)p = (bf16_t)(cvtpk(v, 0.f) & 0xffffu); }

struct GemmIn {
    const bf16_t* A; const bf16_t* Bt; const float* rstd; bf16_t* C; int nparts;
    DEV const bf16_t* a_row(int r) const { return A + (long)r * 1024; }
    DEV long a_kstride() const { return 64; }
    DEV const bf16_t* b_base(int kt) const { return Bt + kt * 64; }
    DEV long ldb() const { return 1024; }
    DEV int nk() const { return 16; }
    template <int TM> DEV void epi(f32x16 (&acc)[TM][2], int m0, int n0, int mrows, int wm, int wn, int lane) const {
#pragma unroll
        for (int i = 0; i < TM; ++i) { const int row = m0 + EPI_M(TM, i); float sq = gldf(rstd + row); if (nparts == 4) sq = ((sq + gldf(rstd + T_ + row)) + gldf(rstd + 2 * T_ + row)) + gldf(rstd + 3 * T_ + row);
            const float rs = __builtin_amdgcn_rsqf(sq * (1.f / 1024.f) + EPS); bf16_t* cr = C + (long)row * PLD + n0;
            EPI_JQ gst8(cr + EPI_NB(j, q), pack4(acc[i][j][4 * q] * rs, acc[i][j][4 * q + 1] * rs, acc[i][j][4 * q + 2] * rs, acc[i][j][4 * q + 3] * rs)); }
    }
};
struct GemmPlain {
    const bf16_t* A; long lda; const bf16_t* Bt; long ldb_; int nk_; bf16_t* C; long ldc;
    DEV const bf16_t* a_row(int r) const { return A + (long)r * lda; }
    DEV long a_kstride() const { return 64; }
    DEV const bf16_t* b_base(int kt) const { return Bt + kt * 64; }
    DEV long ldb() const { return ldb_; }
    DEV int nk() const { return nk_; }
    template <int TM> DEV void epi(f32x16 (&acc)[TM][2], int m0, int n0, int mrows, int wm, int wn, int lane) const {
#pragma unroll
        for (int i = 0; i < TM; ++i) { bf16_t* cr = C + (long)(m0 + EPI_M(TM, i)) * ldc + n0;
#pragma unroll
            for (int j = 0; j < 2; ++j)
#pragma unroll
                for (int q = 0; q < 4; q += 2)
                    gst16(cr + wn * 64 + j * 32 + 8 * q + 8 * (lane >> 5), pair_swap(pack4(acc[i][j][4 * q], acc[i][j][4 * q + 1], acc[i][j][4 * q + 2], acc[i][j][4 * q + 3]),
                                                                                          pack4(acc[i][j][4 * q + 4], acc[i][j][4 * q + 5], acc[i][j][4 * q + 6], acc[i][j][4 * q + 7]))); }
    }
};
template <class MK> DEV void gemm_smallk_run(const MK& mk, int tfirst, int tstep, int tend) {
    constexpr int TM = 2, WN = 2, BM = 256, BN = 128, STG = (BM + BN) * 128, NA = BM / 64, NB = BN / 64;
    const int tid = threadIdx.x, lane = tid & 63, wid = tid >> 6, wm = wid / WN, wn = wid % WN, l31 = lane & 31, hi = lane >> 5;
    if (tfirst >= tend) return;
    unsigned rab[TM], rasw[TM], rbb[2], rbsw[2];
#pragma unroll
    for (int i = 0; i < TM; ++i) { const int row = wm * 32 * TM + i * 32 + l31; rab[i] = row * 128; rasw[i] = (row >> 1) & 7; }
#pragma unroll
    for (int j = 0; j < 2; ++j) { const int n = wn * 64 + j * 32 + l31; rbb[j] = BM * 128 + n * 128; rbsw[j] = (n >> 1) & 7; }
#define SMK_ISSUE(T) do { GemmPlain q_; int qm_, qn_; mk((T), q_, qm_, qn_); \
        for (int kt_ = 0; kt_ < q_.nk_; ++kt_) { \
            _Pragma("unroll") for (int i = 0; i < NA; ++i) { const int row = (tid + 512 * i) >> 3, pc = tid & 7; GLDS16(q_.A + (long)(qm_ + row) * q_.lda + kt_ * 64 + ((pc ^ ((row >> 1) & 7)) << 3), LDS_PH + kt_ * STG + (tid + 512 * i) * 16); } \
            _Pragma("unroll") for (int i = 0; i < NB; ++i) { const int n = (tid + 512 * i) >> 3, pc = tid & 7; GLDS16(q_.Bt + (long)(qn_ + n) * q_.ldb_ + kt_ * 64 + ((pc ^ ((n >> 1) & 7)) << 3), LDS_PH + kt_ * STG + BM * 128 + (tid + 512 * i) * 16); } } } while (0)
    SMK_ISSUE(tfirst);
    asm volatile("s_waitcnt vmcnt(0)" ::: "memory");
    for (int t = tfirst; t < tend; t += tstep) {
        GemmPlain p; int m0, n0; mk(t, p, m0, n0);
        __builtin_amdgcn_s_barrier();
        f32x16 acc[TM][2];
#pragma unroll
        for (int i = 0; i < TM; ++i) { acc[i][0] = f32x16{}; acc[i][1] = f32x16{}; }
        for (int kt = 0; kt < p.nk_; ++kt) {
            const unsigned cur = LDS_PH + kt * STG;
            bf16x8 af[2][TM], bf[2][2];
#pragma unroll
            for (int i = 0; i < TM; ++i) af[0][i] = LDS_BF8(cur + rab[i] + (((0 + hi) ^ rasw[i]) << 4));
#pragma unroll
            for (int j = 0; j < 2; ++j) bf[0][j] = LDS_BF8(cur + rbb[j] + (((0 + hi) ^ rbsw[j]) << 4));
#pragma unroll
            for (int ks = 0; ks < 4; ++ks) {
                if (ks < 3) {
#pragma unroll
                    for (int i = 0; i < TM; ++i) af[(ks + 1) & 1][i] = LDS_BF8(cur + rab[i] + (((2 * (ks + 1) + hi) ^ rasw[i]) << 4));
#pragma unroll
                    for (int j = 0; j < 2; ++j) bf[(ks + 1) & 1][j] = LDS_BF8(cur + rbb[j] + (((2 * (ks + 1) + hi) ^ rbsw[j]) << 4));
                    __builtin_amdgcn_sched_barrier(0);
                }
#pragma unroll
                for (int i = 0; i < TM; ++i)
#pragma unroll
                    for (int j = 0; j < 2; ++j) acc[i][j] = MFMA32(bf[ks & 1][j], af[ks & 1][i], acc[i][j]);
                __builtin_amdgcn_sched_barrier(0);
            }
        }
        asm volatile("s_waitcnt lgkmcnt(0)" ::: "memory");
        __builtin_amdgcn_s_barrier();
        const bool more = t + tstep < tend;
        if (more) SMK_ISSUE(t + tstep);
        __builtin_amdgcn_sched_barrier(0);
        p.template epi<TM>(acc, m0, n0, 256, wm, wn, lane);
        __builtin_amdgcn_sched_barrier(0);
        if (more) asm volatile("s_waitcnt vmcnt(8)" ::: "memory");
    }
#undef SMK_ISSUE
}
DEV float gelu_tanh(float x) { const float u = 0.7978845608028654f * (x + 0.044715f * x * x * x); const float e = fexp2(u * (2.f * LOG2E)); return 0.5f * x * (2.f - 2.f * frcp(1.f + e)); }
struct GemmCmp1 {
    const bf16_t* Xc; int w; const bf16_t* Bt; const float* bias; bf16_t* H1;
    DEV const bf16_t* a_row(int r) const { const int hk = r & 1, bn = r >> 1, b = bn >> 9; int n = bn & 511; n = n > 510 ? 510 : n;
        return Xc + ((long)(b * S_ + 16 * n) * 4 + w * 2 + hk) * 64; }
    DEV long a_kstride() const { return 256; }
    DEV const bf16_t* b_base(int kt) const { return Bt + kt * 64; }
    DEV long ldb() const { return 2048; }
    DEV int nk() const { return 32; }
    template <int TM> DEV void epi(f32x16 (&acc)[TM][2], int m0, int n0, int mrows, int wm, int wn, int lane) const {
#pragma unroll
        for (int i = 0; i < TM; ++i) { bf16_t* cr = H1 + (long)(m0 + EPI_M(TM, i)) * 128 + n0;
            EPI_JQ { const int nb = EPI_NB(j, q); const u4 bb = gld16(bias + n0 + nb);
                gst8(cr + nb, pack4(gelu_tanh(acc[i][j][4 * q] + __uint_as_float(bb.x)), gelu_tanh(acc[i][j][4 * q + 1] + __uint_as_float(bb.y)),
                                    gelu_tanh(acc[i][j][4 * q + 2] + __uint_as_float(bb.z)), gelu_tanh(acc[i][j][4 * q + 3] + __uint_as_float(bb.w)))); } }
    }
};
struct GemmCmp2 {
    const bf16_t* H1; int w; const bf16_t* Bt; const float* gain; bf16_t* Kimg; bf16_t* Vimg;
    DEV const bf16_t* a_row(int r) const { return H1 + (long)r * 128; }
    DEV long a_kstride() const { return 64; }
    DEV const bf16_t* b_base(int kt) const { return Bt + kt * 64; }
    DEV long ldb() const { return 128; }
    DEV int nk() const { return 2; }
    template <int TM> DEV void epi(f32x16 (&acc)[TM][2], int m0, int n0, int mrows, int wm, int wn, int lane) const {
        if (wn != 0) return;
#pragma unroll
        for (int i = 0; i < TM; ++i) {
            const int row = m0 + EPI_M(TM, i); const int hk = row & 1, bn = row >> 1, b = bn >> 9, n = bn & 511;
            float rs = 1.f;
            if (w == 0) { float ss = 0.f;
#pragma unroll
                for (int r = 0; r < 16; ++r) ss += acc[i][0][r] * acc[i][0][r] + acc[i][1][r] * acc[i][1][r];
                rs = __builtin_amdgcn_rsqf(hsum(ss) * (1.f / 64.f) + EPS); }
            if (n == 511) rs = 0.f;
            const long tb = ((long)(b * 2 + hk) * 8 + (n >> 6)) * 4096; const int key = n & 63;
            EPI_JQ { const int col = j * 32 + 8 * q + 4 * (lane >> 5); float v0 = acc[i][j][4 * q] * rs, v1 = acc[i][j][4 * q + 1] * rs, v2 = acc[i][j][4 * q + 2] * rs, v3 = acc[i][j][4 * q + 3] * rs;
                if (w == 0) { const u4 gg = gld16(gain + col); v0 *= __uint_as_float(gg.x); v1 *= __uint_as_float(gg.y); v2 *= __uint_as_float(gg.z); v3 *= __uint_as_float(gg.w);
                    gst8(Kimg + tb + (col >> 3) * 512 + key * 8 + (col & 7), pack4(v0, v1, v2, v3)); }
                else gst8(Vimg + tb + (col >> 5) * 2048 + key * 32 + (col & 31), pack4(v0, v1, v2, v3)); }
        }
    }
};
struct GemmOut {
    const bf16_t* A; const bf16_t* Bt; const float* xin; float* xout;
    DEV const bf16_t* a_row(int r) const { return A + (long)r * 1024; }
    DEV long a_kstride() const { return 64; }
    DEV const bf16_t* b_base(int kt) const { return Bt + kt * 64; }
    DEV long ldb() const { return 1024; }
    DEV int nk() const { return 16; }
    template <int TM> DEV void epi(f32x16 (&acc)[TM][2], int m0, int n0, int mrows, int wm, int wn, int lane) const {
#pragma unroll
        for (int i = 0; i < TM; ++i) { const long ro = (long)(m0 + EPI_M(TM, i)) * 1024 + n0;
            EPI_JQ { const long o = ro + EPI_NB(j, q); const u4 xi = gld16(xin + o); u4 xo;
                xo.x = __float_as_uint(__uint_as_float(xi.x) + acc[i][j][4 * q]); xo.y = __float_as_uint(__uint_as_float(xi.y) + acc[i][j][4 * q + 1]);
                xo.z = __float_as_uint(__uint_as_float(xi.z) + acc[i][j][4 * q + 2]); xo.w = __float_as_uint(__uint_as_float(xi.w) + acc[i][j][4 * q + 3]); gst16(xout + o, xo); }
            __builtin_amdgcn_sched_barrier(0); }
    }
};
struct GemmMoe1 {
    const bf16_t* xb; const int* list; const bf16_t* Bt; const float* rstd; const float* wslot; bf16_t* abuf;
    DEV const bf16_t* a_row(int r) const { const int e = *(const GAS int*)(list + r); return xb + (long)(e >> 1) * 1024; }
    DEV long a_kstride() const { return 64; }
    DEV const bf16_t* b_base(int kt) const { return Bt + kt * 64; }
    DEV long ldb() const { return 1024; }
    DEV int nk() const { return 16; }
    template <int TM> struct Pre { int ee[TM]; float rsv[TM], cwv[TM]; };
    template <int TM> DEV void pre1(Pre<TM>& pr, int m0, int n0, int mrows, int wm, int wn, int lane) const {
        if constexpr (TM <= 2) {
#pragma unroll
        for (int i = 0; i < TM; ++i) { const int lr = EPI_M(TM, i); pr.ee[i] = *(const GAS int*)(list + m0 + (lr < mrows ? lr : 0)); } } }
    template <int TM> DEV void pre2(Pre<TM>& pr, int m0, int n0, int mrows, int wm, int wn, int lane) const {
        if constexpr (TM <= 2) {
#pragma unroll
        for (int i = 0; i < TM; ++i) { pr.rsv[i] = gldf(rstd + (pr.ee[i] >> 1)); pr.cwv[i] = gldf(wslot + pr.ee[i]); } } }
    template <int TM> DEV void epi(f32x16 (&acc)[TM][2], int m0, int n0, int mrows, int wm, int wn, int lane, const Pre<TM>& pr0) const {
        const int hid0 = 32 * ((n0 >> 6) + wn) + 4 * (lane >> 5);
        Pre<TM> pr = pr0;
        if constexpr (TM > 2) {
#pragma unroll
            for (int i = 0; i < TM; ++i) { const int lr = EPI_M(TM, i); pr.ee[i] = *(const GAS int*)(list + m0 + (lr < mrows ? lr : 0)); }
#pragma unroll
            for (int i = 0; i < TM; ++i) { pr.rsv[i] = gldf(rstd + (pr.ee[i] >> 1)); pr.cwv[i] = gldf(wslot + pr.ee[i]); } }
#pragma unroll
        for (int i = 0; i < TM; ++i) { const int lr = EPI_M(TM, i);
            if (lr < mrows) { const int e = pr.ee[i]; const float rs = pr.rsv[i], cw = pr.cwv[i]; bf16_t* ar = abuf + (long)e * 256 + hid0;
                u2 pk[4];
#pragma unroll
                for (int q = 0; q < 4; ++q) { float o[4];
#pragma unroll
                    for (int k = 0; k < 4; ++k) { const float g = acc[i][0][4 * q + k] * rs, u = acc[i][1][4 * q + k] * rs; o[k] = g * frcp(1.f + fexp2(-g * LOG2E)) * u * cw; }
                    pk[q] = pack4(o[0], o[1], o[2], o[3]); }
                gst16(ar + 4 * (lane >> 5), pair_swap(pk[0], pk[1])); gst16(ar + 16 + 4 * (lane >> 5), pair_swap(pk[2], pk[3])); } }
    }
};
struct GemmMoe2 {
    const bf16_t* abuf; const int* list; const bf16_t* B0; const bf16_t* B1; bf16_t* xb; float* xout; float* ssq_out;
    DEV const bf16_t* a_row(int r) const { return abuf + (long)(*(const GAS int*)(list + r)) * 512; }
    DEV long a_kstride() const { return 64; }
    DEV const bf16_t* b_base(int kt) const { return kt < 4 ? B0 + kt * 64 : B1 + (kt - 4) * 64; }
    DEV long ldb() const { return 256; }
    DEV int nk() const { return 8; }
    template <int TM> struct Pre { int tok[TM]; u4 xw[TM][2][2]; };
    template <int TM> DEV void pre1(Pre<TM>& pr, int m0, int n0, int mrows, int wm, int wn, int lane) const {
#pragma unroll
        for (int i = 0; i < TM; ++i) { const int lr = EPI_M(TM, i); pr.tok[i] = *(const GAS int*)(list + m0 + (lr < mrows ? lr : 0)); } }
    template <int TM> DEV void pre2(Pre<TM>& pr, int m0, int n0, int mrows, int wm, int wn, int lane) const {
#pragma unroll
        for (int i = 0; i < TM; ++i) { const long ro = (long)pr.tok[i] * 1024 + n0;
#pragma unroll
            for (int j = 0; j < 2; ++j)
#pragma unroll
                for (int qp = 0; qp < 2; ++qp) pr.xw[i][j][qp] = gld16(xb + ro + wn * 64 + j * 32 + 16 * qp + 8 * (lane >> 5)); } }
    template <int TM> DEV void epi(f32x16 (&acc)[TM][2], int m0, int n0, int mrows, int wm, int wn, int lane, const Pre<TM>& pr) const {
#pragma unroll
        for (int i = 0; i < TM; ++i) { const int lr = EPI_M(TM, i); const bool ok = lr < mrows; float ss = 0.f;
            if (ok) { const long ro = (long)pr.tok[i] * 1024 + n0;
#pragma unroll
                for (int j = 0; j < 2; ++j)
#pragma unroll
                    for (int qp = 0; qp < 2; ++qp) {
                        u2 rr[2]; pair_unswap(pr.xw[i][j][qp], rr[0], rr[1]); u2 pk[2];
#pragma unroll
                        for (int h = 0; h < 2; ++h) { const int q = 2 * qp + h; const u2 r = rr[h];
                            const float y0 = __uint_as_float(r.x << 16) + acc[i][j][4 * q], y1 = __uint_as_float(r.x & 0xffff0000u) + acc[i][j][4 * q + 1], y2 = __uint_as_float(r.y << 16) + acc[i][j][4 * q + 2], y3 = __uint_as_float(r.y & 0xffff0000u) + acc[i][j][4 * q + 3];
                            if (xout) { u4 xo; xo.x = __float_as_uint(y0); xo.y = __float_as_uint(y1); xo.z = __float_as_uint(y2); xo.w = __float_as_uint(y3); gst16(xout + ro + EPI_NB(j, q), xo); }
                            else { pk[h] = pack4(y0, y1, y2, y3); ss += y0 * y0 + y1 * y1 + y2 * y2 + y3 * y3; } }
                        if (!xout) gst16(xb + ro + wn * 64 + j * 32 + 16 * qp + 8 * (lane >> 5), pair_swap(pk[0], pk[1])); } }
            if (!xout) { ss = hsum(ss); if (lane < 32) LDS_F(LDS_EPI + (lr * 4 + wn) * 4) = ok ? ss : 0.f; } }
        if (!xout) {
            __syncthreads();
            const int t = threadIdx.x;
            if (t < 32 * TM * 2 && t < mrows) { const u4 pv = LDS_U4(LDS_EPI + t * 16); const int tok = *(const GAS int*)(list + m0 + t);
                *(GAS float*)(ssq_out + (long)(n0 >> 8) * T_ + tok) = (__uint_as_float(pv.x) + __uint_as_float(pv.y)) + (__uint_as_float(pv.z) + __uint_as_float(pv.w)); }
            __syncthreads();
        }
    }
};

namespace pg8 {
#define PG8_LAS __attribute__((address_space(3)))
typedef unsigned short bf16_t;
typedef short bf16x8 __attribute__((ext_vector_type(8)));
typedef float f32x4 __attribute__((ext_vector_type(4)));
typedef unsigned u32x4 __attribute__((ext_vector_type(4)));
constexpr int BM = 256, BK = 64, HALF = 128, HTB = HALF * BK * 2  , STAGE_BYTES = 8 * HTB, NXCD = 8, WGM = 8;

__host__ __device__ __forceinline__ int lds_byte(int r, int c) { const int st = (r >> 4) * 2 + (c >> 5), rr = r & 15, cc = c & 31, ob = rr * 64 + cc * 2; return st * 1024 + (ob ^ (((ob >> 9) & 1) << 5)); }
__host__ __device__ __forceinline__ void stage_rc(int b, int& R, int& C) { const int st = b / 1024, sb = b % 1024, swz = sb ^ (((sb >> 9) & 1) << 5); R = (st >> 1) * 16 + swz / 64; C = (st & 1) * 32 + (swz % 64) / 2; }
__host__ __device__ __forceinline__ int perm32(int rho) { const int n = rho >> 4, i = rho & 15; return 8 * (i >> 2) + 4 * n + (i & 3); }

struct Unit { int pm, pn; };
struct Gemm { const bf16_t* A; const bf16_t* Bt; int M, N, K; };

struct StaticOrder {
    int nM, nN, nwg, G, c;
    __host__ __device__ void init(int M, int N, int G_, int c_) { nM = M / BM; nN = N / BM; nwg = nM * nN; G = G_; c = c_; }
    __host__ __device__ bool next(int i, Unit& u) const {
        const long L = (long)i * G + c; if (L >= nwg) return false;
        int wgid = (int)L; { const int q = nwg / NXCD, r = nwg % NXCD, xcd = wgid % NXCD, off = wgid / NXCD; wgid = (xcd < r ? xcd * (q + 1) : r * (q + 1) + (xcd - r) * q) + off; }
        const int nig = WGM * nN, gid = wgid / nig, fm = gid * WGM, gsz = (nM - fm) < WGM ? (nM - fm) : WGM;
        u.pm = fm + ((wgid % nig) % gsz); u.pn = (wgid % nig) / gsz; return true;
    }
    __device__ __forceinline__ void a_ready(const Unit&) const {}
    __device__ __forceinline__ void done(const Unit&) const {}
};
__device__ __forceinline__ unsigned cvt_pk_bf16(float lo, float hi) { unsigned r; asm volatile("v_cvt_pk_bf16_f32 %0, %1, %2" : "=v"(r) : "v"(lo), "v"(hi)); return r; }

struct EpiProj {
    static constexpr bool PERM = true, AFTER_DRAIN = false;
    bf16_t* O; int ldc; int ncols; const float* ssq; int nparts; int T;
    __device__ __forceinline__ void operator()(const f32x4 (&acc)[2][2][4][2], const Unit& u, int wr, int wc, int fr, int fq) const {
        const int row0 = u.pm * BM + wr * 64 + fr, col0 = u.pn * BM + wc * 32 + 8 * fq;
        float rs[2][4];
#pragma unroll
        for (int ai = 0; ai < 2; ++ai)
#pragma unroll
            for (int m = 0; m < 4; ++m) { const int row = row0 + ai * HALF + m * 16; float sq = ssq[row]; if (nparts == 4) sq = ((sq + ssq[T + row]) + ssq[2 * T + row]) + ssq[3 * T + row]; rs[ai][m] = sq; }
#pragma unroll
        for (int ai = 0; ai < 2; ++ai)
#pragma unroll
            for (int m = 0; m < 4; ++m) rs[ai][m] = __builtin_amdgcn_rsqf(rs[ai][m] * (1.f / 1024.f) + 1e-6f);
#pragma unroll
        for (int bj = 0; bj < 2; ++bj) {
            if (u.pn * BM + bj * HALF >= ncols) continue;
#pragma unroll
            for (int ai = 0; ai < 2; ++ai)
#pragma unroll
                for (int m = 0; m < 4; ++m) { bf16_t* rowp = O + (size_t)(row0 + ai * HALF + m * 16) * ldc + col0 + bj * HALF; const f32x4 v0 = acc[ai][bj][m][0] * rs[ai][m], v1 = acc[ai][bj][m][1] * rs[ai][m];
                    u32x4 w; w.x = cvt_pk_bf16(v0[0], v0[1]); w.y = cvt_pk_bf16(v0[2], v0[3]); w.z = cvt_pk_bf16(v1[0], v1[1]); w.w = cvt_pk_bf16(v1[2], v1[3]); *(u32x4*)rowp = w; }
        }
    }
};
struct EpiResid {
    static constexpr bool PERM = true, AFTER_DRAIN = false;
    bf16_t* xb; int ldc;
    __device__ __forceinline__ void operator()(const f32x4 (&acc)[2][2][4][2], const Unit& u, int wr, int wc, int fr, int fq) const {
        const int row0 = u.pm * BM + wr * 64 + fr, col0 = u.pn * BM + wc * 32 + 8 * fq;
        u4 xr[2][4][2];
#pragma unroll
        for (int ai = 0; ai < 2; ++ai)
#pragma unroll
            for (int m = 0; m < 4; ++m) { const size_t ro = (size_t)(row0 + ai * HALF + m * 16) * ldc + col0;
#pragma unroll
                for (int bj = 0; bj < 2; ++bj) xr[ai][m][bj] = gld16(xb + ro + bj * HALF); }
#pragma unroll
        for (int ai = 0; ai < 2; ++ai)
#pragma unroll
            for (int m = 0; m < 4; ++m) { const size_t ro = (size_t)(row0 + ai * HALF + m * 16) * ldc + col0;
#pragma unroll
                for (int bj = 0; bj < 2; ++bj) { const u4 r = xr[ai][m][bj]; const f32x4 a0 = acc[ai][bj][m][0], a1 = acc[ai][bj][m][1]; u4 w;
                    w.x = cvt_pk_bf16(__uint_as_float(r.x << 16) + a0[0], __uint_as_float(r.x & 0xffff0000u) + a0[1]); w.y = cvt_pk_bf16(__uint_as_float(r.y << 16) + a0[2], __uint_as_float(r.y & 0xffff0000u) + a0[3]);
                    w.z = cvt_pk_bf16(__uint_as_float(r.z << 16) + a1[0], __uint_as_float(r.z & 0xffff0000u) + a1[1]); w.w = cvt_pk_bf16(__uint_as_float(r.w << 16) + a1[2], __uint_as_float(r.w & 0xffff0000u) + a1[3]);
                    gst16(xb + ro + bj * HALF, w); } }
    }
};

template <class Epi, class Sched, bool ALIGN_EPI = false, bool SP2 = false>
__device__ __forceinline__ void gemm_phase(PG8_LAS unsigned char* lds, const Gemm g, const Sched& S, const Epi& E) {
    const int tid = threadIdx.x, wid = __builtin_amdgcn_readfirstlane(tid >> 6), lane = tid & 63, wr = wid >> 2, wc = wid & 3, fr = lane & 15, fq = lane >> 4;
    const int K = g.K, nt = K / BK;
    unsigned voffA[2], voffB[2];
#pragma unroll
    for (int i = 0; i < 2; ++i) { int R, C; stage_rc(tid * 16 + i * 8192, R, C); const int Rb = Epi::PERM ? ((R & ~31) + perm32(R & 31)) : R;
        voffA[i] = (unsigned)(R * K + C) * 2u; voffB[i] = (unsigned)(Rb * K + C) * 2u; }
    const size_t kstep = (size_t)(BK * 2);
    const size_t hstep = (size_t)HALF * K * 2;
    const size_t tstep = 2 * hstep;
    const unsigned ldsw = (unsigned)wid * 1024u;
    const int aoff = lds_byte(wr * 64 + fr, fq * 8), boff = lds_byte(wc * 32 + fr, fq * 8);
#define PG8_SA(b, h) (((b) * 2 + (h)) * HTB)
#define PG8_SB(b, h) ((4 + (b) * 2 + (h)) * HTB)
#define PG8_STAGE(bufoff, gbase, voff) do { _Pragma("unroll") for (int _i = 0; _i < 2; ++_i) \
        __builtin_amdgcn_global_load_lds((const unsigned*)((const char*)(gbase) + (voff)[_i]), (PG8_LAS unsigned*)(lds + (bufoff) + ldsw + _i * 8192), 16, 0, 0); } while (0)
#define PG8_LDA(dst, b, h) do { _Pragma("unroll") for (int m = 0; m < 4; ++m) _Pragma("unroll") for (int k = 0; k < 2; ++k) dst[m][k] = *(const PG8_LAS bf16x8*)(lds + PG8_SA(b, h) + aoff + m * 2048 + k * 1024); } while (0)
#define PG8_LDB(dst, b, h) do { _Pragma("unroll") for (int n = 0; n < 2; ++n) _Pragma("unroll") for (int k = 0; k < 2; ++k) dst[n][k] = *(const PG8_LAS bf16x8*)(lds + PG8_SB(b, h) + boff + n * 2048 + k * 1024); } while (0)
#define PG8_MMA(ai, bj, At, Bt) do { __builtin_amdgcn_s_setprio(1); _Pragma("unroll") for (int m = 0; m < 4; ++m) _Pragma("unroll") for (int n = 0; n < 2; ++n) _Pragma("unroll") for (int k = 0; k < 2; ++k) \
        acc[ai][bj][m][n] = __builtin_amdgcn_mfma_f32_16x16x32_bf16(Bt[n][k], At[m][k], acc[ai][bj][m][n], 0, 0, 0); __builtin_amdgcn_s_setprio(0); } while (0)
#define PG8_WAIT_V(n) asm volatile("s_waitcnt vmcnt(" #n ")" ::: "memory")
#define PG8_WAIT_L(n) asm volatile("s_waitcnt lgkmcnt(" #n ")" ::: "memory")
#define PG8_BAR __builtin_amdgcn_s_barrier()
#define PG8_SCHED __builtin_amdgcn_sched_barrier(0)
    Unit cur, nxt; int ui = 0;
    if (!S.next(0, cur)) return;
    f32x4 acc[2][2][4][2];
#pragma unroll
    for (int a = 0; a < 2; ++a)
#pragma unroll
        for (int b = 0; b < 2; ++b)
#pragma unroll
            for (int m = 0; m < 4; ++m)
#pragma unroll
                for (int n = 0; n < 2; ++n) acc[a][b][m][n] = (f32x4){0.f, 0.f, 0.f, 0.f};
    bf16x8 At[4][2], B0[2][2], B1[2][2];
    const char* cA = (const char*)g.A + (size_t)cur.pm * tstep; const char* cB = (const char*)g.Bt + (size_t)cur.pn * tstep;
    S.a_ready(cur);
    if constexpr (SP2) {
        PG8_STAGE(PG8_SB(0, 0), cB, voffB); PG8_STAGE(PG8_SB(0, 1), cB + hstep, voffB); PG8_STAGE(PG8_SA(0, 0), cA, voffA); PG8_STAGE(PG8_SA(0, 1), cA + hstep, voffA);
        if (wr == 1) PG8_BAR;
        PG8_WAIT_V(2); PG8_BAR;
        PG8_STAGE(PG8_SB(1, 0), cB + kstep, voffB); PG8_STAGE(PG8_SA(1, 0), cA + kstep, voffA); PG8_STAGE(PG8_SB(1, 1), cB + hstep + kstep, voffB);
        PG8_WAIT_V(6); PG8_BAR;
    } else {
        PG8_STAGE(PG8_SB(0, 0), cB, voffB); PG8_STAGE(PG8_SA(0, 0), cA, voffA); PG8_STAGE(PG8_SB(0, 1), cB + hstep, voffB); PG8_STAGE(PG8_SA(0, 1), cA + hstep, voffA);
        if (wr == 1) PG8_BAR;
        PG8_WAIT_V(4); PG8_BAR;
        PG8_STAGE(PG8_SB(1, 0), cB + kstep, voffB); PG8_STAGE(PG8_SA(1, 0), cA + kstep, voffA); PG8_STAGE(PG8_SB(1, 1), cB + hstep + kstep, voffB);
        PG8_WAIT_V(6); PG8_BAR;
    }
    for (;;) {
        const bool has_next = S.next(ui + 1, nxt);
        const char* nA = has_next ? (const char*)g.A + (size_t)nxt.pm * tstep : cA; const char* nB = has_next ? (const char*)g.Bt + (size_t)nxt.pn * tstep : cB;
        for (int t = 0; t < nt; t += 2) {
            const bool last = (t == nt - 2);
            const char* a1 = cA + (size_t)(t + 1) * kstep;
            const char* a2 = last ? nA : cA + (size_t)(t + 2) * kstep; const char* b2 = last ? nB : cB + (size_t)(t + 2) * kstep;
            const char* a3 = a2 + kstep; const char* b3 = b2 + kstep;
            if (last && has_next) S.a_ready(nxt);
            if constexpr (SP2) {
            PG8_LDB(B0, 0, 0); PG8_LDB(B1, 0, 1); PG8_SCHED; PG8_LDA(At, 0, 0); PG8_STAGE(PG8_SA(1, 1), a1 + hstep, voffA);
            PG8_WAIT_V(8); PG8_WAIT_L(0); PG8_BAR; PG8_MMA(0, 0, At, B0); PG8_MMA(0, 1, At, B1); PG8_BAR; PG8_SCHED;
            PG8_LDA(At, 0, 1); PG8_STAGE(PG8_SB(0, 0), b2, voffB); PG8_STAGE(PG8_SB(0, 1), b2 + hstep, voffB); PG8_STAGE(PG8_SA(0, 0), a2, voffA);
            PG8_WAIT_V(8); PG8_WAIT_L(0); PG8_BAR; PG8_MMA(1, 0, At, B0); PG8_MMA(1, 1, At, B1); PG8_BAR; PG8_SCHED;
            PG8_LDB(B0, 1, 0); PG8_LDB(B1, 1, 1); PG8_SCHED; PG8_LDA(At, 1, 0); PG8_STAGE(PG8_SA(0, 1), a2 + hstep, voffA);
            PG8_WAIT_V(8); PG8_WAIT_L(0); PG8_BAR; PG8_MMA(0, 0, At, B0); PG8_MMA(0, 1, At, B1); PG8_BAR; PG8_SCHED;
            PG8_LDA(At, 1, 1); PG8_STAGE(PG8_SB(1, 0), b3, voffB); PG8_STAGE(PG8_SB(1, 1), b3 + hstep, voffB); PG8_STAGE(PG8_SA(1, 0), a3, voffA);
            PG8_WAIT_V(8); PG8_WAIT_L(0); PG8_BAR; PG8_MMA(1, 0, At, B0); PG8_MMA(1, 1, At, B1); PG8_BAR; PG8_SCHED;
            } else {
            PG8_LDB(B0, 0, 0); PG8_SCHED; PG8_LDA(At, 0, 0); PG8_STAGE(PG8_SA(1, 1), a1 + hstep, voffA);
            PG8_WAIT_L(8); PG8_BAR; PG8_WAIT_L(0); PG8_MMA(0, 0, At, B0); PG8_BAR; PG8_SCHED;
            PG8_LDB(B1, 0, 1); PG8_STAGE(PG8_SB(0, 0), b2, voffB);
            PG8_BAR; PG8_WAIT_L(0); PG8_MMA(0, 1, At, B1); PG8_BAR;
            PG8_LDA(At, 0, 1); PG8_STAGE(PG8_SA(0, 0), a2, voffA);
            PG8_BAR; PG8_WAIT_L(0); PG8_MMA(1, 0, At, B0); PG8_BAR; PG8_SCHED;
            PG8_STAGE(PG8_SB(0, 1), b2 + hstep, voffB);
            PG8_WAIT_V(6); PG8_BAR; PG8_MMA(1, 1, At, B1); PG8_BAR;
            PG8_LDB(B0, 1, 0); PG8_SCHED; PG8_LDA(At, 1, 0); PG8_STAGE(PG8_SA(0, 1), a2 + hstep, voffA);
            PG8_WAIT_L(8); PG8_BAR; PG8_WAIT_L(0); PG8_MMA(0, 0, At, B0); PG8_BAR; PG8_SCHED;
            PG8_LDB(B1, 1, 1); PG8_STAGE(PG8_SB(1, 0), b3, voffB);
            PG8_BAR; PG8_WAIT_L(0); PG8_MMA(0, 1, At, B1); PG8_BAR;
            PG8_LDA(At, 1, 1); PG8_STAGE(PG8_SA(1, 0), a3, voffA);
            PG8_BAR; PG8_WAIT_L(0); PG8_MMA(1, 0, At, B0); PG8_BAR; PG8_SCHED;
            PG8_STAGE(PG8_SB(1, 1), b3 + hstep, voffB);
            PG8_WAIT_V(6); PG8_BAR; PG8_MMA(1, 1, At, B1); PG8_BAR;
            }
        }
        if constexpr (ALIGN_EPI) { if (wr == 0) PG8_BAR; }
        if constexpr (!Epi::AFTER_DRAIN) { E(acc, cur, wr, wc, fr, fq); S.done(cur); }
        if (!has_next) break;
#pragma unroll
        for (int a = 0; a < 2; ++a)
#pragma unroll
            for (int b = 0; b < 2; ++b)
#pragma unroll
                for (int m = 0; m < 4; ++m)
#pragma unroll
                    for (int n = 0; n < 2; ++n) acc[a][b][m][n] = (f32x4){0.f, 0.f, 0.f, 0.f};
        cur = nxt; cA = nA; cB = nB; ++ui;
        if constexpr (ALIGN_EPI) { if (wr == 1) PG8_BAR; }
    }
    PG8_WAIT_V(0);
    if constexpr (!ALIGN_EPI) { if (wr == 0) PG8_BAR; }
    PG8_BAR;
    if constexpr (Epi::AFTER_DRAIN) { E.fused(acc, cur, wr, wc, fr, fq, lds, wid, lane); S.done(cur); }
#undef PG8_SA
#undef PG8_SB
#undef PG8_STAGE
#undef PG8_LDA
#undef PG8_LDB
#undef PG8_MMA
#undef PG8_WAIT_V
#undef PG8_WAIT_L
#undef PG8_BAR
#undef PG8_SCHED
}
}
constexpr int AT_K0 = LDS_PH, AT_K1 = LDS_PH + 12288, AT_V0 = LDS_PH + 24576, AT_V1 = AT_V0 + 8192, AT_LUT = AT_V1 + 8192,
              AT_UN = AT_LUT + 8192, AT_ALIVE = AT_UN + 16, AT_ITEM = AT_ALIVE + 16, AT_IMP = AT_ITEM + 16, AT_END = AT_IMP + 8 * 16 * 129 * 4,
              SB_O = AT_IMP, SB_L = SB_O + 256 * 65 * 4, SB_SM = SB_L + 1024, SB_LIST = SB_SM + 2048, SB_CTR = SB_LIST + 1024, SB_VX = SB_CTR + 16, SB_END = SB_VX + 3 * 8192;
constexpr float NEG_INF = -__builtin_inff();
static_assert(AT_END <= LDS_BYTES && SB_END <= LDS_BYTES, "attention LDS map");

template <int DK> DEV void att_gload(u4& k0, u4& k1, u4& v, const bf16_t* kt, const bf16_t* vt, const int tid__) {
    const int tid = tid__;
    k0 = gld16(kt + tid * 8);
    if (DK == 96) { if (tid < 256) k1 = gld16(kt + (512 + tid) * 8); }
    v = gld16(vt + tid * 8);
}
template <int DK> DEV void att_lstore(const u4& k0, const u4& k1, const u4& v, int buf, const int tid__) {
    const int tid = tid__; const unsigned ks = buf ? AT_K1 : AT_K0, vs = buf ? AT_V1 : AT_V0;
    LDS_U4(ks + tid * 16) = k0;
    if (DK == 96) { if (tid < 256) LDS_U4(ks + (512 + tid) * 16) = k1; }
    LDS_U4(vs + tid * 16) = v;
}
template <int DK> DEV void att_dma(const bf16_t* kt, const bf16_t* vt, int buf, const int tid__) {
    const int tid = tid__; const unsigned ks = AT_K0 + buf * 12288, vs = AT_V0 + buf * 8192;
    GLDS16(kt + tid * 8, ks + tid * 16);
    if (DK == 96) { if (tid < 256) GLDS16(kt + (512 + tid) * 8, ks + (512 + tid) * 16); }
    GLDS16(vt + tid * 8, vs + tid * 16);
}
template <int DK> DEV void att_qk(f32x16& s0, f32x16& s1, int buf, const bf16x8 (&qf)[DK / 16], int lane) {
    const unsigned kb = (buf ? AT_K1 : AT_K0) + (lane >> 5) * 1024 + (lane & 31) * 16;
    s0 = f32x16{}; s1 = f32x16{};
#pragma unroll
    for (int d0 = 0; d0 < DK / 16; ++d0) { const bf16x8 a0 = LDS_BF8(kb + d0 * 2048), a1 = LDS_BF8(kb + d0 * 2048 + 512); s0 = MFMA32(a0, qf[d0], s0); s1 = MFMA32(a1, qf[d0], s1); }
}
#define PACK8(p, sp) __builtin_bit_cast(bf16x8, (u4){cvtpk((p)[8 * (sp) + 0], (p)[8 * (sp) + 1]), cvtpk((p)[8 * (sp) + 2], (p)[8 * (sp) + 3]), cvtpk((p)[8 * (sp) + 4], (p)[8 * (sp) + 5]), cvtpk((p)[8 * (sp) + 6], (p)[8 * (sp) + 7])})
DEV bf16x8 att_vfrag(unsigned a) { const s16x4 lo = lds_tr(a), h4 = lds_tr(a + 512); return (bf16x8){lo[0], lo[1], lo[2], lo[3], h4[0], h4[1], h4[2], h4[3]}; }
DEV void att_pv(f32x16& o0, f32x16& o1, int buf, const f32x16& p0, const f32x16& p1, int lane) {
    const unsigned vb = (buf ? AT_V1 : AT_V0) + (4 * (lane >> 5) + ((lane & 15) >> 2)) * 64 + ((lane >> 4) & 1) * 32 + (lane & 3) * 8;
#pragma unroll
    for (int kb = 0; kb < 2; ++kb)
#pragma unroll
        for (int sp = 0; sp < 2; ++sp) {
            const bf16x8 pf = kb ? PACK8(p1, sp) : PACK8(p0, sp); const unsigned a = vb + (32 * kb + 16 * sp) * 64;
            o0 = MFMA32(att_vfrag(a), pf, o0); o1 = MFMA32(att_vfrag(a + 4096), pf, o1);
        }
}
DEV float att_rowmax(const f32x16& p0, const f32x16& p1) {
    float m = __builtin_fmaxf(p0[0], p1[0]);
#pragma unroll
    for (int r = 1; r < 16; ++r) m = __builtin_fmaxf(m, __builtin_fmaxf(p0[r], p1[r]));
    return hmax(m);
}
template <bool BIAS> DEV void att_logits(f32x16& p0, f32x16& p1, int tq, int n0, int kmul, int kadd, int W, float c, int lutoff, bool selbit, int hi) {
#pragma unroll
    for (int r = 0; r < 16; ++r) {
        const int n = n0 + crow(r, hi);
        { const int dist = tq - (kmul * n + kadd); const bool ok = selbit && dist >= 0 && dist < W; float t = p0[r] * c;
          if (BIAS) { const int idx = dist < 0 ? 0 : (dist > 1023 ? 1023 : dist); t += LDS_F(AT_LUT + lutoff + idx * 4); }
          p0[r] = ok ? t : NEG_INF; }
        { const int dist = tq - (kmul * (n + 32) + kadd); const bool ok = selbit && dist >= 0 && dist < W; float t = p1[r] * c;
          if (BIAS) { const int idx = dist < 0 ? 0 : (dist > 1023 ? 1023 : dist); t += LDS_F(AT_LUT + lutoff + idx * 4); }
          p1[r] = ok ? t : NEG_INF; }
    }
}
DEV float att_rowmax_local(const f32x16& p0, const f32x16& p1) {
    float a = __builtin_fmaxf(p0[0], p1[0]), b = __builtin_fmaxf(p0[1], p1[1]);
#pragma unroll
    for (int r = 2; r < 16; r += 2) { a = __builtin_fmaxf(a, __builtin_fmaxf(p0[r], p1[r])); b = __builtin_fmaxf(b, __builtin_fmaxf(p0[r + 1], p1[r + 1])); }
    return __builtin_fmaxf(a, b);
}
typedef float f32x2 __attribute__((ext_vector_type(2)));
#define PAIR(p, k) ((f32x2){(p)[2 * (k)], (p)[2 * (k) + 1]})
#define UNPAIR(p, k, v) do { (p)[2 * (k)] = (v)[0]; (p)[2 * (k) + 1] = (v)[1]; } while (0)
template <bool FAST, bool FIXED = false> DEV void att_softmax(f32x16& p0, f32x16& p1, float& m, float& l, f32x16& o0, f32x16& o1, float c, float off0, bool sb) {
    if constexpr (FIXED) {
        const f32x2 c2 = {c, c}; f32x2 sa = {0.f, 0.f}, sc = {0.f, 0.f};
        if (FAST) { const float off = sb ? off0 - m : NEG_INF; const f32x2 off2 = {off, off};
#pragma unroll
            for (int k = 0; k < 8; ++k) { f32x2 u = PAIR(p0, k) * c2 + off2, v = PAIR(p1, k) * c2 + off2; u[0] = fexp2(u[0]); u[1] = fexp2(u[1]); v[0] = fexp2(v[0]); v[1] = fexp2(v[1]);
                sa += u; sc += v; UNPAIR(p0, k, u); UNPAIR(p1, k, v); }
        } else { const f32x2 mn2 = {m, m};
#pragma unroll
            for (int k = 0; k < 8; ++k) { f32x2 u = PAIR(p0, k) - mn2, v = PAIR(p1, k) - mn2; u[0] = fexp2(u[0]); u[1] = fexp2(u[1]); v[0] = fexp2(v[0]); v[1] = fexp2(v[1]);
                sa += u; sc += v; UNPAIR(p0, k, u); UNPAIR(p1, k, v); }
        }
        sa += sc; l += sa[0] + sa[1];
        return;
    }
    float mx; const f32x2 c2 = {c, c};
    if (FAST) {
        float a, b;
        { const f32x2 t0 = PAIR(p0, 0) * c2, t1 = PAIR(p1, 0) * c2; a = __builtin_fmaxf(t0[0], t0[1]); b = __builtin_fmaxf(t1[0], t1[1]); }
#pragma unroll
        for (int k = 1; k < 8; ++k) { const f32x2 t0 = PAIR(p0, k) * c2, t1 = PAIR(p1, k) * c2; a = __builtin_fmaxf(__builtin_fmaxf(a, t0[0]), t0[1]); b = __builtin_fmaxf(__builtin_fmaxf(b, t1[0]), t1[1]); }
        mx = hmax(__builtin_fmaxf(a, b)); mx = sb ? mx + off0 : NEG_INF;
    } else mx = hmax(att_rowmax_local(p0, p1));
    float mn = __builtin_fmaxf(m, mx);
    if (__any(mx > m + 8.f)) {
    const float al = fexp2(m - mn); l *= al; const f32x2 al2 = {al, al};
#pragma unroll
    for (int k = 0; k < 8; ++k) { const f32x2 x = PAIR(o0, k) * al2, y = PAIR(o1, k) * al2; UNPAIR(o0, k, x); UNPAIR(o1, k, y); }
    m = mn;
    } else mn = m;
    f32x2 sa = {0.f, 0.f}, sc = {0.f, 0.f};
    if (FAST) { const float off = sb ? off0 - mn : NEG_INF; const f32x2 off2 = {off, off};
#pragma unroll
        for (int k = 0; k < 8; ++k) { f32x2 u = PAIR(p0, k) * c2 + off2, v = PAIR(p1, k) * c2 + off2; u[0] = fexp2(u[0]); u[1] = fexp2(u[1]); v[0] = fexp2(v[0]); v[1] = fexp2(v[1]);
            sa += u; sc += v; UNPAIR(p0, k, u); UNPAIR(p1, k, v); }
    } else { const f32x2 mn2 = {mn, mn};
#pragma unroll
        for (int k = 0; k < 8; ++k) { f32x2 u = PAIR(p0, k) - mn2, v = PAIR(p1, k) - mn2; u[0] = fexp2(u[0]); u[1] = fexp2(u[1]); v[0] = fexp2(v[0]); v[1] = fexp2(v[1]);
            sa += u; sc += v; UNPAIR(p0, k, u); UNPAIR(p1, k, v); }
    }
    sa += sc; l += sa[0] + sa[1];
}
DEV int att_next(int j, int thi, bool usemask) {
    if (usemask) { while (j <= thi && !((LDS_U(AT_UN + (j >> 5) * 4) >> (j & 31)) & 1u)) ++j; }
    return j;
}
template <int DK, bool BIAS, bool FAST, bool FIXED = false>
DEV void att_seg(const bf16_t* Kimg, const bf16_t* Vimg, int j0, int j1, int thi, const bf16x8 (&qf)[DK / 16], int tq, int W, float c, int lutoff, float bfar,
                 float& m, float& l, f32x16& o0, f32x16& o1, const int tid__, int& buf, int kmul, int kadd) {
    const int lane = tid__ & 63, hi = lane >> 5;
    for (int j = j0; j <= j1; ++j) {
        if (j < thi) att_dma<DK>(Kimg + (long)(j + 1) * (DK * 64), Vimg + (long)(j + 1) * 4096, buf ^ 1, tid__);
        bool skip = false, wfast = false;
        if (!FAST) { const int wlo = __builtin_amdgcn_readlane(tq, 0), whi = __builtin_amdgcn_readlane(tq, 31);
            const int pmin = kmul * (64 * j) + kadd, pmax = kmul * (64 * j + 63) + kadd;
            skip = pmin > whi || wlo - pmax >= W;
            if (!BIAS) wfast = pmax <= wlo && whi - pmin < W; }
        if (!skip) {
        f32x16 p0, p1;
        att_qk<DK>(p0, p1, buf, qf, lane);
        if (FAST || wfast) att_softmax<true, FIXED>(p0, p1, m, l, o0, o1, c, bfar, true);
        else { int tq_ = tq, hi_ = hi; asm volatile("" : "+v"(tq_), "+v"(hi_));
               att_logits<BIAS>(p0, p1, tq_, 64 * j, kmul, kadd, W, c, lutoff, true, hi_); att_softmax<false, FIXED>(p0, p1, m, l, o0, o1, c, 0.f, true); }
        att_pv(o0, o1, buf, p0, p1, lane);
        }
        __syncthreads();
        buf ^= 1;
    }
}
template <int DK, bool BIAS, bool SEL, bool FASTB = false, bool FIXED = false>
DEV void att_run(const bf16_t* Kimg, const bf16_t* Vimg, int tlo, int thi, const bf16x8 (&qf)[DK / 16], int tq, int W, float c, int lutoff,
                 const unsigned (&sw)[4], float& m, float& l, f32x16& o0, f32x16& o1, const int tid__, int q0, int qspan, int kmul = 1, int kadd = 0) {
    static_assert(!SEL, "mask-driven tile walks are handled by the compacted selected branch");
    if (tlo > thi) return;
    int buf = 0;
    att_dma<DK>(Kimg + (long)tlo * (DK * 64), Vimg + (long)tlo * 4096, 0, tid__);
    const float bfar = BIAS ? LDS_F(AT_LUT + lutoff + 1023 * 4) : 0.f;
    __syncthreads();
    int jf = tlo - 1;
    if ((!BIAS || FASTB) && W == (1 << 30)) { const int thr = BIAS ? 790 : 0; const int num = q0 - thr - kadd - 63 * kmul;
        if (num >= 0) { jf = num / (64 * kmul); jf = jf > thi ? thi : jf; } }
    if (!BIAS || FASTB) att_seg<DK, BIAS, true, FIXED>(Kimg, Vimg, tlo, jf, thi, qf, tq, W, c, lutoff, bfar, m, l, o0, o1, tid__, buf, kmul, kadd);
    att_seg<DK, BIAS, false, FIXED>(Kimg, Vimg, jf + 1 > tlo ? jf + 1 : tlo, thi, thi, qf, tq, W, c, lutoff, bfar, m, l, o0, o1, tid__, buf, kmul, kadd);
}
DEV void att_store_out(bf16_t* orow, const f32x16& o0, const f32x16& o1, int hi) {
#pragma unroll
    for (int a = 0; a < 4; a += 2) {
        gst16(orow + 8 * a + 8 * hi, pair_swap(pack4(o0[4 * a], o0[4 * a + 1], o0[4 * a + 2], o0[4 * a + 3]), pack4(o0[4 * a + 4], o0[4 * a + 5], o0[4 * a + 6], o0[4 * a + 7])));
        gst16(orow + 32 + 8 * a + 8 * hi, pair_swap(pack4(o1[4 * a], o1[4 * a + 1], o1[4 * a + 2], o1[4 * a + 3]), pack4(o1[4 * a + 4], o1[4 * a + 5], o1[4 * a + 6], o1[4 * a + 7])));
    }
}
template <int NQ> DEV void att_loadq(bf16x8 (&qf)[NQ], const bf16_t* qrow, int hi) {
#pragma unroll
    for (int d0 = 0; d0 < NQ; ++d0) qf[d0] = __builtin_bit_cast(bf16x8, gld16(qrow + d0 * 16 + hi * 8));
}
DEV void att_load_lut(const float* lut2, const int tid__) {
    LDS_U4(AT_LUT + tid__ * 16) = gld16(lut2 + tid__ * 4);
}

DEV void attn_swa(const int tid__, const Args& a, int l, int b, int hk, int qb) {
    unsigned char* ws = a.ws; const int lane = tid__ & 63, wid = __builtin_amdgcn_readfirstlane(tid__ >> 6), l31 = lane & 31, hi = lane >> 5, g = l31 >> 4;
    const int h = hk * 2 + g, q0 = qb * 128, tq = q0 + 16 * wid + (l31 & 15);
    att_load_lut((const float*)(ws + W_LUT) + (hk * 2) * 1024, tid__);
    bf16x8 qf[4]; att_loadq<4>(qf, (const bf16_t*)(ws + X_QSW) + ((long)(b * 4 + h) * S_ + tq) * 64, hi);
    float m = gldf(a.in[6] + l * 4 + h) * LOG2E, ls = hi ? 0.f : 1.f; f32x16 o0 = f32x16{}, o1 = f32x16{};
    const unsigned sw[4] = {0, 0, 0, 0};
    __syncthreads();
    const int tlo = q0 / 64 - 2 < 0 ? 0 : q0 / 64 - 2;
    att_run<64, true, false>((const bf16_t*)(ws + A_KSW) + (long)(b * 2 + hk) * 128 * 4096, (const bf16_t*)(ws + A_VSW) + (long)(b * 2 + hk) * 128 * 4096,
                             tlo, q0 / 64 + 1, qf, tq, 128, 0.125f * LOG2E, g * 4096, sw, m, ls, o0, o1, tid__, q0, 128);
    const float inv = frcp(hsum(ls));
#pragma unroll
    for (int r = 0; r < 16; ++r) { o0[r] *= inv; o1[r] *= inv; }
    att_store_out((bf16_t*)(ws + P_ORAW) + (long)(b * S_ + tq) * 1024 + 256 + h * 64, o0, o1, hi);
    __syncthreads();
}
DEV void attn_mla(const int tid__, const Args& a, int l, int b, int h, int qb) {
    unsigned char* ws = a.ws; const int lane = tid__ & 63, wid = __builtin_amdgcn_readfirstlane(tid__ >> 6), l31 = lane & 31, hi = lane >> 5;
    const int q0 = qb * 256, tq = q0 + 32 * wid + l31;
    bf16x8 qf[6]; att_loadq<6>(qf, (const bf16_t*)(ws + A_QM) + ((long)(b * 4 + h) * S_ + tq) * 96, hi);
    float m = -1e30f, ls = 0.f; f32x16 o0 = f32x16{}, o1 = f32x16{};
    const unsigned sw[4] = {0, 0, 0, 0};
    const float mb = gldf((const float*)(ws + W_MLAB) + l);
    if (mb <= 60.f) { m = mb;
    att_run<96, false, false, false, true>((const bf16_t*)(ws + A_KM) + (long)(b * 4 + h) * 128 * 6144, (const bf16_t*)(ws + A_VM) + (long)(b * 4 + h) * 128 * 4096,
                              0, q0 / 64 + 3, qf, tq, 1 << 30, 0.10206207261596577f * LOG2E, 0, sw, m, ls, o0, o1, tid__, q0, 256);
    } else
    att_run<96, false, false>((const bf16_t*)(ws + A_KM) + (long)(b * 4 + h) * 128 * 6144, (const bf16_t*)(ws + A_VM) + (long)(b * 4 + h) * 128 * 4096,
                              0, q0 / 64 + 3, qf, tq, 1 << 30, 0.10206207261596577f * LOG2E, 0, sw, m, ls, o0, o1, tid__, q0, 256);
    const float inv = frcp(hsum(ls));
#pragma unroll
    for (int r = 0; r < 16; ++r) { o0[r] *= inv; o1[r] *= inv; }
    att_store_out((bf16_t*)(ws + P_ORAW) + (long)(b * S_ + tq) * 1024 + 768 + h * 64, o0, o1, hi);
}
DEV void attn_sb(const int tid__, const Args& a, int l, int b, int h, int qb) {
    unsigned char* ws = a.ws; const int lane = tid__ & 63, wid = __builtin_amdgcn_readfirstlane(tid__ >> 6), l31 = lane & 31, hi = lane >> 5;
    const int q0 = qb * 256, tq = q0 + 32 * wid + l31;
    bf16x8 qf[4]; att_loadq<4>(qf, (const bf16_t*)(ws + X_QSB) + ((long)(b * 4 + h) * S_ + tq) * 64, hi);
    const bf16_t* Kimg = (const bf16_t*)(ws + X_KSB) + (long)(b * 4 + h) * 128 * 4096; const bf16_t* Vimg = (const bf16_t*)(ws + X_VSB) + (long)(b * 4 + h) * 128 * 4096;
    f32x16 o0 = f32x16{}, o1 = f32x16{}; float carry = 1.f;
    if (tid__ < 3) LDS_I(AT_ALIVE + tid__ * 4) = 0;
    u4 k0, k1, v; int buf = 0, j = q0 / 64 + 3, it = 0;
    att_gload<64>(k0, k1, v, Kimg + (long)j * 4096, Vimg + (long)j * 4096, tid__); att_lstore<64>(k0, k1, v, 0, tid__);
    __syncthreads();
    for (;;) {
        const int jn = j - 1;
        if (jn >= 0) att_gload<64>(k0, k1, v, Kimg + (long)jn * 4096, Vimg + (long)jn * 4096, tid__);
        if (tid__ == 0) LDS_I(AT_ALIVE + ((it + 1) % 3) * 4) = 0;
        const bool skip = 64 * j >= __builtin_amdgcn_readfirstlane(tq - l31) + 31;
        if (!skip) {
        f32x16 p0, p1, g0, g1;
        att_qk<64>(p0, p1, buf, qf, lane);
        if (64 * j + 63 < __builtin_amdgcn_readfirstlane(tq - l31)) {
#pragma unroll
        for (int r = 0; r < 16; ++r) {
            { const float e = fexp2(__builtin_fminf(p0[r] * (0.125f * LOG2E), 80.f * LOG2E)), rr = frcp(1.f + e); p0[r] = rr; g0[r] = e * rr; }
            { const float e = fexp2(__builtin_fminf(p1[r] * (0.125f * LOG2E), 80.f * LOG2E)), rr = frcp(1.f + e); p1[r] = rr; g1[r] = e * rr; }
        }
        } else {
#pragma unroll
        for (int r = 0; r < 16; ++r) {
            const int key = 64 * j + crow(r, hi);
            { const bool ok = key < tq; const float e = fexp2(__builtin_fminf(p0[r] * (0.125f * LOG2E), 80.f * LOG2E)), rr = frcp(1.f + e); p0[r] = ok ? rr : 1.f; g0[r] = ok ? e * rr : 0.f; }
            { const bool ok = key + 32 < tq; const float e = fexp2(__builtin_fminf(p1[r] * (0.125f * LOG2E), 80.f * LOG2E)), rr = frcp(1.f + e); p1[r] = ok ? rr : 1.f; g1[r] = ok ? e * rr : 0.f; }
        }
        }
        float gp[2][4], go[2][4], sg[2][4];
#pragma unroll
        for (int q = 0; q < 4; ++q) { gp[0][q] = p0[4 * q] * p0[4 * q + 1] * p0[4 * q + 2] * p0[4 * q + 3]; gp[1][q] = p1[4 * q] * p1[4 * q + 1] * p1[4 * q + 2] * p1[4 * q + 3]; }
#pragma unroll
        for (int kb = 0; kb < 2; ++kb)
#pragma unroll
            for (int q = 0; q < 4; ++q) go[kb][q] = hother(gp[kb][q], hi);
        float run = carry;
#pragma unroll
        for (int kb = 1; kb >= 0; --kb)
#pragma unroll
            for (int q = 3; q >= 0; --q) {
                const float gh1 = hi ? gp[kb][q] : go[kb][q], gh0 = hi ? go[kb][q] : gp[kb][q];
                const float s1 = run; run *= gh1; const float s0 = run; run *= gh0; sg[kb][q] = hi ? s1 : s0;
            }
        carry = run;
#pragma unroll
        for (int q = 0; q < 4; ++q) {
            { const float e3 = sg[0][q], e2 = e3 * p0[4 * q + 3], e1 = e2 * p0[4 * q + 2], e0 = e1 * p0[4 * q + 1];
              p0[4 * q] = g0[4 * q] * e0; p0[4 * q + 1] = g0[4 * q + 1] * e1; p0[4 * q + 2] = g0[4 * q + 2] * e2; p0[4 * q + 3] = g0[4 * q + 3] * e3; }
            { const float e3 = sg[1][q], e2 = e3 * p1[4 * q + 3], e1 = e2 * p1[4 * q + 2], e0 = e1 * p1[4 * q + 1];
              p1[4 * q] = g1[4 * q] * e0; p1[4 * q + 1] = g1[4 * q + 1] * e1; p1[4 * q + 2] = g1[4 * q + 2] * e2; p1[4 * q + 3] = g1[4 * q + 3] * e3; }
        }
        att_pv(o0, o1, buf, p0, p1, lane);
        }
        if (__any(carry >= 1e-30f) && lane == 0) LDS_I(AT_ALIVE + (it % 3) * 4) = 1;
        if (jn >= 0) att_lstore<64>(k0, k1, v, buf ^ 1, tid__);
        __syncthreads();
        const int alive = LDS_I(AT_ALIVE + (it % 3) * 4);
        if (jn < 0 || !alive) break;
        j = jn; buf ^= 1; ++it;
    }
    att_store_out((bf16_t*)(ws + P_ORAW) + (long)(b * S_ + tq) * 1024 + h * 64, o0, o1, hi);
    __syncthreads();
}

#define RLX_AGENT __ATOMIC_RELAXED, __HIP_MEMORY_SCOPE_AGENT
DEV void att_store_out_wt(bf16_t* orow, const f32x16& o0, const f32x16& o1, int hi) {
#pragma unroll
    for (int q = 0; q < 4; ++q) {
        const unsigned long long w0 = (unsigned long long)cvtpk(o0[4 * q], o0[4 * q + 1]) | ((unsigned long long)cvtpk(o0[4 * q + 2], o0[4 * q + 3]) << 32);
        const unsigned long long w1 = (unsigned long long)cvtpk(o1[4 * q], o1[4 * q + 1]) | ((unsigned long long)cvtpk(o1[4 * q + 2], o1[4 * q + 3]) << 32);
        __hip_atomic_store((GAS unsigned long long*)(orow + 8 * q + 4 * hi), w0, RLX_AGENT); __hip_atomic_store((GAS unsigned long long*)(orow + 32 + 8 * q + 4 * hi), w1, RLX_AGENT);
    }
}
#ifndef PROBE_NSA
#define PROBE_NSA 0
#endif
DEV void attn_nsa_a(const int tid__, const Args& a, int l, int b, int hk, int qb) {
    unsigned char* ws = a.ws; const int lane = tid__ & 63, wid = __builtin_amdgcn_readfirstlane(tid__ >> 6), l31 = lane & 31, hi = lane >> 5, g = l31 >> 4;
    const int h = hk * 2 + g, q0 = qb * 128, tq = q0 + 16 * wid + (l31 & 15);
    const float c = 0.125f * LOG2E; const int lutoff = g * 4096;
    att_load_lut((const float*)(ws + W_LUT) + (4 + hk * 2) * 1024, tid__);
    if (tid__ < 4) LDS_U(AT_UN + tid__ * 4) = 0u;
    for (int i = lane; i < 16 * 129 / 4; i += 64) LDS_U4(AT_IMP + wid * (16 * 129 * 4) + i * 16) = u4{0u, 0u, 0u, 0u};
    const bf16_t* qrow = (const bf16_t*)(ws + A_QN) + ((long)(b * 4 + h) * S_ + tq) * 64;
    const float* gt = (const float*)(ws + A_GATES) + (long)(b * S_ + tq) * 12 + h;
#define NSA_LOADQ() bf16x8 qf[4]; { const bf16_t* q_ = qrow; asm volatile("" : "+v"(q_)); att_loadq<4>(qf, q_, hi); }
    const int sbase = b * 2 + hk;
    const bf16_t* Kc = (const bf16_t*)(ws + A_KC) + (long)sbase * 8 * 4096; const bf16_t* Vc = (const bf16_t*)(ws + A_VC) + (long)sbase * 8 * 4096;
    __syncthreads();
    const int Tmax = ((q0 + 127 - 31) >> 4) >> 6;
    const unsigned sw[4] = {0u, 0u, 0u, 0u};
    float m = -1e30f, ls = 0.f; u4 kp0;
    const float gate_c = gldf(gt);
    for (int rep_ = 0; rep_ < ((PROBE_NSA & 16) ? 3 : 1); ++rep_)
    {
        m = -1e30f; ls = 0.f;
        f32x16 o0 = f32x16{}, o1 = f32x16{}; NSA_LOADQ();
        att_run<64, true, false, true>(Kc, Vc, 0, Tmax, qf, tq, 1 << 30, c, lutoff, sw, m, ls, o0, o1, tid__, q0, 128, 16, 31);
        kp0 = gld16(Kc + tid__ * 8);
        const float lt0 = hsum(ls); const float sc = lt0 > 0.f ? gate_c * frcp(lt0) : 0.f;
#pragma unroll
        for (int r = 0; r < 16; ++r) { o0[r] *= sc; o1[r] *= sc; }
        att_store_out_wt((bf16_t*)(ws + P_ORAW) + (long)(b * S_ + tq) * 1024 + 512 + h * 64, o0, o1, hi);
    }
    const float lt = hsum(ls); const float mm = lt > 0.f ? m + __builtin_amdgcn_logf(lt) : __builtin_inff();
    {
        const unsigned ib = AT_IMP + wid * (16 * 129 * 4) + (l31 & 15) * (129 * 4); NSA_LOADQ();
        int buf = 0; float carry = 0.f;
        LDS_U4(AT_K0 + tid__ * 16) = kp0;
        __syncthreads();
        for (int T = 0; T <= Tmax; ++T) {
            if (T < Tmax) kp0 = gld16(Kc + (long)(T + 1) * 4096 + tid__ * 8);
            f32x16 p0, p1; att_qk<64>(p0, p1, buf, qf, lane);
            if (q0 - (16 * (64 * T + 63) + 31) >= 790) {
                const float off = LDS_F(AT_LUT + lutoff + 1023 * 4) - mm;
#pragma unroll
                for (int r = 0; r < 16; ++r) { p0[r] = fexp2(__builtin_fmaf(p0[r], c, off)); p1[r] = fexp2(__builtin_fmaf(p1[r], c, off)); }
            } else {
                { int tq_ = tq, hi_ = hi; asm volatile("" : "+v"(tq_), "+v"(hi_)); att_logits<true>(p0, p1, tq_, 64 * T, 16, 31, 1 << 30, c, lutoff, true, hi_); }
#pragma unroll
                for (int r = 0; r < 16; ++r) { p0[r] = fexp2(p0[r] - mm); p1[r] = fexp2(p1[r] - mm); }
            }
            float tprev = carry;
#pragma unroll
            for (int kb = 0; kb < 2; ++kb)
#pragma unroll
                for (int q = 0; q < 4; ++q) {
                    const float e3 = kb ? p1[4 * q + 3] : p0[4 * q + 3];
                    const float sum4 = kb ? (p1[4 * q] + p1[4 * q + 1]) + (p1[4 * q + 2] + e3) : (p0[4 * q] + p0[4 * q + 1]) + (p0[4 * q + 2] + e3);
                    const float tq_ = hother(e3, hi);
                    float e = sum4 + (hi ? tq_ : tprev);
                    e += __shfl_xor(e, 16);
                    if (g == 0) LDS_F(ib + (16 * T + 8 * kb + 2 * q + hi) * 4) = e;
                    tprev = tq_;
                }
            carry = tprev;
            if (T < Tmax) LDS_U4((buf ? AT_K0 : AT_K1) + tid__ * 16) = kp0;
            __syncthreads();
            buf ^= 1;
        }
    }
    for (int rep_ = 0; rep_ < ((PROBE_NSA & 8) ? 3 : 1); ++rep_)
    {
        const int qq = lane & 15, part = lane >> 4; const int tqq = q0 + 16 * wid + qq, cur = tqq >> 6; unsigned kk[32];
        const unsigned ib = AT_IMP + wid * (16 * 129 * 4) + qq * (129 * 4) + part * 128;
#pragma unroll
        for (int i = 0; i < 32; ++i) {
            const float v = LDS_F(ib + i * 4); const int j = 32 * part + i; const bool valid = j <= cur, forced = (j == 0) || (j == cur) || (j == cur - 1);
            kk[i] = !valid ? 0u : (forced ? (0x7fffff00u | (unsigned)(255 - j)) : ((__float_as_uint(v) & 0xffffff00u) | (unsigned)(255 - j)));
        }
        unsigned thr = 0u, ncur = 255u;
        {
            const unsigned cand = 1u << 30; unsigned cnt = 0u;
#pragma unroll
            for (int i = 0; i < 32; ++i) cnt += (kk[i] >= cand) ? 1u : 0u;
            cnt += __shfl_xor(cnt, 16); cnt += __shfl_xor(cnt, 32);
            if (cnt >= 16u) { thr = cand; ncur = cnt; }
        }
#pragma unroll 1
        for (int bit = 28; bit >= 0; bit -= 2) {
            if (__all(ncur == 16u)) break;
            const unsigned c1 = thr | (1u << bit), c2 = thr | (2u << bit), c3 = thr | (3u << bit); unsigned cnt = 0u;
#pragma unroll
            for (int i = 0; i < 32; ++i) cnt += ((kk[i] >= c1) ? 1u : 0u) + ((kk[i] >= c2) ? 0x100u : 0u) + ((kk[i] >= c3) ? 0x10000u : 0u);
            cnt += __shfl_xor(cnt, 16); cnt += __shfl_xor(cnt, 32);
            const unsigned n3 = (cnt >> 16) & 0xffu, n2 = (cnt >> 8) & 0xffu, n1 = cnt & 0xffu;
            if (n3 >= 16u) { thr = c3; ncur = n3; } else if (n2 >= 16u) { thr = c2; ncur = n2; } else if (n1 >= 16u) { thr = c1; ncur = n1; }
        }
        thr = thr < 1u ? 1u : thr;
        unsigned w = 0u;
#pragma unroll
        for (int i = 0; i < 32; ++i) w |= (kk[i] >= thr ? 1u : 0u) << i;
        __hip_atomic_store((GAS unsigned*)((unsigned*)(ws + MS_SELM) + ((long)sbase * 8192 + tqq) * 4 + part), w, RLX_AGENT);
        atomicOr((unsigned*)(smem + AT_UN + part * 4), w);
    }
    __syncthreads();
    if (tid__ < 4) __hip_atomic_store((GAS unsigned*)((unsigned*)(ws + MS_UNM) + (sbase * 64 + qb) * 4 + tid__), LDS_U(AT_UN + tid__ * 4), RLX_AGENT);
    asm volatile("s_waitcnt vmcnt(0)" ::: "memory");
    __syncthreads();
    if (tid__ == 0) __hip_atomic_store((GAS unsigned*)((unsigned*)(ws + WS_CTL) + CW_NSAF + l * 1024 + sbase * 64 + qb), 1u, RLX_AGENT);
    __syncthreads();
}
DEV float sb_bmax(const float* rel_bias, int h) {
    float m = gldf(rel_bias + 4 + h);
#pragma unroll 4
    for (int k = 1; k < 32; ++k) m = __builtin_fmaxf(m, gldf(rel_bias + k * 8 + 4 + h));
    return m;
}
DEV void attn_nsa_b(const int tid__, const Args& a, int l, int b, int hk, int qb) {
    unsigned char* ws = a.ws; const int lane = tid__ & 63, wid = __builtin_amdgcn_readfirstlane(tid__ >> 6), l31 = lane & 31, hi = lane >> 5, g = l31 >> 4;
    const int h = hk * 2 + g, q0 = qb * 128, tq = q0 + 16 * wid + (l31 & 15);
    const float c = 0.125f * LOG2E; const int lutoff = g * 4096; const int sbase = b * 2 + hk;
    att_load_lut((const float*)(ws + W_LUT) + (4 + hk * 2) * 1024, tid__);
    if (tid__ == 0) { GAS unsigned* f = (GAS unsigned*)((unsigned*)(ws + WS_CTL) + CW_NSAF + l * 1024 + sbase * 64 + qb); unsigned sp = 0;
        while (__hip_atomic_load(f, RLX_AGENT) == 0u && ++sp < (1u << 22)) __builtin_amdgcn_s_sleep(2); }
    __syncthreads();
    if (tid__ < 4) LDS_U(AT_UN + tid__ * 4) = __hip_atomic_load((GAS unsigned*)((unsigned*)(ws + MS_UNM) + (sbase * 64 + qb) * 4 + tid__), RLX_AGENT);
    unsigned sw[4];
    { GAS unsigned long long* mp = (GAS unsigned long long*)((unsigned*)(ws + MS_SELM) + ((long)sbase * 8192 + tq) * 4);
      const unsigned long long m0 = __hip_atomic_load(mp, RLX_AGENT), m1 = __hip_atomic_load(mp + 1, RLX_AGENT);
      sw[0] = (unsigned)m0; sw[1] = (unsigned)(m0 >> 32); sw[2] = (unsigned)m1; sw[3] = (unsigned)(m1 >> 32); }
    const bf16_t* qrow = (const bf16_t*)(ws + A_QN) + ((long)(b * 4 + h) * S_ + tq) * 64;
    const float* gt = (const float*)(ws + A_GATES) + (long)(b * S_ + tq) * 12 + h;
    const unsigned stash = AT_IMP + wid * (16 * 129 * 4) + lane * 4;
    __syncthreads();
    for (int rep_ = 0; rep_ < ((PROBE_NSA & 2) ? 2 : 1); ++rep_)
    {
        for (int i = tid__; i < 512; i += 512) LDS_U(SB_SM + i * 4) = __hip_atomic_load((GAS unsigned*)((unsigned*)(ws + MS_SELM) + ((long)sbase * 8192 + q0) * 4 + i), RLX_AGENT);
        for (int i = tid__; i < (256 * 65 + 256) / 4; i += 512) LDS_U4(SB_O + i * 16) = u4{0u, 0u, 0u, 0u};
        if (tid__ == 0) LDS_I(SB_CTR) = 0;
        float gq = __builtin_fabsf(gldf(a.in[7] + l * 64 + lane)), gk = __builtin_fabsf(gldf(a.in[8] + (l * 3 + 1) * 64 + lane));
#pragma unroll
        for (int mk = 1; mk < 64; mk <<= 1) { gq = __builtin_fmaxf(gq, __shfl_xor(gq, mk)); gk = __builtin_fmaxf(gk, __shfl_xor(gk, mk)); }
        __syncthreads();
        const unsigned vpriv = wid < 5 ? AT_K0 + wid * 8192 : SB_VX + (wid - 5) * 8192;
        const bf16_t* Kimg = (const bf16_t*)(ws + A_KNS) + (long)sbase * 128 * 4096; const bf16_t* Vimg = (const bf16_t*)(ws + A_VNS) + (long)sbase * 128 * 4096;
        const bf16_t* Qb = (const bf16_t*)(ws + A_QN) + ((long)(b * 4 + h) * S_ + q0) * 64 + hi * 8;
        const float mref = (8.0f * gq * gk + 0.01f) * LOG2E + sb_bmax(a.in[1], h) * LOG2E;
        const int jmax = (q0 + 127) >> 6;
        constexpr float SCL_L = 2095000.f;
        const float vmax = __builtin_fmaxf(__uint_as_float(xb_ld((unsigned*)(ws + WS_CTL) + CW_VMAX + l * 16 + sbase)), 1e-20f); const float scl_o = 2095000.f / vmax; const float lscl = __builtin_amdgcn_logf(scl_o);
        for (;;) {
            int ti = 0; if (lane == 0) ti = atomicAdd((int*)(smem + SB_CTR), 1);
            ti = __builtin_amdgcn_readfirstlane(ti);
            if (ti > jmax) break;
            const int j = jmax < 4 ? ti : (ti < 3 ? jmax - ti : (ti == 3 ? 0 : jmax - ti + 1));
            const unsigned wa = LDS_U(SB_SM + (lane * 4 + (j >> 5)) * 4), wb = LDS_U(SB_SM + ((lane + 64) * 4 + (j >> 5)) * 4);
            const unsigned long long ma = __ballot((wa >> (j & 31)) & 1u), mb = __ballot((wb >> (j & 31)) & 1u);
            const int na = __popcll(ma), n = na + __popcll(mb);
            if (n == 0) continue;
            const unsigned long long below = (1ull << lane) - 1ull;
            if ((ma >> lane) & 1ull) *(LAS unsigned char*)((LAS char*)smem + SB_LIST + wid * 128 + __popcll(ma & below)) = (unsigned char)lane;
            if ((mb >> lane) & 1ull) *(LAS unsigned char*)((LAS char*)smem + SB_LIST + wid * 128 + na + __popcll(mb & below)) = (unsigned char)(lane + 64);
            const bf16_t* kt = Kimg + (long)j * 4096 + hi * 512 + l31 * 8; bf16x8 kf[8];
#pragma unroll
            for (int d0 = 0; d0 < 4; ++d0) { kf[2 * d0] = __builtin_bit_cast(bf16x8, gld16(kt + d0 * 1024)); kf[2 * d0 + 1] = __builtin_bit_cast(bf16x8, gld16(kt + d0 * 1024 + 256)); }
            { const bf16_t* vt = Vimg + (long)j * 4096;
#pragma unroll
              for (int i = 0; i < 8; ++i) LDS_U4(vpriv + (lane + 64 * i) * 16) = gld16(vt + (lane + 64 * i) * 8); }
            const bool far = q0 - (64 * j + 63) >= 790; const float bfar = LDS_F(AT_LUT + lutoff + 1023 * 4);
            const int ntask = (n + 15) >> 4;
            bf16x8 qq[4]; int qi = *(LAS unsigned char*)((LAS char*)smem + SB_LIST + wid * 128 + ((l31 & 15) < n ? (l31 & 15) : 0));
#pragma unroll
            for (int d0 = 0; d0 < 4; ++d0) qq[d0] = __builtin_bit_cast(bf16x8, gld16(Qb + (long)qi * 64 + d0 * 16));
            for (int task = 0; task < ntask; ++task) {
                const int idx = 16 * task + (l31 & 15); const bool valid = idx < n;
                const int tqq = q0 + qi, colg = qi * 2 + g;
                const int idn = idx + 16; const int qin = *(LAS unsigned char*)((LAS char*)smem + SB_LIST + wid * 128 + (idn < n ? idn : 0)); bf16x8 qn[4];
#pragma unroll
                for (int d0 = 0; d0 < 4; ++d0) qn[d0] = __builtin_bit_cast(bf16x8, gld16(Qb + (long)qin * 64 + d0 * 16));
                f32x16 p0 = f32x16{}, p1 = f32x16{};
#pragma unroll
                for (int d0 = 0; d0 < 4; ++d0) { p0 = MFMA32(kf[2 * d0], qq[d0], p0); p1 = MFMA32(kf[2 * d0 + 1], qq[d0], p1); }
                float ssum; const float offv = (valid ? lscl : NEG_INF) - mref;
                if (far) {
                    const f32x2 c2 = {c, c}, off2 = {bfar + offv, bfar + offv}; f32x2 sa = {0.f, 0.f}, sc2 = {0.f, 0.f};
#pragma unroll
                    for (int k = 0; k < 8; ++k) { f32x2 u = PAIR(p0, k) * c2 + off2, v = PAIR(p1, k) * c2 + off2; u[0] = fexp2(u[0]); u[1] = fexp2(u[1]); v[0] = fexp2(v[0]); v[1] = fexp2(v[1]);
                        sa += u; sc2 += v; UNPAIR(p0, k, u); UNPAIR(p1, k, v); }
                    sa += sc2; ssum = sa[0] + sa[1];
                } else {
                    ssum = 0.f;
#pragma unroll
                    for (int r = 0; r < 16; ++r) {
                        const int d0_ = tqq - (64 * j + crow(r, hi)), d1_ = d0_ - 32;
                        const float b0 = LDS_F(AT_LUT + lutoff + (d0_ < 0 ? 0 : (d0_ > 1023 ? 1023 : d0_)) * 4), b1 = LDS_F(AT_LUT + lutoff + (d1_ < 0 ? 0 : (d1_ > 1023 ? 1023 : d1_)) * 4);
                        p0[r] = d0_ >= 0 ? fexp2(__builtin_fmaf(p0[r], c, b0 + offv)) : 0.f;
                        p1[r] = d1_ >= 0 ? fexp2(__builtin_fmaf(p1[r], c, b1 + offv)) : 0.f;
                        ssum += p0[r] + p1[r];
                    }
                }
                f32x16 o0 = f32x16{}, o1 = f32x16{};
                {   const unsigned vb = vpriv + (4 * hi + ((lane & 15) >> 2)) * 64 + ((lane >> 4) & 1) * 32 + (lane & 3) * 8;
#pragma unroll
                    for (int kb = 0; kb < 2; ++kb)
#pragma unroll
                        for (int sp = 0; sp < 2; ++sp) { const bf16x8 pf = kb ? PACK8(p1, sp) : PACK8(p0, sp); const unsigned av = vb + (32 * kb + 16 * sp) * 64;
                            o0 = MFMA32(att_vfrag(av), pf, o0); o1 = MFMA32(att_vfrag(av + 4096), pf, o1); } }
                if (valid) {
                    atomicAdd((int*)(smem + SB_L + colg * 4), (int)__builtin_rintf(ssum * vmax));
                    const unsigned ob = SB_O + (colg * 65 + 4 * hi) * 4;
#pragma unroll
                    for (int r = 0; r < 16; ++r) { atomicAdd((int*)(smem + ob + ((r & 3) + 8 * (r >> 2)) * 4), (int)o0[r]); atomicAdd((int*)(smem + ob + (32 + (r & 3) + 8 * (r >> 2)) * 4), (int)o1[r]); }
                }
                qi = qin;
#pragma unroll
                for (int d0 = 0; d0 < 4; ++d0) qq[d0] = qn[d0];
            }
        }
        __syncthreads();
        {
            const int colg = (16 * wid + (l31 & 15)) * 2 + g; const float t2 = (float)LDS_I(SB_L + colg * 4) * (1.f / SCL_L); const float sc = t2 > 0.f ? gldf(gt + 4) * frcp(t2) * frcp(scl_o) : 0.f;
            f32x16 o0, o1; const unsigned ob = SB_O + (colg * 65 + 4 * hi) * 4;
#pragma unroll
            for (int r = 0; r < 16; ++r) { o0[r] = sc * (float)LDS_I(ob + ((r & 3) + 8 * (r >> 2)) * 4); o1[r] = sc * (float)LDS_I(ob + (32 + (r & 3) + 8 * (r >> 2)) * 4); }
            __syncthreads();
#pragma unroll
            for (int r = 0; r < 16; ++r) { LDS_F(stash + r * 256) = o0[r]; LDS_F(stash + 4096 + r * 256) = o1[r]; }
        }
        __syncthreads();
    }
    f32x16 f0, f1;
    for (int rep_ = 0; rep_ < ((PROBE_NSA & 4) ? 2 : 1); ++rep_)
    {
        float mw = -1e30f, l3 = 0.f; f32x16 o0 = f32x16{}, o1 = f32x16{}; NSA_LOADQ();
        const int tlo = q0 / 64 - 8 < 0 ? 0 : q0 / 64 - 8;
        att_run<64, true, false>((const bf16_t*)(ws + A_KNW) + (long)sbase * 128 * 4096, (const bf16_t*)(ws + A_VNW) + (long)sbase * 128 * 4096,
                                 tlo, q0 / 64 + 1, qf, tq, 512, c, lutoff, sw, mw, l3, o0, o1, tid__, q0, 128);
        const float t3 = hsum(l3); const float sc = t3 > 0.f ? gldf(gt + 8) * frcp(t3) : 0.f;
#pragma unroll
        for (int r = 0; r < 16; ++r) { f0[r] = LDS_F(stash + r * 256) + sc * o0[r]; f1[r] = LDS_F(stash + 4096 + r * 256) + sc * o1[r]; }
    }
    bf16_t* orow = (bf16_t*)(ws + P_ORAW) + (long)(b * S_ + tq) * 1024 + 512 + h * 64;
#pragma unroll
    for (int q = 0; q < 4; ++q) {
        const unsigned long long c0 = __hip_atomic_load((GAS unsigned long long*)(orow + 8 * q + 4 * hi), RLX_AGENT), c1 = __hip_atomic_load((GAS unsigned long long*)(orow + 32 + 8 * q + 4 * hi), RLX_AGENT);
        f0[4 * q] += bflo((unsigned)c0); f0[4 * q + 1] += bfhi((unsigned)c0); f0[4 * q + 2] += bflo((unsigned)(c0 >> 32)); f0[4 * q + 3] += bfhi((unsigned)(c0 >> 32));
        f1[4 * q] += bflo((unsigned)c1); f1[4 * q + 1] += bfhi((unsigned)c1); f1[4 * q + 2] += bflo((unsigned)(c1 >> 32)); f1[4 * q + 3] += bfhi((unsigned)(c1 >> 32));
    }
    att_store_out(orow, f0, f1, hi);
    __syncthreads();
}
DEV void unpack8(const u4& u, float (&v)[8]) { v[0] = bflo(u.x); v[1] = bfhi(u.x); v[2] = bflo(u.y); v[3] = bfhi(u.y); v[4] = bflo(u.z); v[5] = bfhi(u.z); v[6] = bflo(u.w); v[7] = bfhi(u.w); }
DEV u4 pack8f(const float (&v)[8]) { u4 o; o.x = cvtpk(v[0], v[1]); o.y = cvtpk(v[2], v[3]); o.z = cvtpk(v[4], v[5]); o.w = cvtpk(v[6], v[7]); return o; }
DEV long kimg_off(int nstream, int s, int chunk, int nchunk) { return ((long)nstream * 128 + (s >> 6)) * (nchunk * 512) + chunk * 512 + (s & 63) * 8; }
DEV long vimg_off(int nstream, int s, int chunk) { return ((long)nstream * 128 + (s >> 6)) * 4096 + (chunk >> 2) * 2048 + (s & 63) * 32 + (chunk & 3) * 8; }
DEV void phase_prep(const Args& a, int l) {
    unsigned char* ws = a.ws; const int lane = threadIdx.x & 63, wv = threadIdx.x >> 6, tj = lane >> 3, ch = lane & 7;
    const bf16_t* proj = (const bf16_t*)(ws + P_PROJ);
    if (threadIdx.x < 64) LDS_U(LDS_PH + threadIdx.x * 4) = 0u;
    __syncthreads();
    int it = -1;
    for (int grp = blockIdx.x * 8 + wv; grp < T_ / 8; grp += gridDim.x * 8) {
        ++it;
        const int t = grp * 8 + tj, b = t >> 13, s = t & 8191; const bf16_t* pr = proj + (long)t * PLD + ch * 8;
        u4 rawall[42];
#pragma unroll
        for (int k = 0; k < 42; ++k) rawall[k] = gld16(pr + k * 64);
#pragma unroll
        for (int h0 = 0; h0 < 36; h0 += 6) {
            u4 raw[6];
#pragma unroll
            for (int k = 0; k < 6; ++k) raw[k] = rawall[h0 + k];
#pragma unroll
            for (int k = 0; k < 6; ++k) {
                const int hd = h0 + k; float v[8]; unpack8(raw[k], v);
                const float* gn = nullptr;
                if (hd >= 12 && hd < 16) gn = a.in[4] + l * 64; else if (hd >= 16 && hd < 18) gn = a.in[5] + l * 64; else if (hd >= 20 && hd < 24) gn = a.in[7] + l * 64;
                else if (hd >= 28 && hd < 30) gn = a.in[8] + (l * 3 + 1) * 64; else if (hd >= 32 && hd < 34) gn = a.in[8] + (l * 3 + 2) * 64;
                u4 o = raw[k];
                if (gn) { float ss = 0.f;
#pragma unroll
                    for (int e = 0; e < 8; ++e) ss += v[e] * v[e];
                    ss += __shfl_xor(ss, 1); ss += __shfl_xor(ss, 2); ss += __shfl_xor(ss, 4);
                    const float rs = __builtin_amdgcn_rsqf(ss * (1.f / 64.f) + EPS); const u4 g0 = gld16(gn + ch * 8), g1 = gld16(gn + ch * 8 + 4);
                    v[0] *= rs * __uint_as_float(g0.x); v[1] *= rs * __uint_as_float(g0.y); v[2] *= rs * __uint_as_float(g0.z); v[3] *= rs * __uint_as_float(g0.w);
                    v[4] *= rs * __uint_as_float(g1.x); v[5] *= rs * __uint_as_float(g1.y); v[6] *= rs * __uint_as_float(g1.z); v[7] *= rs * __uint_as_float(g1.w);
                    o = pack8f(v); }
                if (hd < 4) gst16((bf16_t*)(ws + X_QSB) + ((long)(b * 4 + hd) * S_ + s) * 64 + ch * 8, o);
                else if (hd < 8) gst16((bf16_t*)(ws + X_KSB) + kimg_off(b * 4 + hd - 4, s, ch, 8), o);
                else if (hd < 12) gst16((bf16_t*)(ws + X_VSB) + vimg_off(b * 4 + hd - 8, s, ch), o);
                else if (hd < 16) gst16((bf16_t*)(ws + X_QSW) + ((long)(b * 4 + hd - 12) * S_ + s) * 64 + ch * 8, o);
                else if (hd < 18) gst16((bf16_t*)(ws + A_KSW) + kimg_off(b * 2 + hd - 16, s, ch, 8), o);
                else if (hd < 20) gst16((bf16_t*)(ws + A_VSW) + vimg_off(b * 2 + hd - 18, s, ch), o);
                else if (hd < 24) gst16((bf16_t*)(ws + A_QN) + ((long)(b * 4 + hd - 20) * S_ + s) * 64 + ch * 8, o);
                else if (hd < 28) gst16((bf16_t*)(ws + A_XC) + (long)t * 256 + (hd - 24) * 64 + ch * 8, o);
                else if (hd < 30) gst16((bf16_t*)(ws + A_KNS) + kimg_off(b * 2 + hd - 28, s, ch, 8), o);
                else if (hd < 32) { gst16((bf16_t*)(ws + A_VNS) + vimg_off(b * 2 + hd - 30, s, ch), o);
                    float mx = 0.f;
#pragma unroll
                    for (int e = 0; e < 8; ++e) mx = __builtin_fmaxf(mx, __builtin_fabsf(v[e]));
#pragma unroll
                    for (int mk = 1; mk < 64; mk <<= 1) mx = __builtin_fmaxf(mx, __shfl_xor(mx, mk));
                    if (lane == 0) { const unsigned sl = LDS_PH + (it * 2 + hd - 30) * 8; atomicMax((unsigned*)(smem + sl), __float_as_uint(mx));
                        if (atomicAdd((unsigned*)(smem + sl + 4), 1u) == 7u) atomicMax((unsigned*)(ws + WS_CTL) + CW_VMAX + l * 16 + (grp >> 10) * 2 + hd - 30, atomicMax((unsigned*)(smem + sl), 0u)); } }
                else if (hd < 34) gst16((bf16_t*)(ws + A_KNW) + kimg_off(b * 2 + hd - 32, s, ch, 8), o);
                else gst16((bf16_t*)(ws + A_VNW) + vimg_off(b * 2 + hd - 34, s, ch), o);
            }
        }
        {
            u4 raw[6]; float v[6][8];
#pragma unroll
            for (int k = 0; k < 6; ++k) raw[k] = rawall[36 + k];
            float sq = 0.f, sk = 0.f;
#pragma unroll
            for (int k = 0; k < 6; ++k) { unpack8(raw[k], v[k]);
                if (k < 5) { float ss = 0.f;
#pragma unroll
                    for (int e = 0; e < 8; ++e) ss += v[k][e] * v[k][e];
                    if (k < 3) sq += ss; else sk += ss; } }
            sq += __shfl_xor(sq, 1); sq += __shfl_xor(sq, 2); sq += __shfl_xor(sq, 4); sk += __shfl_xor(sk, 1); sk += __shfl_xor(sk, 2); sk += __shfl_xor(sk, 4);
            const float rq = __builtin_amdgcn_rsqf(sq * (1.f / 192.f) + EPS), rk = __builtin_amdgcn_rsqf(sk * (1.f / 128.f) + EPS);
#pragma unroll
            for (int k = 0; k < 5; ++k) { const float rs = k < 3 ? rq : rk;
#pragma unroll
                for (int e = 0; e < 8; ++e) v[k][e] *= rs;
                if (k < 3) gst16((bf16_t*)(ws + A_CQN) + (long)t * 192 + k * 64 + ch * 8, pack8f(v[k]));
                else gst16((bf16_t*)(ws + A_CKVN) + (long)t * 128 + (k - 3) * 64 + ch * 8, pack8f(v[k])); }
            if (ch < 4) gst16((bf16_t*)(ws + A_KPE) + (long)t * 32 + ch * 8, raw[5]);
            else if (ch < 6) { float* gt = (float*)(ws + A_GATES) + (long)t * 12 + (ch - 4) * 8; const int ne = ch == 4 ? 8 : 4;
#pragma unroll
                for (int e = 0; e < 8; ++e) if (e < ne) *(GAS float*)(gt + e) = frcp(1.f + fexp2(-v[5][e] * LOG2E)); }
        }
    }
}

DEV void phase_mla_fin(const Args& a, int l) {
    unsigned char* ws = a.ws; const int lane = threadIdx.x & 63, wv = threadIdx.x >> 6, tj = lane >> 3, ch = lane & 7;
    const float* qg = a.in[16] + l * 96; const float* kg = a.in[17] + l * 96;
    for (int grp = blockIdx.x * 8 + wv; grp < T_ / 8; grp += gridDim.x * 8) {
        const int t = grp * 8 + tj, b = t >> 13, s = t & 8191;
        u4 rq[6], rkv[8], rpe;
#pragma unroll
        for (int k = 0; k < 6; ++k) rq[k] = gld16((const bf16_t*)(ws + P_QRAW) + (long)t * 384 + k * 64 + ch * 8);
#pragma unroll
        for (int k = 0; k < 8; ++k) rkv[k] = gld16((const bf16_t*)(ws + P_KVRAW) + (long)t * 512 + k * 64 + ch * 8);
        rpe = gld16((const bf16_t*)(ws + A_KPE) + (long)t * 32 + (ch & 3) * 8);
        const float* rp = (const float*)(ws + W_ROPE) + (long)s * 32;
        float cs[8], sn[8];
        { const int i0 = (ch & 1) * 8;
#pragma unroll
          for (int e = 0; e < 8; e += 2) { const u4 cc = gld16(rp + 2 * (i0 + e)); cs[e] = __uint_as_float(cc.x); sn[e] = __uint_as_float(cc.y); cs[e + 1] = __uint_as_float(cc.z); sn[e + 1] = __uint_as_float(cc.w); } }
        const bool x2half = (ch & 2) != 0;
        float vq[6][8], hs[4] = {0.f, 0.f, 0.f, 0.f};
#pragma unroll
        for (int k = 0; k < 6; ++k) { unpack8(rq[k], vq[k]); float ss = 0.f;
#pragma unroll
            for (int e = 0; e < 8; ++e) ss += vq[k][e] * vq[k][e];
            if (k == 0) hs[0] += ss; else if (k == 1) { hs[0] += ch < 4 ? ss : 0.f; hs[1] += ch < 4 ? 0.f : ss; } else if (k == 2) hs[1] += ss;
            else if (k == 3) hs[2] += ss; else if (k == 4) { hs[2] += ch < 4 ? ss : 0.f; hs[3] += ch < 4 ? 0.f : ss; } else hs[3] += ss; }
#pragma unroll
        for (int h = 0; h < 4; ++h) { hs[h] += __shfl_xor(hs[h], 1); hs[h] += __shfl_xor(hs[h], 2); hs[h] += __shfl_xor(hs[h], 4); hs[h] = __builtin_amdgcn_rsqf(hs[h] * (1.f / 96.f) + EPS); }
#pragma unroll
        for (int k = 0; k < 6; ++k) {
            const int piece = 8 * k + ch; const int h = (k == 0) ? 0 : (k == 1 ? (ch < 4 ? 0 : 1) : (k == 2 ? 1 : (k == 3 ? 2 : (k == 4 ? (ch < 4 ? 2 : 3) : 3)))); const int ph = piece - 12 * h;
            const float rs = h == 0 ? hs[0] : (h == 1 ? hs[1] : (h == 2 ? hs[2] : hs[3]));
            float o[8]; { const u4 ga = gld16(qg + ph * 8), gb = gld16(qg + ph * 8 + 4);
                o[0] = vq[k][0] * rs * __uint_as_float(ga.x); o[1] = vq[k][1] * rs * __uint_as_float(ga.y); o[2] = vq[k][2] * rs * __uint_as_float(ga.z); o[3] = vq[k][3] * rs * __uint_as_float(ga.w);
                o[4] = vq[k][4] * rs * __uint_as_float(gb.x); o[5] = vq[k][5] * rs * __uint_as_float(gb.y); o[6] = vq[k][6] * rs * __uint_as_float(gb.z); o[7] = vq[k][7] * rs * __uint_as_float(gb.w); }
            const bool rope_reg = (k == 1 || k == 2 || k == 4 || k == 5);
            if (rope_reg) { const bool is_rope = ph >= 8;
#pragma unroll
                for (int e = 0; e < 8; ++e) { const float other = __shfl_xor(o[e], 2); const float r1 = x2half ? other : o[e], r2 = x2half ? o[e] : other;
                    const float res = x2half ? (r1 * sn[e] + r2 * cs[e]) : (r1 * cs[e] - r2 * sn[e]); o[e] = is_rope ? res : o[e]; } }
            gst16((bf16_t*)(ws + A_QM) + ((long)(b * 4 + h) * S_ + s) * 96 + ph * 8, pack8f(o));
        }
        float vpe[8]; unpack8(rpe, vpe); float spe = 0.f;
#pragma unroll
        for (int e = 0; e < 8; ++e) spe += vpe[e] * vpe[e];
        spe = ch < 4 ? spe : 0.f; spe += __shfl_xor(spe, 1); spe += __shfl_xor(spe, 2); spe += __shfl_xor(spe, 4);
        float gkn[8], gkr[8];
        { const u4 a0 = gld16(kg + ch * 8), a1 = gld16(kg + ch * 8 + 4), b0 = gld16(kg + 64 + (ch & 3) * 8), b1 = gld16(kg + 64 + (ch & 3) * 8 + 4);
          gkn[0] = __uint_as_float(a0.x); gkn[1] = __uint_as_float(a0.y); gkn[2] = __uint_as_float(a0.z); gkn[3] = __uint_as_float(a0.w); gkn[4] = __uint_as_float(a1.x); gkn[5] = __uint_as_float(a1.y); gkn[6] = __uint_as_float(a1.z); gkn[7] = __uint_as_float(a1.w);
          gkr[0] = __uint_as_float(b0.x); gkr[1] = __uint_as_float(b0.y); gkr[2] = __uint_as_float(b0.z); gkr[3] = __uint_as_float(b0.w); gkr[4] = __uint_as_float(b1.x); gkr[5] = __uint_as_float(b1.y); gkr[6] = __uint_as_float(b1.z); gkr[7] = __uint_as_float(b1.w); }
#pragma unroll
        for (int h = 0; h < 4; ++h) {
            float vk[8]; unpack8(rkv[2 * h], vk); float ss = 0.f;
#pragma unroll
            for (int e = 0; e < 8; ++e) ss += vk[e] * vk[e];
            ss += __shfl_xor(ss, 1); ss += __shfl_xor(ss, 2); ss += __shfl_xor(ss, 4);
            const float rk = __builtin_amdgcn_rsqf((ss + spe) * (1.f / 96.f) + EPS);
            float o[8];
#pragma unroll
            for (int e = 0; e < 8; ++e) o[e] = vk[e] * rk * gkn[e];
            gst16((bf16_t*)(ws + A_KM) + kimg_off(b * 4 + h, s, ch, 12), pack8f(o));
            float pe[8];
#pragma unroll
            for (int e = 0; e < 8; ++e) pe[e] = vpe[e] * rk * gkr[e];
#pragma unroll
            for (int e = 0; e < 8; ++e) { const float other = __shfl_xor(pe[e], 2); const float r1 = x2half ? other : pe[e], r2 = x2half ? pe[e] : other;
                pe[e] = x2half ? (r1 * sn[e] + r2 * cs[e]) : (r1 * cs[e] - r2 * sn[e]); }
            if (ch < 4) gst16((bf16_t*)(ws + A_KM) + kimg_off(b * 4 + h, s, 8 + ch, 12), pack8f(pe));
            gst16((bf16_t*)(ws + A_VM) + vimg_off(b * 4 + h, s, ch), rkv[2 * h + 1]);
        }
    }
}

DEV void phase_combine(const Args& a) {
    const int lane = threadIdx.x & 63, wv = threadIdx.x >> 6; bf16_t* oraw = (bf16_t*)(a.ws + P_ORAW);
    for (int t = blockIdx.x * 8 + wv; t < T_; t += gridDim.x * 8) {
        bf16_t* p = oraw + (long)t * 1024 + lane * 16;
        float v0[8], v1[8]; unpack8(gld16(p), v0); unpack8(gld16(p + 8), v1);
        float ss = 0.f;
#pragma unroll
        for (int e = 0; e < 8; ++e) ss += v0[e] * v0[e] + v1[e] * v1[e];
        ss += __shfl_xor(ss, 1); ss += __shfl_xor(ss, 2); ss += __shfl_xor(ss, 4); ss += __shfl_xor(ss, 8);
        const float rs = __builtin_amdgcn_rsqf(ss * (1.f / 256.f) + EPS);
#pragma unroll
        for (int e = 0; e < 8; ++e) { v0[e] *= rs; v1[e] *= rs; }
        gst16(p, pack8f(v0)); gst16(p + 8, pack8f(v1));
    }
}

DEV int pair_index(int lo, int hi) { return 7 * lo - (lo * (lo - 1)) / 2 + (hi - lo - 1); }
DEV void phase_router(const Args& a, int l, bool dry = false) {
    unsigned char* ws = a.ws; const int lane = threadIdx.x & 63, wv = threadIdx.x >> 6, l31 = lane & 31, hi = lane >> 5;
    const bf16_t* Wb = (const bf16_t*)(ws + W_R) + (long)l * 2 * 48 * 1024; const bf16_t* xb = (const bf16_t*)(ws + X_XB);
    unsigned* ctl = (unsigned*)(ws + WS_CTL);
    constexpr unsigned WROW = 528, RT_WBUF = 96 * WROW;
    const unsigned lg = LDS_PH + 2 * RT_WBUF + wv * 6144;
    constexpr unsigned RT_CNT = LDS_PH + 2 * RT_WBUF + 8 * 6144, RT_BASE = RT_CNT + 1024;
    static_assert(RT_BASE + 1024 <= LDS_BYTES, "router LDS map");
    const float* bg = a.in[22] + l * 4; const float* be = a.in[24] + l * 32;
    for (int rnd = blockIdx.x; rnd < T_ / 256; rnd += gridDim.x) {
        f32x16 acc[2]; acc[0] = f32x16{}; acc[1] = f32x16{}; float ss = 0.f;
        if (threadIdx.x < 160) LDS_I(RT_CNT + threadIdx.x * 4) = 0;
        const int tk = rnd * 256 + wv * 32 + l31; const bf16_t* xr = xb + (long)tk * 1024 + hi * 8;
        u4 wst[6], xcur[16];
#pragma unroll
        for (int k = 0; k < 6; ++k) { const int i = threadIdx.x + 512 * k, row = i >> 5, c = i & 31; wst[k] = gld16(Wb + (long)row * 1024 + c * 8); }
#pragma unroll
        for (int sI = 0; sI < 16; ++sI) xcur[sI] = gld16(xr + sI * 16);
        __syncthreads();
#pragma unroll
        for (int k = 0; k < 6; ++k) { const int i = threadIdx.x + 512 * k, row = i >> 5, c = i & 31; LDS_U4(LDS_PH + row * WROW + c * 16) = wst[k]; }
        __syncthreads();
#pragma unroll 1
        for (int kc = 0; kc < 4; ++kc) {
            const unsigned wbuf = LDS_PH + (kc & 1) * RT_WBUF + l31 * WROW + hi * 16; const int kn = kc < 3 ? kc + 1 : 3;
            if (kc < 3) {
#pragma unroll
                for (int k = 0; k < 6; ++k) { const int i = threadIdx.x + 512 * k, row = i >> 5, c = i & 31; wst[k] = gld16(Wb + (long)row * 1024 + (kc + 1) * 256 + c * 8); }
            }
#pragma unroll
            for (int sI = 0; sI < 16; ++sI) {
                const u4 xv = xcur[sI]; const bf16x8 xf = __builtin_bit_cast(bf16x8, xv);
                xcur[sI] = gld16(xr + kn * 256 + sI * 16);
                __builtin_amdgcn_sched_barrier(0);
                const bf16x8 h0 = LDS_BF8(wbuf + sI * 32), h1 = LDS_BF8(wbuf + 32 * WROW + sI * 32), l0 = LDS_BF8(wbuf + 48 * WROW + sI * 32), l1 = LDS_BF8(wbuf + 80 * WROW + sI * 32);
                acc[0] = MFMA32(h0, xf, acc[0]); acc[1] = MFMA32(h1, xf, acc[1]); acc[0] = MFMA32(l0, xf, acc[0]); acc[1] = MFMA32(l1, xf, acc[1]);
                const float x0 = bflo(xv.x), x1 = bfhi(xv.x), x2 = bflo(xv.y), x3 = bfhi(xv.y), x4 = bflo(xv.z), x5 = bfhi(xv.z), x6 = bflo(xv.w), x7 = bfhi(xv.w);
                ss += (x0 * x0 + x1 * x1 + x2 * x2 + x3 * x3) + (x4 * x4 + x5 * x5 + x6 * x6 + x7 * x7);
            }
            if (kc < 3) {
#pragma unroll
                for (int k = 0; k < 6; ++k) { const int i = threadIdx.x + 512 * k, row = i >> 5, c = i & 31; LDS_U4(LDS_PH + ((kc + 1) & 1) * RT_WBUF + row * WROW + c * 16) = wst[k]; }
                __syncthreads(); }
        }
        const float rstd = __builtin_amdgcn_rsqf(hsum(ss) * (1.f / 1024.f) + EPS);
#pragma unroll
        for (int r = 0; r < 16; ++r) { LDS_F(lg + (l31 * 48 + crow(r, hi)) * 4) = acc[0][r]; if (r < 8) LDS_F(lg + (l31 * 48 + 32 + crow(r, hi)) * 4) = acc[1][r]; }
        int sv_e0 = 0, sv_e1 = 0, sv_p = 0, sv_r0 = 0, sv_r1 = 0, sv_r3 = 0;
        if (lane < 32) {
            const unsigned row = lg + lane * 192;
            float gl[4]; int gs = 0; float gm;
#pragma unroll
            for (int j = 0; j < 4; ++j) gl[j] = LDS_F(row + j * 4) * rstd + gldf(bg + j);
            gm = gl[0];
#pragma unroll
            for (int j = 1; j < 4; ++j) if (gl[j] > gm) { gm = gl[j]; gs = j; }
            float gden = 0.f;
#pragma unroll
            for (int j = 0; j < 4; ++j) gden += fexp2((gl[j] - gm) * LOG2E);
            const float gw = frcp(gden);
            float el[8];
#pragma unroll
            for (int j = 0; j < 8; ++j) el[j] = LDS_F(row + (4 + gs * 8 + j) * 4) * rstd + gldf(be + gs * 8 + j);
            int i1 = 0; float m1 = el[0];
#pragma unroll
            for (int j = 1; j < 8; ++j) if (el[j] > m1) { m1 = el[j]; i1 = j; }
            int i2 = -1; float m2 = -3.0e38f;
#pragma unroll
            for (int j = 0; j < 8; ++j) if (j != i1 && el[j] > m2) { m2 = el[j]; i2 = j; }
            const float p2 = fexp2((m2 - m1) * LOG2E); const float w1 = gw * frcp(1.f + p2), w2 = gw - w1;
            const int lo = i1 < i2 ? i1 : i2, hi2 = i1 < i2 ? i2 : i1; const float wlo = i1 < i2 ? w1 : w2, whi = i1 < i2 ? w2 : w1;
            const int elo = gs * 8 + lo, ehi = gs * 8 + hi2, pr = gs * 28 + pair_index(lo, hi2);
            { u2 ww; ww.x = __float_as_uint(wlo); ww.y = __float_as_uint(whi); gst8((float*)(ws + M_WSLOT) + 2 * tk, ww); }
            *(GAS float*)((float*)(ws + M_RSTD2) + tk) = rstd;
            sv_e0 = elo; sv_e1 = ehi; sv_p = pr;
            sv_r0 = atomicAdd((int*)(smem + RT_CNT + elo * 4), 1); sv_r1 = atomicAdd((int*)(smem + RT_CNT + ehi * 4), 1); sv_r3 = atomicAdd((int*)(smem + RT_CNT + (32 + pr) * 4), 1);
        }
        __syncthreads();
        if (!dry && threadIdx.x < 160) { const int t = threadIdx.x; const int c = LDS_I(RT_CNT + t * 4); int base = 0;
            if (c > 0 && t < 32 + NPAIR) base = (int)atomicAdd(t < 32 ? ctl + CW_CNTE + l * 32 + t : ctl + CW_CNTP + l * 128 + (t - 32), (unsigned)c);
            LDS_I(RT_BASE + t * 4) = base; }
        __syncthreads();
        if (!dry && lane < 32) {
            *(GAS int*)((int*)(ws + M_LISTE) + (long)sv_e0 * 65536 + LDS_I(RT_BASE + sv_e0 * 4) + sv_r0) = tk * 2;
            *(GAS int*)((int*)(ws + M_LISTE) + (long)sv_e1 * 65536 + LDS_I(RT_BASE + sv_e1 * 4) + sv_r1) = tk * 2 + 1;
            *(GAS int*)((int*)(ws + M_LISTP) + (long)sv_p * 65536 + LDS_I(RT_BASE + (32 + sv_p) * 4) + sv_r3) = tk;
        }
    }
}

DEV void phase_moe1(const Args& a, int l) {
    unsigned char* ws = a.ws; unsigned* cnt = (unsigned*)(ws + WS_CTL) + CW_CNTE + l * 32;
    if (threadIdx.x < 32) LDS_I(LDS_EPI + 4096 + threadIdx.x * 4) = (int)xb_ld(cnt + threadIdx.x);
    __syncthreads();
    if (threadIdx.x == 0) { int af = 0, ah = 0; for (int e = 0; e < 32; ++e) { const int c = LDS_I(LDS_EPI + 4096 + e * 4); LDS_I(LDS_SCHED + e * 4) = af; LDS_I(LDS_SCHED + 256 + e * 4) = ah; af += (c >> 8) * 2; ah += (((c & 255) + 127) >> 7) * 2; }
        LDS_I(LDS_SCHED + 32 * 4) = af; LDS_I(LDS_SCHED + 256 + 32 * 4) = ah; }
    __syncthreads();
    const int nfull = LDS_I(LDS_SCHED + 32 * 4), total = nfull + LDS_I(LDS_SCHED + 256 + 32 * 4);
    for (int t = blockIdx.x; t < total; t += gridDim.x) {
        const bool full = t < nfull; const int v = full ? t : t - nfull; const unsigned tab = LDS_SCHED + (full ? 0 : 256);
        int e = 0; while (e < 31 && v >= LDS_I(tab + (e + 1) * 4)) ++e;
        const int loc = v - LDS_I(tab + e * 4), mt = loc >> 1, nt = loc & 1; const int ce = LDS_I(LDS_EPI + 4096 + e * 4);
        GemmMoe1 p{(const bf16_t*)(ws + X_XB), (const int*)(ws + M_LISTE) + (long)e * 65536, (const bf16_t*)(ws + W_GU) + ((long)(l * 32 + e) * 512) * 1024,
                   (const float*)(ws + M_RSTD2), (const float*)(ws + M_WSLOT), (bf16_t*)(ws + M_ABUF)};
        if (full) gemm_tile<4, 4>(p, mt * 256, nt * 256, 256);
        else { const int row0 = (ce >> 8) * 256 + mt * 128; const int mrows = ce - row0 < 128 ? ce - row0 : 128; gemm_tile3<2, 4>(p, row0, nt * 256, mrows); }
    }
}
DEV void phase_moe2(const Args& a, int l, float* xout, float* ssqo) {
    unsigned char* ws = a.ws; unsigned* cnt = (unsigned*)(ws + WS_CTL) + CW_CNTP + l * 128;
    if (threadIdx.x < NPAIR) LDS_I(LDS_EPI + 4096 + threadIdx.x * 4) = (int)xb_ld(cnt + threadIdx.x);
    __syncthreads();
    if (threadIdx.x == 0) { int acc = 0; for (int e = 0; e < NPAIR; ++e) { LDS_I(LDS_SCHED + e * 4) = acc; acc += ((LDS_I(LDS_EPI + 4096 + e * 4) + 127) >> 7) * 4; } LDS_I(LDS_SCHED + NPAIR * 4) = acc; }
    __syncthreads();
    const int total = LDS_I(LDS_SCHED + NPAIR * 4);
    for (int t = blockIdx.x; t < total; t += gridDim.x) {
        int e = 0; while (e < NPAIR - 1 && t >= LDS_I(LDS_SCHED + (e + 1) * 4)) ++e;
        const int loc = t - LDS_I(LDS_SCHED + e * 4), mt = loc >> 2, nt = loc & 3; const int ce = LDS_I(LDS_EPI + 4096 + e * 4); const int mrows = ce - mt * 128 < 128 ? ce - mt * 128 : 128;
        const int gs = e / 28; int q = e % 28, lo = 0; while (q >= 7 - lo) { q -= 7 - lo; ++lo; } const int hi2 = lo + 1 + q;
        const bf16_t* Wd = (const bf16_t*)(ws + W_DN) + (long)(l * 32) * 262144;
        GemmMoe2 p{(const bf16_t*)(ws + M_ABUF), (const int*)(ws + M_LISTP) + (long)e * 65536, Wd + (long)(gs * 8 + lo) * 262144, Wd + (long)(gs * 8 + hi2) * 262144, (bf16_t*)(ws + X_XB), xout, ssqo};
        gemm_tile3<2, 4>(p, mt * 128, nt * 256, mrows);
    }
}

#ifndef ATT_ONLY
#define ATT_ONLY 15
#endif
#define ATT_QUEUE_X(XQ, NPER, BODY) { int tid__ = threadIdx.x; asm volatile("" : "+v"(tid__)); const int x0_ = (int)(xb_xcc_id() & 7u); \
    for (int xi_ = 0; xi_ < 8; ++xi_) { const int xq = (x0_ + xi_) & 7; for (;;) { if (tid__ == 0) LDS_I(AT_ITEM) = (int)atomicAdd(qx + (XQ) + xq, 1u); __syncthreads(); \
        const int item = __builtin_amdgcn_readfirstlane(LDS_I(AT_ITEM)); __syncthreads(); if (item >= (NPER)) break; BODY } } }
#define ATT_QUEUE(QIDX, NITEMS, BODY) ATT_QUEUE_F(QIDX, NITEMS, false, BODY)
#define ATT_QUEUE_F(QIDX, NITEMS, FIRST, BODY) { int tid__ = threadIdx.x; asm volatile("" : "+v"(tid__)); const int q0_ = (FIRST) ? (int)gridDim.x : 0; int nx_ = 0; \
    if (FIRST) nx_ = (int)blockIdx.x; else if (tid__ == 0) nx_ = (int)atomicAdd(qc + (QIDX), 1u); \
    for (;;) { if (tid__ == 0) LDS_I(AT_ITEM) = nx_; __syncthreads(); \
        const int item = __builtin_amdgcn_readfirstlane(LDS_I(AT_ITEM)); __syncthreads(); if (item >= (NITEMS)) break; \
        if (tid__ == 0) nx_ = q0_ + (int)atomicAdd(qc + (QIDX), 1u);        \
        BODY } }
DEV void phase_attn(const Args& a, int l) {
    unsigned* qc = (unsigned*)(a.ws + WS_CTL) + CW_ATTQ + l * 16; unsigned* qx = (unsigned*)(a.ws + WS_CTL) + CW_ATTQ + 64 + l * 32;
#ifndef PROBE_ATT
#define PROBE_ATT 0
#endif
    if (PROBE_ATT & 1) ATT_QUEUE(8, 1024, { attn_mla(tid__, a, l, (item & 31) >> 2, item & 3, 31 - (item >> 5)); })
    if (PROBE_ATT & 2) ATT_QUEUE(9, 1024, { attn_nsa_b(tid__, a, l, (item & 15) >> 1, item & 1, 63 - (item >> 4)); })
    if (PROBE_ATT & 4) ATT_QUEUE(10, 1024, { attn_sb(tid__, a, l, item >> 7, (item >> 5) & 3, item & 31); })
    if (PROBE_ATT & 8) ATT_QUEUE(11, 1024, { attn_swa(tid__, a, l, item >> 7, (item >> 6) & 1, item & 63); })
    if (ATT_ONLY & 2) ATT_QUEUE_F(4, 1024, (gridDim.x <= 1024), { attn_nsa_a(tid__, a, l, (item & 15) >> 1, item & 1, 63 - (item >> 4)); if (PROBE_NSA & 1) attn_nsa_a(tid__, a, l, (item & 15) >> 1, item & 1, 63 - (item >> 4)); })
    if (ATT_ONLY & 1) ATT_QUEUE_X(0, 128, { const int st_ = xq * 4 + (item & 3); attn_mla(tid__, a, l, st_ >> 2, st_ & 3, 31 - (item >> 2)); })
    if (ATT_ONLY & 2) ATT_QUEUE(1, 1024, { attn_nsa_b(tid__, a, l, (item & 15) >> 1, item & 1, 63 - (item >> 4)); })
    if (ATT_ONLY & 4) ATT_QUEUE(2, 1024, { attn_sb(tid__, a, l, item >> 7, (item >> 5) & 3, item & 31); })
    if (ATT_ONLY & 8) ATT_QUEUE(3, 1024, { attn_swa(tid__, a, l, item >> 7, (item >> 6) & 1, item & 63); })
}

constexpr int NPHASE = 1 + 11 * L_;
#define XCD_REMAP(t) ((((t) & ~255)) + (((t) & 7) << 5) + (((t) & 255) >> 3))
#ifndef PROBE_PH
#define PROBE_PH 0
#endif
#ifndef PH_ONLY
#define PH_ONLY -1
#endif
#define IN(k) (a0.ph_lo <= (k) && (k) < a0.ph_hi && (PH_ONLY < 0 || PH_ONLY == ((k) == 0 ? 0 : 1 + ((k) - 1) % 11)))
#define GB(k) do { if (IN(k) && IN((k) + 1)) { xcd_barrier(bar); if (PROBE_PH & 2048) { xcd_barrier(bar); xcd_barrier(bar); } } } while (0)
#define GB2(k) do { if (IN(k) && IN((k) + 2)) xcd_barrier(bar); } while (0)
#define LAUNDER() do { unsigned char* w_ = a0.ws; float* o_ = a0.out; const float* x_ = xin0; asm volatile("" : "+s"(w_), "+s"(o_), "+s"(x_)); a.ws = w_; a.out = o_; ws = w_; xin = x_; } while (0)
template <int l> DEV void run_layer(const Args& a0, const XcdBarrier& bar) {
    Args a = a0; unsigned char* ws = a0.ws;
    const int pb = 1 + 11 * l;
    const float* xin0 = l == 0 ? a0.in[0] : (const float*)a0.out; const float* xin = xin0;
    if (IN(pb + 1)) { LAUNDER();
        pg8::Gemm g{(const bf16_t*)(ws + X_XB), (const bf16_t*)(ws + W_WIN) + (long)l * PLD * 1024, T_, 2816, 1024};
        pg8::StaticOrder S; S.init(T_, 2816, (int)gridDim.x, (int)blockIdx.x);
        pg8::EpiProj E{(bf16_t*)(ws + P_PROJ), PLD, PLD, l == 0 ? (const float*)(ws + MS_RSTD1) : (const float*)(ws + MS_SSQP), l == 0 ? 1 : 4, T_};
        for (int rep = 0; rep < ((PROBE_PH & 1) ? 2 : 1); ++rep)
        pg8::gemm_phase<pg8::EpiProj, pg8::StaticOrder, true, true>((LAS unsigned char*)((LAS char*)smem + LDS_PH), g, S, E);
    }
    GB(pb + 1);
    if (IN(pb + 2)) { LAUNDER(); phase_prep(a, l); if (PROBE_PH & 2) phase_prep(a, l); }
    GB(pb + 2);
    if (IN(pb + 3)) { LAUNDER();
        for (int rep = 0; rep < ((PROBE_PH & 16) ? 2 : 1); ++rep)
        {
            if (blockIdx.x < 64) { const int u = blockIdx.x, w = u >> 5; GemmCmp1 p{(const bf16_t*)(ws + A_XC), w, (const bf16_t*)(ws + W_C1) + (long)(l * 2 + w) * 128 * 2048, (const float*)(ws + W_B1) + (l * 2 + w) * 128, (bf16_t*)(ws + A_H1) + (long)w * 8192 * 128};
                gemm_tile3<2, 2>(p, (u & 31) * 256, 0, 256); }
            const bf16_t* wq = (const bf16_t*)(ws + W_QUP) + (long)l * 384 * 192; const bf16_t* wkv = (const bf16_t*)(ws + W_KVUP) + (long)l * 512 * 128;
            auto mk = [&](int u, GemmPlain& p, int& m0, int& n0) {
                if (u < 768) { p = GemmPlain{(const bf16_t*)(ws + A_CQN), 192, wq, 192, 3, (bf16_t*)(ws + P_QRAW), 384}; m0 = (u / 3) * 256; n0 = (u % 3) * 128; }
                else { const int v = u - 768; p = GemmPlain{(const bf16_t*)(ws + A_CKVN), 128, wkv, 128, 2, (bf16_t*)(ws + P_KVRAW), 512}; m0 = (v / 4) * 256; n0 = (v % 4) * 128; } };
            if (gridDim.x == 256) {
                if (blockIdx.x < 64) gemm_smallk_run(mk, (int)blockIdx.x, 64, 64); else gemm_smallk_run(mk, 64 + ((int)blockIdx.x - 64), 192, 1792);
            } else gemm_smallk_run(mk, (int)blockIdx.x, (int)gridDim.x, 1792);
        }
    }
    GB(pb + 3);
    if (IN(pb + 4)) { LAUNDER();
        phase_mla_fin(a, l);
        if (PROBE_PH & 32) phase_mla_fin(a, l);
        __syncthreads();
        for (int t = blockIdx.x; t < 64; t += gridDim.x) { const int w = t >> 5;
            GemmCmp2 p{(const bf16_t*)(ws + A_H1) + (long)w * 8192 * 128, w, (const bf16_t*)(ws + W_C2) + (long)(l * 2 + w) * 128 * 128, a.in[8] + (l * 3) * 64, (bf16_t*)(ws + A_KC), (bf16_t*)(ws + A_VC)};
            gemm_tile3<2, 2>(p, (t & 31) * 256, 0, 256); }
    }
    GB(pb + 4);
    if (IN(pb + 5)) { LAUNDER(); phase_attn(a, l); }
    GB(pb + 5);
    if (IN(pb + 6)) { LAUNDER(); phase_combine(a); if (PROBE_PH & 64) phase_combine(a); }
    GB(pb + 6);
    if (IN(pb + 7)) { LAUNDER();
        pg8::Gemm g{(const bf16_t*)(ws + P_ORAW), (const bf16_t*)(ws + W_WOUT) + (long)l * 1048576, T_, 1024, 1024};
        pg8::StaticOrder S; S.init(T_, 1024, (int)gridDim.x, (int)blockIdx.x);
        pg8::EpiResid E{(bf16_t*)(ws + X_XB), 1024};
        for (int rep = 0; rep < (((PROBE_PH & 128) && l == 0) ? 2 : 1); ++rep)
        pg8::gemm_phase<pg8::EpiResid, pg8::StaticOrder, true, true>((LAS unsigned char*)((LAS char*)smem + LDS_PH), g, S, E);
    }
    GB(pb + 7);
    if (IN(pb + 8)) { LAUNDER(); phase_router(a, l); if (PROBE_PH & 512) phase_router(a, l, true); }
    GB(pb + 8);
    if (IN(pb + 9)) { LAUNDER(); phase_moe1(a, l); if (PROBE_PH & 4) { __syncthreads(); phase_moe1(a, l); } }
    GB(pb + 9);
    if (IN(pb + 10)) { LAUNDER(); phase_moe2(a, l, l + 1 < L_ ? nullptr : a.out, (float*)(ws + MS_SSQP)); if (PROBE_PH & 1024) { __syncthreads(); phase_moe2(a, l, (float*)(ws + P_PROJ), nullptr); } }
    if (l + 1 < L_) GB2(pb + 10);
}
__global__ void __launch_bounds__(512, 2) hymba_fwd(Args a0) {
    if (threadIdx.x == 0) { LDS_U(0) = 0u; LDS_U(4) = 0u; LDS_U(8) = 0u; LDS_U(12) = 0u; }
    __syncthreads();
    XcdBarrier bar; bar.bar = (unsigned*)(a0.ws + WS_CTL) + CW_BAR; bar.x = 0; bar.st = (volatile LAS unsigned*)((LAS char*)smem);
    if (a0.ph_hi - a0.ph_lo > 1) bar = xcd_barrier_post((unsigned*)(a0.ws + WS_CTL) + CW_BAR, (volatile LAS unsigned*)((LAS char*)smem));
    if (IN(0)) { phase_p0(a0); if (PROBE_PH & 256) { __syncthreads(); phase_p0(a0); } }
    GB2(0);
    run_layer<0>(a0, bar);
    run_layer<1>(a0, bar);
}

extern "C" void kernel_launch(void* const* d_in, const int* in_sizes, int n_in, void* d_out, int out_size, void* d_ws, size_t ws_size, hipStream_t stream) {
    static int grid = 0;
    if (grid == 0) {
        if (n_in != 28 || out_size != T_ * D_ || ws_size < WS_END) { fprintf(stderr, "kernel_launch: unexpected shapes (n_in %d out %d ws %zu)\n", n_in, out_size, ws_size); grid = -1; return; }
        int dev = 0, cus = 0, per_cu = 0;
        if (hipGetDevice(&dev) != hipSuccess || hipDeviceGetAttribute(&cus, hipDeviceAttributeMultiprocessorCount, dev) != hipSuccess) { grid = -1; return; }
        if (hipFuncSetAttribute((const void*)hymba_fwd, hipFuncAttributeMaxDynamicSharedMemorySize, LDS_BYTES) != hipSuccess) { fprintf(stderr, "kernel_launch: hipFuncSetAttribute failed\n"); grid = -1; return; }
        if (hipOccupancyMaxActiveBlocksPerMultiprocessor(&per_cu, (const void*)hymba_fwd, 512, LDS_BYTES) != hipSuccess || per_cu < 1) { fprintf(stderr, "kernel_launch: occupancy query reports %d\n", per_cu); per_cu = 1; }
        (void)hipGetLastError();
        grid = cus;
    }
    if (grid < 0) return;
    (void)hipMemsetAsync((char*)d_ws + WS_CTL, 0, CTL_BYTES, stream);
    Args a{};
    for (int i = 0; i < 28; ++i) a.in[i] = (const float*)d_in[i];
    a.out = (float*)d_out; a.ws = (unsigned char*)d_ws;
#if MK_LAUNCHES == 1
    a.ph_lo = 0; a.ph_hi = NPHASE;
    hipLaunchKernelGGL(hymba_fwd, dim3(grid), dim3(512), LDS_BYTES, stream, a);
#else
    for (int k = 0; k < NPHASE; ++k) { a.ph_lo = k; a.ph_hi = k + 1; hipLaunchKernelGGL(hymba_fwd, dim3(grid), dim3(512), LDS_BYTES, stream, a); }
#endif
}
```
